# Optimizing an MI355X kernel written in HIP

```python
import math
import jax, jax.numpy as jnp
from jax import lax
import numpy as np

D_MODEL = 1024
BATCH = 4
SEQ = 8192
DEPTH = 2

GLA_HEADS = 4
GLA_DK = 64
GLA_DV = 128
GLA_GATE_RANK = 16
GLA_TAU = 16.0
GLA_CHUNK = 64
MLA_HEADS = 4
MLA_NOPE = 128
MLA_ROPE = 64
MLA_V = 128
MLA_Q_RANK = 256
MLA_KV_RANK = 128
ROPE_THETA = 10000.0
ATTN_BLOCK = 128
D_GLA = GLA_HEADS * GLA_DV
D_MLA = MLA_HEADS * MLA_V
D_MIX = D_GLA + D_MLA
D_FF = 4 * D_MODEL
N_MOD = 6
RMS_EPS = 1e-6
IN_SIZES = (GLA_HEADS * GLA_DK, GLA_HEADS * GLA_DK, D_GLA, D_GLA, GLA_GATE_RANK,
            MLA_Q_RANK, MLA_KV_RANK, MLA_ROPE)
D_IN = sum(IN_SIZES)

kernel_name = 'hybrid_gla_mla_adaln_block'


def split_cols(t, sizes):
    idx = []
    acc = 0
    for s in sizes[:-1]:
        acc += s
        idx.append(acc)
    return jnp.split(t, idx, axis=-1)


def rms_norm(x, gain=None):
    xf = x.astype(jnp.float32)
    y = xf * lax.rsqrt(jnp.mean(xf * xf, axis=-1, keepdims=True) + RMS_EPS)
    if gain is not None:
        y = y * gain.astype(jnp.float32)
    return y.astype(x.dtype)


def rope_tables(positions):
    inv_freq = ROPE_THETA ** (-jnp.arange(0, MLA_ROPE, 2, dtype=jnp.float32) / MLA_ROPE)
    ang = positions.astype(jnp.float32)[..., None] * inv_freq
    return jnp.cos(ang), jnp.sin(ang)


def apply_rope(t, cos, sin):
    t = t.astype(jnp.float32)
    half = t.shape[-1] // 2
    t1, t2 = t[..., :half], t[..., half:]
    return jnp.concatenate([t1 * cos - t2 * sin, t2 * cos + t1 * sin], axis=-1)


def gla_chunked(q, k, v, log_a):
    B, S, H, dk = q.shape
    dv = v.shape[-1]
    C = GLA_CHUNK
    N = S // C

    def to_chunks(t):
        return t.reshape(B, N, C, H, t.shape[-1]).transpose(1, 0, 3, 2, 4)

    causal = jnp.tril(jnp.ones((C, C), dtype=bool))

    def step(state, inp):
        qc, kc, vc, gc = inp
        b = jnp.cumsum(gc, axis=2)
        o_inter = jnp.einsum('bhcd,bhde->bhce', qc * jnp.exp(b), state)
        diff = b[:, :, :, None, :] - b[:, :, None, :, :]
        decay = jnp.exp(jnp.where(causal[:, :, None], diff, -jnp.inf))
        attn = jnp.sum(qc[:, :, :, None, :] * kc[:, :, None, :, :] * decay, axis=-1)
        o_intra = jnp.einsum('bhij,bhje->bhie', attn, vc)
        b_last = b[:, :, -1:, :]
        k_dec = kc * jnp.exp(b_last - b)
        state = jnp.exp(b_last[:, :, 0, :])[..., None] * state + jnp.einsum('bhcd,bhce->bhde', k_dec, vc)
        return state, o_inter + o_intra

    state0 = jnp.zeros((B, H, dk, dv), dtype=jnp.float32)
    _, o = lax.scan(step, state0, (to_chunks(q), to_chunks(k), to_chunks(v), to_chunks(log_a)))
    return o.transpose(1, 0, 3, 2, 4).reshape(B, S, H, dv)


def mla_attention(q_nope, q_pe, k_nope, k_pe, v):
    B, S, H, _ = q_nope.shape
    NB = S // ATTN_BLOCK
    scale = (MLA_NOPE + MLA_ROPE) ** -0.5
    key_idx = jnp.arange(S)

    def blocks(t):
        return t.reshape(B, NB, ATTN_BLOCK, *t.shape[2:]).swapaxes(0, 1)

    def one_block(args):
        qn, qp, blk = args
        s = (jnp.einsum('bqhd,bkhd->bhqk', qn, k_nope).astype(jnp.float32)
             + jnp.einsum('bqhr,bkr->bhqk', qp, k_pe).astype(jnp.float32)) * scale
        q_idx = blk * ATTN_BLOCK + jnp.arange(ATTN_BLOCK)
        mask = key_idx[None, :] <= q_idx[:, None]
        p = jax.nn.softmax(jnp.where(mask, s, -jnp.inf), axis=-1)
        return jnp.einsum('bhqk,bkhe->bqhe', p.astype(v.dtype), v)

    out = lax.map(one_block, (blocks(q_nope), blocks(q_pe), jnp.arange(NB)))
    return out.swapaxes(0, 1).reshape(B, S, H, v.shape[-1])


def hybrid_mixer(h, cos, sin, w_in, w_gate_up, b_gate, gla_out_norm, q_a_norm, w_q_up,
                 kv_a_norm, w_kv_up, q_norm_nope, k_norm_nope, q_norm_rope, k_norm_rope, w_out):
    B, S, _ = h.shape
    proj = h @ w_in
    g_q, g_k, g_v, g_o, g_a, m_q, m_kv, m_kpe = split_cols(proj, IN_SIZES)

    q = g_q.reshape(B, S, GLA_HEADS, GLA_DK).astype(jnp.float32) * (GLA_DK ** -0.5)
    k = g_k.reshape(B, S, GLA_HEADS, GLA_DK).astype(jnp.float32)
    v = g_v.reshape(B, S, GLA_HEADS, GLA_DV).astype(jnp.float32)
    log_a = jax.nn.log_sigmoid((g_a @ w_gate_up + b_gate).astype(jnp.float32)) / GLA_TAU
    log_a = log_a.reshape(B, S, GLA_HEADS, GLA_DK)
    o = gla_chunked(q, k, v, log_a)
    o = rms_norm(o, gla_out_norm) * jax.nn.silu(g_o.reshape(B, S, GLA_HEADS, GLA_DV).astype(jnp.float32))
    gla_out = o.reshape(B, S, D_GLA).astype(h.dtype)

    qh = (rms_norm(m_q, q_a_norm) @ w_q_up).reshape(B, S, MLA_HEADS, MLA_NOPE + MLA_ROPE)
    q_nope, q_pe = qh[..., :MLA_NOPE], qh[..., MLA_NOPE:]
    q_nope = rms_norm(q_nope, q_norm_nope)
    q_pe = apply_rope(rms_norm(q_pe, q_norm_rope), cos[:, :, None, :], sin[:, :, None, :])
    kv = (rms_norm(m_kv, kv_a_norm) @ w_kv_up).reshape(B, S, MLA_HEADS, MLA_NOPE + MLA_V)
    k_nope, mv = kv[..., :MLA_NOPE], kv[..., MLA_NOPE:]
    k_nope = rms_norm(k_nope, k_norm_nope)
    k_pe = apply_rope(rms_norm(m_kpe, k_norm_rope), cos, sin)
    mla_out = mla_attention(q_nope, q_pe, k_nope, k_pe, mv).reshape(B, S, D_MLA)

    mixed = jnp.concatenate([gla_out, mla_out.astype(gla_out.dtype)], axis=-1)
    return mixed @ w_out


def setup_inputs(seed: int = 0) -> dict:
    key = jax.random.key(seed)
    ks = jax.random.split(key, 24)
    f32 = jnp.float32

    def w(k, shape, fan_in):
        return jax.random.normal(k, shape, f32) * (fan_in ** -0.5)

    def gain(k, shape):
        return 1.0 + 0.02 * jax.random.normal(k, shape, f32)

    x = jax.random.normal(ks[0], (BATCH, SEQ, D_MODEL), f32)
    c = jax.random.normal(ks[1], (BATCH, D_MODEL), f32)
    offsets = jax.random.randint(ks[2], (BATCH, 1), 0, 1024, dtype=jnp.int32)
    positions = (offsets + jnp.arange(SEQ, dtype=jnp.int32)[None, :]).astype(jnp.int32)
    return {
        'x': x,
        'c': c,
        'positions': positions,
        'w_ada': w(ks[3], (DEPTH, D_MODEL, N_MOD * D_MODEL), D_MODEL),
        'b_ada': 0.02 * jax.random.normal(ks[4], (DEPTH, N_MOD * D_MODEL), f32),
        'w_in': w(ks[5], (DEPTH, D_MODEL, D_IN), D_MODEL),
        'w_gate_up': w(ks[6], (DEPTH, GLA_GATE_RANK, GLA_HEADS * GLA_DK), GLA_GATE_RANK),
        'b_gate': 0.1 * jax.random.normal(ks[7], (DEPTH, GLA_HEADS * GLA_DK), f32),
        'gla_out_norm': gain(ks[8], (DEPTH, GLA_DV)),
        'q_a_norm': gain(ks[9], (DEPTH, MLA_Q_RANK)),
        'w_q_up': w(ks[10], (DEPTH, MLA_Q_RANK, MLA_HEADS * (MLA_NOPE + MLA_ROPE)), MLA_Q_RANK),
        'kv_a_norm': gain(ks[11], (DEPTH, MLA_KV_RANK)),
        'w_kv_up': w(ks[12], (DEPTH, MLA_KV_RANK, MLA_HEADS * (MLA_NOPE + MLA_V)), MLA_KV_RANK),
        'q_norm_nope': gain(ks[13], (DEPTH, MLA_NOPE)),
        'k_norm_nope': gain(ks[14], (DEPTH, MLA_NOPE)),
        'q_norm_rope': gain(ks[15], (DEPTH, MLA_ROPE)),
        'k_norm_rope': gain(ks[16], (DEPTH, MLA_ROPE)),
        'w_out': w(ks[17], (DEPTH, D_MIX, D_MODEL), D_MIX),
        'w_mlp_up': w(ks[18], (DEPTH, D_MODEL, D_FF), D_MODEL),
        'w_mlp_down': w(ks[19], (DEPTH, D_FF, D_MODEL), D_FF),
    }


def reference(x, c, positions, w_ada, b_ada, w_in, w_gate_up, b_gate, gla_out_norm, q_a_norm,
              w_q_up, kv_a_norm, w_kv_up, q_norm_nope, k_norm_nope, q_norm_rope, k_norm_rope,
              w_out, w_mlp_up, w_mlp_down):
    cos, sin = rope_tables(positions)
    cond = jax.nn.silu(c)
    for l in range(DEPTH):
        mod = (cond @ w_ada[l] + b_ada[l])[:, None, :]
        shift_a, scale_a, gate_a, shift_f, scale_f, gate_f = jnp.split(mod, N_MOD, axis=-1)
        h = rms_norm(x) * (1.0 + scale_a) + shift_a
        mix = hybrid_mixer(h, cos, sin, w_in[l], w_gate_up[l], b_gate[l], gla_out_norm[l],
                           q_a_norm[l], w_q_up[l], kv_a_norm[l], w_kv_up[l], q_norm_nope[l],
                           k_norm_nope[l], q_norm_rope[l], k_norm_rope[l], w_out[l])
        x = x + gate_a * mix
        h = rms_norm(x) * (1.0 + scale_f) + shift_f
        x = x + gate_f * (jnp.square(jax.nn.relu(h @ w_mlp_up[l])) @ w_mlp_down[l])
    return x
```

```cpp
#include <hip/hip_runtime.h>
#include <hip/hip_bf16.h>
#include <hip/hip_cooperative_groups.h>
#include <cstdio>
#include <cstdint>
#include <cmath>
namespace cg = cooperative_groups;
__device__ __forceinline__ int opaque_tid() { int t = threadIdx.x; asm volatile("" : "+v"(t)); return t; }
namespace pg8 {
#define PG8_LAS __attribute__((address_space(3)))
typedef unsigned short bf16_t;
typedef short bf16x8 __attribute__((ext_vector_type(8)));
typedef float f32x4 __attribute__((ext_vector_type(4)));
typedef unsigned u32x4 __attribute__((ext_vector_type(4)));
constexpr int BM = 256, BK = 64, HALF = 128, HTB = HALF * BK * 2  , STAGE_BYTES = 8 * HTB, NXCD = 8, WGM = 8;

__host__ __device__ __forceinline__ int lds_byte(int r, int c) { const int st = (r >> 4) * 2 + (c >> 5), rr = r & 15, cc = c & 31, ob = rr * 64 + cc * 2; return st * 1024 + (ob ^ (((ob >> 9) & 1) << 5)); }
__host__ __device__ __forceinline__ void stage_rc(int b, int& R, int& C) { const int st = b / 1024, sb = b % 1024, swz = sb ^ (((sb >> 9) & 1) << 5); R = (st >> 1) * 16 + swz / 64; C = (st & 1) * 32 + (swz % 64) / 2; }
__host__ __device__ __forceinline__ int perm32(int rho) { const int n = rho >> 4, i = rho & 15; return 8 * (i >> 2) + 4 * n + (i & 3); }

struct Unit { int pm, pn; };
struct Gemm { const bf16_t* A; const bf16_t* Bt; int M, N, K; };

struct StaticOrder {
    int nM, nN, nwg, G, c;
    __host__ __device__ void init(int M, int N, int G_, int c_) { nM = M / BM; nN = N / BM; nwg = nM * nN; G = G_; c = c_; }
    __host__ __device__ bool next(int i, Unit& u) const {
        const long L = (long)i * G + c; if (L >= nwg) return false;
        int wgid = (int)L; { const int q = nwg / NXCD, r = nwg % NXCD, xcd = wgid % NXCD, off = wgid / NXCD; wgid = (xcd < r ? xcd * (q + 1) : r * (q + 1) + (xcd - r) * q) + off; }
        const int nig = WGM * nN, gid = wgid / nig, fm = gid * WGM, gsz = (nM - fm) < WGM ? (nM - fm) : WGM;
        u.pm = fm + ((wgid % nig) % gsz); u.pn = (wgid % nig) / gsz; return true;
    }
    __device__ __forceinline__ void a_ready(const Unit&) const {}
    __device__ __forceinline__ void done(const Unit&) const {}
};

__device__ __forceinline__ unsigned cvt_pk_bf16(float lo, float hi) { unsigned r; asm volatile("v_cvt_pk_bf16_f32 %0, %1, %2" : "=v"(r) : "v"(lo), "v"(hi)); return r; }
typedef float f32x2 __attribute__((ext_vector_type(2)));
__device__ __forceinline__ f32x2 gelu_pk(f32x2 v) {
    const f32x2 av = __builtin_elementwise_abs(v), d = av * 0.2316418882f + 1.0f;
    f32x2 t; t.x = __builtin_amdgcn_rcpf(d.x); t.y = __builtin_amdgcn_rcpf(d.y);
    f32x2 q = t * 0.5307027145f + (-0.7265760135f); q = q * t + 0.7107068705f; q = q * t + (-0.142248368f); q = q * t + 0.127414796f; q = q * t;
    const f32x2 s = (v * v) * (-0.72134752044f);
    f32x2 e; e.x = __builtin_amdgcn_exp2f(s.x); e.y = __builtin_amdgcn_exp2f(s.y);
    const f32x2 m = v * (q * e), r = v - m;
    f32x2 o; o.x = v.x < 0.f ? m.x : r.x; o.y = v.y < 0.f ? m.y : r.y; return o;
}

template <int ACT  > struct EpiBf16 {
    static constexpr bool PERM = true, AFTER_DRAIN = false; static_assert(ACT == 0 || ACT == 1 || ACT == 2, "EpiBf16: ACT is 0 (none), 1 (gelu_pk) or 2 (relu squared)");
    bf16_t* O; int ldc; const float* bias; int split_cols; size_t split_stride; float scale0;
    __device__ __forceinline__ void operator()(const f32x4 (&acc)[2][2][4][2], const Unit& u, int wr, int wc, int fr, int fq) const {
        const int row0 = u.pm * BM + wr * 64 + fr; int colt = u.pn * BM; bf16_t* base = O;
        float sc = 1.f; if (split_cols) { const int t = colt / split_cols; base += (size_t)t * split_stride; colt -= t * split_cols; if (t == 0) sc = scale0; }
        const int col0 = colt + wc * 32 + 8 * fq, bcol0 = u.pn * BM + wc * 32 + 8 * fq;
        f32x4 bv[2][2];
#pragma unroll
        for (int bj = 0; bj < 2; ++bj)
#pragma unroll
            for (int n = 0; n < 2; ++n) bv[bj][n] = bias ? *(const f32x4*)(bias + bcol0 + bj * HALF + 4 * n) : (f32x4){0.f, 0.f, 0.f, 0.f};
#pragma unroll
        for (int ai = 0; ai < 2; ++ai)
#pragma unroll
            for (int m = 0; m < 4; ++m) { bf16_t* rowp = base + (size_t)(row0 + ai * HALF + m * 16) * ldc + col0;
#pragma unroll
                for (int bj = 0; bj < 2; ++bj) { f32x4 v0 = acc[ai][bj][m][0] + bv[bj][0], v1 = acc[ai][bj][m][1] + bv[bj][1];
                    if (ACT == 1) { f32x2 a = gelu_pk((f32x2){v0[0], v0[1]}), b = gelu_pk((f32x2){v0[2], v0[3]}), c = gelu_pk((f32x2){v1[0], v1[1]}), d = gelu_pk((f32x2){v1[2], v1[3]});
                        v0 = (f32x4){a.x, a.y, b.x, b.y}; v1 = (f32x4){c.x, c.y, d.x, d.y}; }
                    if (ACT == 2) { v0 = __builtin_elementwise_max(v0, (f32x4){0.f, 0.f, 0.f, 0.f}); v1 = __builtin_elementwise_max(v1, (f32x4){0.f, 0.f, 0.f, 0.f}); v0 = v0 * v0; v1 = v1 * v1; }
                    v0 = v0 * sc; v1 = v1 * sc; u32x4 w; w.x = cvt_pk_bf16(v0[0], v0[1]); w.y = cvt_pk_bf16(v0[2], v0[3]); w.z = cvt_pk_bf16(v1[0], v1[1]); w.w = cvt_pk_bf16(v1[2], v1[3]);
                    *(u32x4*)(rowp + bj * HALF) = w; } }
    }
};
template <class Epi, class Sched, bool ALIGN_EPI = false, bool SP2 = false>
__device__ __forceinline__ void gemm_phase(PG8_LAS unsigned char* lds, const Gemm g, const Sched& S, const Epi& E) {
    const int tid = opaque_tid(), wid = __builtin_amdgcn_readfirstlane(tid >> 6), lane = tid & 63, wr = wid >> 2, wc = wid & 3, fr = lane & 15, fq = lane >> 4;
    const int K = g.K, nt = K / BK;
    unsigned voffA[2], voffB[2];
#pragma unroll
    for (int i = 0; i < 2; ++i) { int R, C; stage_rc(tid * 16 + i * 8192, R, C); const int Rb = Epi::PERM ? ((R & ~31) + perm32(R & 31)) : R;
        voffA[i] = (unsigned)(R * K + C) * 2u; voffB[i] = (unsigned)(Rb * K + C) * 2u; }
    const size_t kstep = (size_t)(BK * 2);
    const size_t hstep = (size_t)HALF * K * 2;
    const size_t tstep = 2 * hstep;
    const unsigned ldsw = (unsigned)wid * 1024u;
    const int aoff = lds_byte(wr * 64 + fr, fq * 8), boff = lds_byte(wc * 32 + fr, fq * 8);
#define PG8_SA(b, h) (((b) * 2 + (h)) * HTB)
#define PG8_SB(b, h) ((4 + (b) * 2 + (h)) * HTB)
#define PG8_STAGE(bufoff, gbase, voff) do { _Pragma("unroll") for (int _i = 0; _i < 2; ++_i) \
        __builtin_amdgcn_global_load_lds((const unsigned*)((const char*)(gbase) + (voff)[_i]), (PG8_LAS unsigned*)(lds + (bufoff) + ldsw + _i * 8192), 16, 0, 0); } while (0)
#define PG8_LDA(dst, b, h) do { _Pragma("unroll") for (int m = 0; m < 4; ++m) _Pragma("unroll") for (int k = 0; k < 2; ++k) dst[m][k] = *(const PG8_LAS bf16x8*)(lds + PG8_SA(b, h) + aoff + m * 2048 + k * 1024); } while (0)
#define PG8_LDB(dst, b, h) do { _Pragma("unroll") for (int n = 0; n < 2; ++n) _Pragma("unroll") for (int k = 0; k < 2; ++k) dst[n][k] = *(const PG8_LAS bf16x8*)(lds + PG8_SB(b, h) + boff + n * 2048 + k * 1024); } while (0)
#define PG8_MMA(ai, bj, At, Bt) do { __builtin_amdgcn_s_setprio(1); _Pragma("unroll") for (int m = 0; m < 4; ++m) _Pragma("unroll") for (int n = 0; n < 2; ++n) _Pragma("unroll") for (int k = 0; k < 2; ++k) \
        acc[ai][bj][m][n] = __builtin_amdgcn_mfma_f32_16x16x32_bf16(Bt[n][k], At[m][k], acc[ai][bj][m][n], 0, 0, 0); __builtin_amdgcn_s_setprio(0); } while (0)
#define PG8_WAIT_V(n) asm volatile("s_waitcnt vmcnt(" #n ")" ::: "memory")
#define PG8_WAIT_L(n) asm volatile("s_waitcnt lgkmcnt(" #n ")" ::: "memory")
#define PG8_BAR __builtin_amdgcn_s_barrier()
#define PG8_SCHED __builtin_amdgcn_sched_barrier(0)
    Unit cur, nxt; int ui = 0;
    if (!S.next(0, cur)) return;
    f32x4 acc[2][2][4][2];
#pragma unroll
    for (int a = 0; a < 2; ++a)
#pragma unroll
        for (int b = 0; b < 2; ++b)
#pragma unroll
            for (int m = 0; m < 4; ++m)
#pragma unroll
                for (int n = 0; n < 2; ++n) acc[a][b][m][n] = (f32x4){0.f, 0.f, 0.f, 0.f};
    bf16x8 At[4][2], B0[2][2], B1[2][2];
    const char* cA = (const char*)g.A + (size_t)cur.pm * tstep; const char* cB = (const char*)g.Bt + (size_t)cur.pn * tstep;
    S.a_ready(cur);
    if constexpr (SP2) {
        PG8_STAGE(PG8_SB(0, 0), cB, voffB); PG8_STAGE(PG8_SB(0, 1), cB + hstep, voffB); PG8_STAGE(PG8_SA(0, 0), cA, voffA); PG8_STAGE(PG8_SA(0, 1), cA + hstep, voffA);
        if (wr == 1) PG8_BAR;
        PG8_WAIT_V(2); PG8_BAR;
        PG8_STAGE(PG8_SB(1, 0), cB + kstep, voffB); PG8_STAGE(PG8_SA(1, 0), cA + kstep, voffA); PG8_STAGE(PG8_SB(1, 1), cB + hstep + kstep, voffB);
        PG8_WAIT_V(6); PG8_BAR;
    } else {
        PG8_STAGE(PG8_SB(0, 0), cB, voffB); PG8_STAGE(PG8_SA(0, 0), cA, voffA); PG8_STAGE(PG8_SB(0, 1), cB + hstep, voffB); PG8_STAGE(PG8_SA(0, 1), cA + hstep, voffA);
        if (wr == 1) PG8_BAR;
        PG8_WAIT_V(4); PG8_BAR;
        PG8_STAGE(PG8_SB(1, 0), cB + kstep, voffB); PG8_STAGE(PG8_SA(1, 0), cA + kstep, voffA); PG8_STAGE(PG8_SB(1, 1), cB + hstep + kstep, voffB);
        PG8_WAIT_V(6); PG8_BAR;
    }
    for (;;) {
        const bool has_next = S.next(ui + 1, nxt);
        const char* nA = has_next ? (const char*)g.A + (size_t)nxt.pm * tstep : cA; const char* nB = has_next ? (const char*)g.Bt + (size_t)nxt.pn * tstep : cB;
        for (int t = 0; t < nt; t += 2) {
            const bool last = (t == nt - 2);
            const char* a1 = cA + (size_t)(t + 1) * kstep;
            const char* a2 = last ? nA : cA + (size_t)(t + 2) * kstep; const char* b2 = last ? nB : cB + (size_t)(t + 2) * kstep;
            const char* a3 = a2 + kstep; const char* b3 = b2 + kstep;
            if (last && has_next) S.a_ready(nxt);
            if constexpr (SP2) {
            PG8_LDB(B0, 0, 0); PG8_LDB(B1, 0, 1); PG8_SCHED; PG8_LDA(At, 0, 0); PG8_STAGE(PG8_SA(1, 1), a1 + hstep, voffA);
            PG8_WAIT_V(8); PG8_WAIT_L(0); PG8_BAR; PG8_MMA(0, 0, At, B0); PG8_MMA(0, 1, At, B1); PG8_BAR; PG8_SCHED;
            PG8_LDA(At, 0, 1); PG8_STAGE(PG8_SB(0, 0), b2, voffB); PG8_STAGE(PG8_SB(0, 1), b2 + hstep, voffB); PG8_STAGE(PG8_SA(0, 0), a2, voffA);
            PG8_WAIT_V(8); PG8_WAIT_L(0); PG8_BAR; PG8_MMA(1, 0, At, B0); PG8_MMA(1, 1, At, B1); PG8_BAR; PG8_SCHED;
            PG8_LDB(B0, 1, 0); PG8_LDB(B1, 1, 1); PG8_SCHED; PG8_LDA(At, 1, 0); PG8_STAGE(PG8_SA(0, 1), a2 + hstep, voffA);
            PG8_WAIT_V(8); PG8_WAIT_L(0); PG8_BAR; PG8_MMA(0, 0, At, B0); PG8_MMA(0, 1, At, B1); PG8_BAR; PG8_SCHED;
            PG8_LDA(At, 1, 1); PG8_STAGE(PG8_SB(1, 0), b3, voffB); PG8_STAGE(PG8_SB(1, 1), b3 + hstep, voffB); PG8_STAGE(PG8_SA(1, 0), a3, voffA);
            PG8_WAIT_V(8); PG8_WAIT_L(0); PG8_BAR; PG8_MMA(1, 0, At, B0); PG8_MMA(1, 1, At, B1); PG8_BAR; PG8_SCHED;
            } else {
            PG8_LDB(B0, 0, 0); PG8_SCHED; PG8_LDA(At, 0, 0); PG8_STAGE(PG8_SA(1, 1), a1 + hstep, voffA);
            PG8_WAIT_L(8); PG8_BAR; PG8_WAIT_L(0); PG8_MMA(0, 0, At, B0); PG8_BAR; PG8_SCHED;
            PG8_LDB(B1, 0, 1); PG8_STAGE(PG8_SB(0, 0), b2, voffB);
            PG8_BAR; PG8_WAIT_L(0); PG8_MMA(0, 1, At, B1); PG8_BAR;
            PG8_LDA(At, 0, 1); PG8_STAGE(PG8_SA(0, 0), a2, voffA);
            PG8_BAR; PG8_WAIT_L(0); PG8_MMA(1, 0, At, B0); PG8_BAR; PG8_SCHED;
            PG8_STAGE(PG8_SB(0, 1), b2 + hstep, voffB);
            PG8_WAIT_V(6); PG8_BAR; PG8_MMA(1, 1, At, B1); PG8_BAR;
            PG8_LDB(B0, 1, 0); PG8_SCHED; PG8_LDA(At, 1, 0); PG8_STAGE(PG8_SA(0, 1), a2 + hstep, voffA);
            PG8_WAIT_L(8); PG8_BAR; PG8_WAIT_L(0); PG8_MMA(0, 0, At, B0); PG8_BAR; PG8_SCHED;
            PG8_LDB(B1, 1, 1); PG8_STAGE(PG8_SB(1, 0), b3, voffB);
            PG8_BAR; PG8_WAIT_L(0); PG8_MMA(0, 1, At, B1); PG8_BAR;
            PG8_LDA(At, 1, 1); PG8_STAGE(PG8_SA(1, 0), a3, voffA);
            PG8_BAR; PG8_WAIT_L(0); PG8_MMA(1, 0, At, B0); PG8_BAR; PG8_SCHED;
            PG8_STAGE(PG8_SB(1, 1), b3 + hstep, voffB);
            PG8_WAIT_V(6); PG8_BAR; PG8_MMA(1, 1, At, B1); PG8_BAR;
            }
        }
        if constexpr (ALIGN_EPI) { if (wr == 0) PG8_BAR; }
        if constexpr (!Epi::AFTER_DRAIN) { E(acc, cur, wr, wc, fr, fq); S.done(cur); }
        if (!has_next) break;
#pragma unroll
        for (int a = 0; a < 2; ++a)
#pragma unroll
            for (int b = 0; b < 2; ++b)
#pragma unroll
                for (int m = 0; m < 4; ++m)
#pragma unroll
                    for (int n = 0; n < 2; ++n) acc[a][b][m][n] = (f32x4){0.f, 0.f, 0.f, 0.f};
        cur = nxt; cA = nA; cB = nB; ++ui;
        if constexpr (ALIGN_EPI) { if (wr == 1) PG8_BAR; }
    }
    PG8_WAIT_V(0);
    if constexpr (!ALIGN_EPI) { if (wr == 0) PG8_BAR; }
    PG8_BAR;
    if constexpr (Epi::AFTER_DRAIN) { E.fused(acc, cur, wr, wc, fr, fq, lds, wid, lane); S.done(cur); }
#undef PG8_SA
#undef PG8_SB
#undef PG8_STAGE
#undef PG8_LDA
#undef PG8_LDB
#undef PG8_MMA
#undef PG8_WAIT_V
#undef PG8_WAIT_L
#undef PG8_BAR
#undef PG8_SCHED
}
typedef unsigned u32x2 __attribute__((ext_vector_type(2)));
constexpr float RMS_EPS_F = 1e-6f;
struct EpiResGate {
    static constexpr bool PERM = false, AFTER_DRAIN = false;
    const float* xin; float* xout; const float* gate;
    __device__ __forceinline__ void operator()(const f32x4 (&acc)[2][2][4][2], const Unit& u, int wr, int wc, int fr, int fq) const {
        const int b = u.pm >> 5;
        const int col0 = u.pn * BM + wc * 32 + 4 * fq;
        const float* gp = gate + (size_t)b * 6144 + col0;
        f32x4 gv[2][2];
#pragma unroll
        for (int bj = 0; bj < 2; ++bj)
#pragma unroll
            for (int n = 0; n < 2; ++n) gv[bj][n] = *(const f32x4*)(gp + bj * HALF + n * 16);
#pragma unroll
        for (int ai = 0; ai < 2; ++ai)
#pragma unroll
            for (int m = 0; m < 4; ++m) { const size_t off = (size_t)(u.pm * BM + ai * HALF + wr * 64 + m * 16 + fr) * 1024 + col0;
#pragma unroll
                for (int bj = 0; bj < 2; ++bj)
#pragma unroll
                    for (int n = 0; n < 2; ++n) { const f32x4 xi = *(const f32x4*)(xin + off + bj * HALF + n * 16);
                        *(f32x4*)(xout + off + bj * HALF + n * 16) = xi + gv[bj][n] * acc[ai][bj][m][n]; } }
    }
};
struct EpiQN {
    static constexpr bool PERM = false, AFTER_DRAIN = false;
    bf16_t* Q; const float* gn_nope; PG8_LAS float* P;
    __device__ __forceinline__ void operator()(const f32x4 (&acc)[2][2][4][2], const Unit& u, int wr_, int wc_, int fr_, int fq_) const {
        int tx = threadIdx.x; asm volatile("" : "+v"(tx));
        const int fr = tx & 15, fq = (tx >> 4) & 3, wc = (tx >> 6) & 3, wr = tx >> 8;
        const int b = u.pm >> 5, s0 = (u.pm & 31) * BM;
#pragma unroll
            for (int ai = 0; ai < 2; ++ai)
#pragma unroll
                for (int m = 0; m < 4; ++m)
#pragma unroll
                    for (int bj = 0; bj < 2; ++bj) { float s = 0.f;
#pragma unroll
                        for (int n = 0; n < 2; ++n) { const f32x4 x = acc[ai][bj][m][n]; s += (x[0] * x[0] + x[1] * x[1]) + (x[2] * x[2] + x[3] * x[3]); }
                        s += __shfl_xor(s, 16); s += __shfl_xor(s, 32);
                        if (fq == 0) P[((ai * HALF + wr * 64 + m * 16 + fr) * 2 + bj) * 4 + wc] = s; }
            asm volatile("s_waitcnt lgkmcnt(0)" ::: "memory"); __builtin_amdgcn_s_barrier(); asm volatile("" ::: "memory");
#pragma unroll
            for (int ai = 0; ai < 2; ++ai)
#pragma unroll
                for (int m = 0; m < 4; ++m) { int rl = ai * HALF + wr * 64 + m * 16 + fr; asm volatile("" : "+v"(rl));
#pragma unroll
                    for (int bj = 0; bj < 2; ++bj) { const f32x4 pp = *(const PG8_LAS f32x4*)(P + (rl * 2 + bj) * 4);
                        const float rr = 1.0f / sqrtf(((pp[0] + pp[1]) + (pp[2] + pp[3])) * (1.0f / 128.0f) + RMS_EPS_F);
                        const int head = 2 * u.pn + bj;
                        const unsigned qoff = (unsigned)(((b * 4 + head) * 8192 + s0 + rl) * 192 + wc * 32 + 4 * fq);
#pragma unroll
                        for (int n = 0; n < 2; ++n) { const f32x4 g = *(const f32x4*)(gn_nope + wc * 32 + n * 16 + 4 * fq);
                            const f32x4 v = acc[ai][bj][m][n] * rr * g; u32x2 w; w.x = cvt_pk_bf16(v[0], v[1]); w.y = cvt_pk_bf16(v[2], v[3]);
                            *(u32x2*)(Q + qoff + n * 16) = w; } }
                    asm volatile("" ::: "memory"); }
    }
};
struct EpiQR {
    static constexpr bool PERM = false, AFTER_DRAIN = false;
    bf16_t* Q; const float* gn_rope; const float* cosT; const float* sinT;
    __device__ __forceinline__ void operator()(const f32x4 (&acc)[2][2][4][2], const Unit& u, int wr_, int wc_, int fr_, int fq_) const {
        int tx = threadIdx.x; asm volatile("" : "+v"(tx));
        const int fr = tx & 15, fq = (tx >> 4) & 3, wc = (tx >> 6) & 3, wr = tx >> 8;
        const int b = u.pm >> 5, s0 = (u.pm & 31) * BM;
#pragma unroll
            for (int ai = 0; ai < 2; ++ai)
#pragma unroll
                for (int m = 0; m < 4; ++m) { int rl = ai * HALF + wr * 64 + m * 16 + fr; asm volatile("" : "+v"(rl)); float s = 0.f;
#pragma unroll
                    for (int bj = 0; bj < 2; ++bj)
#pragma unroll
                        for (int n = 0; n < 2; ++n) { const f32x4 x = acc[ai][bj][m][n]; s += (x[0] * x[0] + x[1] * x[1]) + (x[2] * x[2] + x[3] * x[3]); }
                    s += __shfl_xor(s, 16); s += __shfl_xor(s, 32);
                    const float rr = 1.0f / sqrtf(s * (1.0f / 64.0f) + RMS_EPS_F);
                    const size_t t = (size_t)u.pm * BM + rl;
                    bf16_t* qrow = Q + ((size_t)(b * 4 + wc) * 8192 + s0 + rl) * 192 + 128;
#pragma unroll
                    for (int n = 0; n < 2; ++n) { const int j0 = n * 16 + 4 * fq;
                        const f32x4 c4 = *(const f32x4*)(cosT + t * 32 + j0), s4 = *(const f32x4*)(sinT + t * 32 + j0);
                        const f32x4 g1 = *(const f32x4*)(gn_rope + j0), g2 = *(const f32x4*)(gn_rope + 32 + j0);
                        const f32x4 y1 = acc[ai][0][m][n] * rr * g1, y2 = acc[ai][1][m][n] * rr * g2;
                        const f32x4 o1 = y1 * c4 - y2 * s4, o2 = y2 * c4 + y1 * s4;
                        u32x2 w1, w2; w1.x = cvt_pk_bf16(o1[0], o1[1]); w1.y = cvt_pk_bf16(o1[2], o1[3]); w2.x = cvt_pk_bf16(o2[0], o2[1]); w2.y = cvt_pk_bf16(o2[2], o2[3]);
                        *(u32x2*)(qrow + j0) = w1; *(u32x2*)(qrow + 32 + j0) = w2; }
                    asm volatile("" ::: "memory"); }
    }
};
struct EpiKV {
    static constexpr bool PERM = false, AFTER_DRAIN = false;
    bf16_t* Kb; bf16_t* Vb; const float* gn_k; PG8_LAS float* P;
    __device__ __forceinline__ void operator()(const f32x4 (&acc)[2][2][4][2], const Unit& u, int wr_, int wc_, int fr_, int fq_) const {
        int tx = threadIdx.x; asm volatile("" : "+v"(tx));
        const int fr = tx & 15, fq = (tx >> 4) & 3, wc = (tx >> 6) & 3, wr = tx >> 8;
        const int b = u.pm >> 5, s0 = (u.pm & 31) * BM;
#pragma unroll
        for (int ai = 0; ai < 2; ++ai)
#pragma unroll
            for (int m = 0; m < 4; ++m) { float s = 0.f;
#pragma unroll
                for (int n = 0; n < 2; ++n) { const f32x4 x = acc[ai][0][m][n]; s += (x[0] * x[0] + x[1] * x[1]) + (x[2] * x[2] + x[3] * x[3]); }
                s += __shfl_xor(s, 16); s += __shfl_xor(s, 32);
                if (fq == 0) P[(ai * HALF + wr * 64 + m * 16 + fr) * 4 + wc] = s; }
        asm volatile("s_waitcnt lgkmcnt(0)" ::: "memory"); __builtin_amdgcn_s_barrier(); asm volatile("" ::: "memory");
#pragma unroll
        for (int ai = 0; ai < 2; ++ai)
#pragma unroll
            for (int m = 0; m < 4; ++m) { int rl = ai * HALF + wr * 64 + m * 16 + fr; asm volatile("" : "+v"(rl));
                const f32x4 pp = *(const PG8_LAS f32x4*)(P + rl * 4);
                const float rr = 1.0f / sqrtf(((pp[0] + pp[1]) + (pp[2] + pp[3])) * (1.0f / 128.0f) + RMS_EPS_F);
                const size_t tok = (size_t)(b * 4 + u.pn) * 8192 + s0 + rl;
                bf16_t* krow = Kb + tok * 192; bf16_t* vrow = Vb + tok * 128;
#pragma unroll
                for (int n = 0; n < 2; ++n) { const int d0 = wc * 32 + n * 16 + 4 * fq; const f32x4 g = *(const f32x4*)(gn_k + d0);
                    const f32x4 kx = acc[ai][0][m][n] * rr * g, vx = acc[ai][1][m][n];
                    u32x2 w1, w2; w1.x = cvt_pk_bf16(kx[0], kx[1]); w1.y = cvt_pk_bf16(kx[2], kx[3]); w2.x = cvt_pk_bf16(vx[0], vx[1]); w2.y = cvt_pk_bf16(vx[2], vx[3]);
                    *(u32x2*)(krow + d0) = w1; *(u32x2*)(vrow + d0) = w2; }
                asm volatile("" ::: "memory"); }
    }
};
}
namespace att {
using bf16 = __hip_bfloat16;
typedef short bf16x8 __attribute__((ext_vector_type(8)));
typedef short s16x4 __attribute__((ext_vector_type(4)));
typedef float f32x16 __attribute__((ext_vector_type(16)));
typedef float f32x4 __attribute__((ext_vector_type(4)));
typedef unsigned u32x4 __attribute__((ext_vector_type(4)));
constexpr int DQ = 192, DV = 128, LDO = 1024, SEQL = 8192;
constexpr float SCALE = 0.07216878364870322f;
constexpr float THR = 8.f;
constexpr int NW = 8, QBLK = 32, KVBLK = 64, QB = NW * QBLK;
constexpr int SHM_V = KVBLK * DV * 2, SHM_K = KVBLK * DQ * 2;
constexpr int KPITCH = DQ * 2;
constexpr int LDS_NEED = 2 * SHM_V + 2 * SHM_K + NW * 64 * 4;
#define KSWZ(row, colB) ((row) * 384 + ((colB) ^ (((row) & 7) << 4)))
#define SBAR() __builtin_amdgcn_sched_barrier(0)
__device__ __forceinline__ int v_st(int k, int c) { const int kk = (k & ~0xC) | ((k & 4) << 1) | ((k & 8) >> 1); return ((kk >> 3) * 4 + (c >> 5)) * 512 + ((kk & 7) * 32 + (c & 31)) * 2; }
__device__ __forceinline__ int v_rd_base(int lane) { return ((lane & 3) << 3) | (((lane >> 2) & 3) << 6) | (((lane >> 4) & 1) << 5) | (((lane >> 5) & 1) << 8); }
constexpr int v_rd_off(int d0, int ks, int half) { return d0 * 512 + ks * 4096 + half * 2048; }
__device__ __forceinline__ int crow(int r, int hi) { return (r & 3) + 8 * (r >> 2) + 4 * hi; }
__device__ __forceinline__ unsigned cvtpk(float lo, float hi) { unsigned r; asm volatile("v_cvt_pk_bf16_f32 %0, %1, %2" : "=v"(r) : "v"(lo), "v"(hi)); return r; }
__device__ __forceinline__ bf16x8 load8(const bf16* p) { return *reinterpret_cast<const bf16x8*>(p); }
__device__ __forceinline__ void mask_tile(f32x16& p0, f32x16& p1, int dq) {
    const float NEG = -__builtin_inff();
#pragma unroll
    for (int r = 0; r < 16; ++r) {
        const int c = (r & 3) + 8 * (r >> 2);
        if (dq - c < 0) p0[r] = NEG;
        if (dq - c - 32 < 0) p1[r] = NEG;
    }
}
__device__ __forceinline__ void partialSM(f32x16& p0, f32x16& p1, float& m_reg, float& mn, float& alpha) {
    float pmax = p0[0]; for (int r = 1; r < 16; ++r) pmax = fmaxf(pmax, p0[r]); for (int r = 0; r < 16; ++r) pmax = fmaxf(pmax, p1[r]);
    { auto rr = __builtin_amdgcn_permlane32_swap(__float_as_uint(pmax), __float_as_uint(pmax), false, false);
      pmax = fmaxf(__uint_as_float(rr[0]), __uint_as_float(rr[1])); }
    constexpr float C2 = 1.4426950408889634f * SCALE;
    if (__builtin_expect(__all((pmax - m_reg) * SCALE <= THR), 1)) { mn = m_reg; alpha = 1.f; }
    else { mn = fmaxf(m_reg, pmax); alpha = __builtin_amdgcn_exp2f((m_reg - mn) * C2); m_reg = mn; }
    const float mnL = -mn * C2;
    for (int r = 0; r < 16; ++r) p0[r] = fmaf(p0[r], C2, mnL); for (int r = 0; r < 16; ++r) p1[r] = fmaf(p1[r], C2, mnL);
    for (int r = 0; r < 16; ++r) p0[r] = __builtin_amdgcn_exp2f(p0[r]);
}
__device__ __forceinline__ void finishSM(f32x16& p0, f32x16& p1, float alpha, float& l_reg, bf16x8& pa0, bf16x8& pa1, bf16x8& pa2, bf16x8& pa3) {
    for (int r = 0; r < 16; ++r) p1[r] = __builtin_amdgcn_exp2f(p1[r]);
    float ps = 0; for (int r = 0; r < 16; ++r) ps += p0[r]; for (int r = 0; r < 16; ++r) ps += p1[r];
    { auto rr = __builtin_amdgcn_permlane32_swap(__float_as_uint(ps), __float_as_uint(ps), false, false);
      ps = __uint_as_float(rr[0]) + __uint_as_float(rr[1]); }
    l_reg = l_reg * alpha + ps;
#define PK4(P, B_, OUT) do { unsigned a0 = cvtpk(P[B_+0], P[B_+1]), a1 = cvtpk(P[B_+2], P[B_+3]);                          \
        unsigned b0 = cvtpk(P[B_+4], P[B_+5]), b1 = cvtpk(P[B_+6], P[B_+7]);                                             \
        auto r0 = __builtin_amdgcn_permlane32_swap(a0, b0, false, false); auto r1 = __builtin_amdgcn_permlane32_swap(a1, b1, false, false); \
        u32x4 w = {r0[0], r1[0], r0[1], r1[1]}; OUT = *reinterpret_cast<bf16x8*>(&w); } while (0)
    PK4(p0, 0, pa0); PK4(p0, 8, pa1); PK4(p1, 0, pa2); PK4(p1, 8, pa3);
#undef PK4
}
template <int KB>
__device__ __forceinline__ void qkt(f32x16& p0, f32x16& p1, const char* K_lds, int r32, int hi, const bf16x8* qr) {
    p0 = f32x16{}; p1 = f32x16{};
    const char* kb[4];
#pragma unroll
    for (int dd = 0; dd < 4; ++dd) kb[dd] = K_lds + KB * SHM_K + KSWZ(r32, (dd * 16 + hi * 8) * 2);
#pragma unroll
    for (int d0 = 0; d0 < 12; ++d0) { const char* a = kb[d0 & 3] + (d0 >> 2) * 128;
        bf16x8 b0 = *reinterpret_cast<const bf16x8*>(a);
        bf16x8 b1 = *reinterpret_cast<const bf16x8*>(a + 32 * KPITCH);
        p0 = __builtin_amdgcn_mfma_f32_32x32x16_bf16(b0, qr[d0], p0, 0, 0, 0);
        p1 = __builtin_amdgcn_mfma_f32_32x32x16_bf16(b1, qr[d0], p1, 0, 0, 0); }
}
template <int VB>
__device__ __forceinline__ void pv_tile(f32x16* o, int vb0, bf16x8 pa0, bf16x8 pa1, bf16x8 pa2, bf16x8 pa3) {
#define TRRD(dst, off) asm volatile("ds_read_b64_tr_b16 %0, %1 offset:%2" : "=&v"(dst) : "v"(vb0), "i"(off) : "memory")
#define PV_D0(d0) do { s16x4 l0, l1, l2, l3, h0, h1, h2, h3; constexpr int b_ = VB * SHM_V + v_rd_off(d0, 0, 0);     \
        TRRD(l0, b_); TRRD(h0, b_ + 2048); TRRD(l1, b_ + 4096); TRRD(h1, b_ + 6144); TRRD(l2, b_ + 8192); TRRD(h2, b_ + 10240); TRRD(l3, b_ + 12288); TRRD(h3, b_ + 14336); \
        asm volatile("s_waitcnt lgkmcnt(0)" ::: "memory"); SBAR();   \
        o[d0] = __builtin_amdgcn_mfma_f32_32x32x16_bf16(pa0, (bf16x8){l0[0], l0[1], l0[2], l0[3], h0[0], h0[1], h0[2], h0[3]}, o[d0], 0, 0, 0);   \
        o[d0] = __builtin_amdgcn_mfma_f32_32x32x16_bf16(pa1, (bf16x8){l1[0], l1[1], l1[2], l1[3], h1[0], h1[1], h1[2], h1[3]}, o[d0], 0, 0, 0);   \
        o[d0] = __builtin_amdgcn_mfma_f32_32x32x16_bf16(pa2, (bf16x8){l2[0], l2[1], l2[2], l2[3], h2[0], h2[1], h2[2], h2[3]}, o[d0], 0, 0, 0);   \
        o[d0] = __builtin_amdgcn_mfma_f32_32x32x16_bf16(pa3, (bf16x8){l3[0], l3[1], l3[2], l3[3], h3[0], h3[1], h3[2], h3[3]}, o[d0], 0, 0, 0); } while (0)
    PV_D0(0); PV_D0(1); PV_D0(2); PV_D0(3);
#undef PV_D0
#undef TRRD
}
struct BlockRef { const bf16* Q; const bf16* K; const bf16* V; bf16* O; int P0; };
struct Stage { bf16x8 st_v0, st_v1, st_k0, st_k1, st_k2; };
#define VMW() asm volatile("s_waitcnt vmcnt(0)" ::: "memory")
#define SLOAD_H(Kp, Vp, k0) do { const bf16* vt_ = (Vp) + (size_t)(k0) * DV; const bf16* kt_ = (Kp) + (size_t)(k0) * DQ;     \
                         S.st_v0 = load8(vt_ + voff); S.st_v1 = load8(vt_ + voff + 32 * DV);              \
                         S.st_k0 = load8(kt_ + koff); S.st_k1 = load8(kt_ + koff + 64); S.st_k2 = load8(kt_ + koff + 128); } while (0)
#define SWRITE_HK(bf) do { *(bf16x8*)(K_lds + (bf) * SHM_K + kws) = S.st_k0; *(bf16x8*)(K_lds + (bf) * SHM_K + kws + 128) = S.st_k1; *(bf16x8*)(K_lds + (bf) * SHM_K + kws + 256) = S.st_k2; } while (0)
#define SWRITE_HV(bf) do { *(bf16x8*)(V_lds + (bf) * SHM_V + vst0) = S.st_v0; *(bf16x8*)(V_lds + (bf) * SHM_V + vst1) = S.st_v1; } while (0)
#define SWRITE_H(bf) do { SWRITE_HV(bf); SWRITE_HK(bf); } while (0)
__device__ __forceinline__ void attn_block(const BlockRef& cur, char* lds) {
    const int tid = opaque_tid(), wid = __builtin_amdgcn_readfirstlane(tid >> 6), lane = tid & 63, r32 = lane & 31, hi = lane >> 5;
    const int NT = cur.P0 / KVBLK + QB / KVBLK;
    const int qlo = cur.P0 + wid * QBLK, qm = qlo + r32 - 4 * hi;
    char* V_lds = lds; char* K_lds = lds + 2 * SHM_V;
    float* ws = (float*)(lds + 2 * SHM_V + 2 * SHM_K) + wid * 64; float* li_l = ws, * al_l = ws + 32;
    float m_reg = -1e30f, l_reg = 0; f32x16 o[4] = {};
    const int sr = tid >> 4, sc = (tid & 15) * 8, vst0 = v_st(sr, sc), vst1 = v_st(32 + sr, sc);
    const int kr = tid >> 3, kc = tid & 7, kws = KSWZ(kr, kc * 16);
    const unsigned voff = (unsigned)(sr * DV + sc), koff = (unsigned)(kr * DQ + kc * 8);
    const int vb0 = (int)(uintptr_t)V_lds + v_rd_base(lane);
    const bf16* Kh = cur.K; const bf16* Vh = cur.V;
    Stage S; bf16x8 qr[12];
#pragma unroll
    for (int d0 = 0; d0 < 12; ++d0) qr[d0] = load8(cur.Q + (size_t)(wid * QBLK + r32) * DQ + d0 * 16 + hi * 8);
    SLOAD_H(Kh, Vh, 0); VMW(); SWRITE_H(0);
    __syncthreads();
#define RESC(a) do { if (__any((a) < 1.f)) { if (hi == 0) al_l[r32] = (a); asm volatile("s_waitcnt lgkmcnt(0)" ::: "memory");              \
                     for (int d_ = 0; d_ < 4; ++d_) for (int r = 0; r < 16; ++r) o[d_][r] *= al_l[crow(r, hi)]; } } while (0)
#define KBASE(t) ((t) * KVBLK)
#define MASKT(P0_, P1_, t) do { const int kb_ = KBASE(t); if (kb_ + KVBLK - 1 > qlo) mask_tile(P0_, P1_, qm - kb_); } while (0)
    f32x16 p0, p1; float mn, al; bf16x8 pa0, pa1, pa2, pa3;
#define STEP(t, BUF) do {                                                                                                     \
        qkt<BUF>(p0, p1, K_lds, r32, hi, qr); SBAR();                                                                         \
        if ((t) + 1 < NT) { SLOAD_H(Kh, Vh, KBASE((t) + 1)); SBAR(); }                                                        \
        MASKT(p0, p1, (t)); partialSM(p0, p1, m_reg, mn, al);                                                                 \
        RESC(al);                                                                                                             \
        finishSM(p0, p1, al, l_reg, pa0, pa1, pa2, pa3); SBAR();                                                              \
        pv_tile<BUF>(o, vb0, pa0, pa1, pa2, pa3); SBAR();                                                                     \
        if ((t) + 1 < NT) { VMW(); SWRITE_H(1 - BUF); }                                                                       \
        __syncthreads(); } while (0)
    for (int t = 0; t < NT; t += 2) { STEP(t, 0); STEP(t + 1, 1); }
    if (hi == 0) li_l[r32] = l_reg; asm volatile("s_waitcnt lgkmcnt(0)" ::: "memory");
    float rli[16];
#pragma unroll
    for (int r = 0; r < 16; ++r) rli[r] = __builtin_amdgcn_rcpf(li_l[crow(r, hi)]);
    bf16* Ow = cur.O + (size_t)(wid * QBLK) * LDO;
#pragma unroll
    for (int r = 0; r < 16; ++r) { const int orow = crow(r, hi);
#pragma unroll
        for (int d0 = 0; d0 < 4; ++d0) { const float v = o[d0][r] * rli[r];
            const float vn = __shfl_xor(v, 1);
            if ((r32 & 1) == 0) *(unsigned*)(Ow + (size_t)orow * LDO + d0 * 32 + r32) = cvtpk(v, vn); } }
    __syncthreads();
#undef RESC
#undef KBASE
#undef MASKT
#undef STEP
}
#undef VMW
#undef SLOAD_H
#undef SWRITE_HK
#undef SWRITE_HV
#undef SWRITE_H
struct Item { int bh, qb0, qb1; };
__device__ __forceinline__ Item decode(int L) { Item it; const int xcd = L & 7, k = L >> 3; it.bh = (k >> 4) * 8 + xcd; const int x = k & 15; it.qb0 = x; it.qb1 = 31 - x; return it; }
__device__ __forceinline__ BlockRef mkref(const Item& it, int pass, const bf16* Q, const bf16* K, const bf16* V, bf16* mixed) {
    const int qb = pass ? it.qb1 : it.qb0; BlockRef r;
    r.Q = Q + ((size_t)it.bh * SEQL + (size_t)qb * QB) * DQ; r.K = K + (size_t)it.bh * SEQL * DQ; r.V = V + (size_t)it.bh * SEQL * DV;
    r.O = mixed + ((size_t)(it.bh >> 2) * SEQL + (size_t)qb * QB) * LDO + 512 + (it.bh & 3) * 128; r.P0 = qb * QB;
    return r;
}
__device__ __forceinline__ void attn_phase(char* lds, const bf16* Q, const bf16* K, const bf16* V, bf16* mixed) {
    for (int L = blockIdx.x; L < 256; L += gridDim.x) {
        const Item it = decode(L);
        attn_block(mkref(it, 0, Q, K, V, mixed), lds);
        attn_block(mkref(it, 1, Q, K, V, mixed), lds);
    }
}
#undef KSWZ
#undef SBAR
}
namespace mk {
typedef unsigned short bf16_t;
typedef short bf16x8 __attribute__((ext_vector_type(8)));
typedef float f32x4 __attribute__((ext_vector_type(4)));
typedef float f32x2 __attribute__((ext_vector_type(2)));
typedef float f32x16 __attribute__((ext_vector_type(16)));
typedef unsigned u32x2 __attribute__((ext_vector_type(2)));
typedef unsigned u32x4 __attribute__((ext_vector_type(4)));
#define LAS __attribute__((address_space(3)))
constexpr int NB = 4, SEQ = 8192, T = NB * SEQ, DM = 1024, DEPTH = 2, DFF = 4096, NIN = 2048, NMOD = 6 * DM;
constexpr float EPS = 1e-6f;
constexpr size_t MiB = 1u << 20;
constexpr size_t W_IN = 0, W_Q = 4 * MiB, W_KV = W_Q + 384 * 1024, W_O = W_KV + 256 * 1024, W_1 = W_O + 2 * MiB, W_2 = W_1 + 8 * MiB, W_LAYER = 23 * MiB;
static_assert(W_2 + 8 * MiB <= W_LAYER, "weights");
constexpr size_t WS_W = 0, WS_MOD = 46 * MiB, WS_COS = 47 * MiB, WS_SIN = 51 * MiB, WS_HN = 55 * MiB, WS_QN = 119 * MiB, WS_KVN = 135 * MiB,
                 WS_GST = 143 * MiB, WS_GDV = 207 * MiB, WS_R = 208 * MiB, WS_END = 464 * MiB;
constexpr size_t R_PROJ = 0, R_Q = 128 * MiB, R_K = 176 * MiB, R_V = 224 * MiB;
constexpr int LDS_BYTES = 139264;
constexpr int EPI_OFF = 131072;

__device__ __forceinline__ float bf2f(unsigned short v) { return __uint_as_float((unsigned)v << 16); }
__device__ __forceinline__ unsigned f2bf(float f) { unsigned u = __float_as_uint(f); return (u + 0x7fffu + ((u >> 16) & 1u)) >> 16; }
__device__ __forceinline__ unsigned pk2(float lo, float hi) { return f2bf(lo) | (f2bf(hi) << 16); }
__device__ __forceinline__ float wave_sum(float v) {
#pragma unroll
    for (int o = 1; o < 64; o <<= 1) v += __shfl_xor(v, o);
    return v;
}
__device__ __forceinline__ float half_sum32(float v) {
#pragma unroll
    for (int o = 1; o < 32; o <<= 1) v += __shfl_xor(v, o);
    return v;
}
__device__ __forceinline__ int crow(int r, int hi) { return (r & 3) + 8 * (r >> 2) + 4 * hi; }

__device__ __forceinline__ int src_col(int map, int n) {
    if (map == 1) { if (n < 1536) return n; if (n < 1984) return n + 16; if (n < 2000) return n - 1984 + 1536; return -1; }
    if (map == 2) { if (n < 512) return (n >> 7) * 192 + (n & 127); const int c = n - 512, bj = c >> 7, hd = (c & 127) >> 5, w = c & 31; return hd * 192 + 128 + 32 * bj + w; }
    return n;
}
__device__ __forceinline__ void transpose_item(const float* W, int K, int N, int NP, bf16_t* WT, int map, LAS float* scr, int item, int lane) {
    const int nblk = NP / 32, kb = item / nblk, nb = item % nblk, k0 = 64 * kb, n0 = 32 * nb;
    const int sc = src_col(map, n0 + (lane & 31));
#pragma unroll 8
    for (int i = 0; i < 32; ++i) { const int kk = 2 * i + (lane >> 5); scr[kk * 33 + (lane & 31)] = sc >= 0 ? W[(size_t)(k0 + kk) * N + sc] : 0.f; }
    asm volatile("s_waitcnt lgkmcnt(0)" ::: "memory");
    const int c = lane & 7;
#pragma unroll
    for (int j = 0; j < 4; ++j) { const int n = (lane >> 3) + 8 * j; const LAS float* s = scr + (8 * c) * 33 + n;
        u32x4 o; o.x = pk2(s[0 * 33], s[1 * 33]); o.y = pk2(s[2 * 33], s[3 * 33]); o.z = pk2(s[4 * 33], s[5 * 33]); o.w = pk2(s[6 * 33], s[7 * 33]);
        *(u32x4*)(WT + (size_t)(n0 + n) * K + k0 + 8 * c) = o; }
    asm volatile("s_waitcnt lgkmcnt(0)" ::: "memory");
}
__device__ __forceinline__ void adaln_unit(int u, const float* c, const float* w_ada, const float* b_ada, float* mod, LAS float* lds) {
    const int tid = opaque_tid(), wave = tid >> 6, lane = tid & 63;
    const int l = u / 96, n0 = (u % 96) * 64;
    LAS float* sc = lds; LAS float* red = lds + 4096;
    for (int i = tid; i < 4096; i += 512) { const float v = c[i]; sc[i] = v / (1.0f + __expf(-v)); }
    __syncthreads();
    const float* wp = w_ada + (size_t)l * DM * NMOD + n0 + lane;
    float a0 = 0.f, a1 = 0.f, a2 = 0.f, a3 = 0.f;
#pragma unroll 8
    for (int k = wave * 128; k < wave * 128 + 128; ++k) { const float w = wp[(size_t)k * NMOD]; a0 += sc[k] * w; a1 += sc[1024 + k] * w; a2 += sc[2048 + k] * w; a3 += sc[3072 + k] * w; }
    red[(wave * 4 + 0) * 64 + lane] = a0; red[(wave * 4 + 1) * 64 + lane] = a1; red[(wave * 4 + 2) * 64 + lane] = a2; red[(wave * 4 + 3) * 64 + lane] = a3;
    __syncthreads();
    if (tid < 256) { const int b = tid >> 6; float s = b_ada[(size_t)l * NMOD + n0 + lane];
#pragma unroll
        for (int w = 0; w < 8; ++w) s += red[(w * 4 + b) * 64 + lane];
        mod[((size_t)l * 4 + b) * NMOD + n0 + lane] = s; }
    __syncthreads();
}
__device__ __forceinline__ void norm_rows(const float* xin, bf16_t* hn, const float* modl, int soff, int coff) {
    const int tid = opaque_tid(), lane = tid & 63, gw = blockIdx.x * 8 + (tid >> 6), NGW = gridDim.x * 8;
    for (int t = gw; t < T; t += NGW) {
        const f32x4* xr = (const f32x4*)(xin + (size_t)t * DM) + lane; f32x4 v[4]; float ss = 0.f;
#pragma unroll
        for (int j = 0; j < 4; ++j) { v[j] = xr[64 * j]; ss += (v[j][0] * v[j][0] + v[j][1] * v[j][1]) + (v[j][2] * v[j][2] + v[j][3] * v[j][3]); }
        const float rr = 1.0f / sqrtf(wave_sum(ss) * (1.0f / DM) + EPS);
        const float* mb = modl + (size_t)(t >> 13) * NMOD;
#pragma unroll
        for (int j = 0; j < 4; ++j) { const int col = 256 * j + 4 * lane;
            const f32x4 sc = *(const f32x4*)(mb + coff + col), sh = *(const f32x4*)(mb + soff + col);
            const f32x4 h = v[j] * rr * (sc + 1.0f) + sh;
            u32x2 w; w.x = pk2(h[0], h[1]); w.y = pk2(h[2], h[3]); *(u32x2*)(hn + (size_t)t * DM + col) = w; }
    }
}
__device__ __forceinline__ void prep_tokens(const bf16_t* proj, bf16_t* qn, bf16_t* kvn, bf16_t* Kb, const float* qa, const float* kva, const float* kr,
                                            const float* cosT, const float* sinT) {
    const int tid = opaque_tid(), lane = tid & 63, gw = blockIdx.x * 8 + (tid >> 6), NGW = gridDim.x * 8;
    for (int t = gw; t < T; t += NGW) {
        const bf16_t* pr = proj + (size_t)t * NIN;
        { const u32x2 w = *(const u32x2*)(pr + 1536 + 4 * lane);
          const float q0 = __uint_as_float(w.x << 16), q1 = __uint_as_float(w.x & 0xffff0000u), q2 = __uint_as_float(w.y << 16), q3 = __uint_as_float(w.y & 0xffff0000u);
          const float rr = 1.0f / sqrtf(wave_sum((q0 * q0 + q1 * q1) + (q2 * q2 + q3 * q3)) * (1.0f / 256.0f) + EPS);
          const f32x4 g = *(const f32x4*)(qa + 4 * lane);
          u32x2 o; o.x = pk2(q0 * rr * g[0], q1 * rr * g[1]); o.y = pk2(q2 * rr * g[2], q3 * rr * g[3]); *(u32x2*)(qn + (size_t)t * 256 + 4 * lane) = o; }
        { const unsigned w = *(const unsigned*)(pr + 1792 + 2 * lane);
          const float k0 = __uint_as_float(w << 16), k1 = __uint_as_float(w & 0xffff0000u);
          const float rr = 1.0f / sqrtf(wave_sum(k0 * k0 + k1 * k1) * (1.0f / 128.0f) + EPS);
          const f32x2 g = *(const f32x2*)(kva + 2 * lane);
          *(unsigned*)(kvn + (size_t)t * 128 + 2 * lane) = pk2(k0 * rr * g[0], k1 * rr * g[1]); }
        { float y = bf2f(pr[1920 + lane]);
          const float rr = 1.0f / sqrtf(wave_sum(y * y) * (1.0f / 64.0f) + EPS);
          y = y * rr * kr[lane];
          const float pn = __shfl_xor(y, 32); const int j = lane & 31;
          const float c = cosT[(size_t)t * 32 + j], s = sinT[(size_t)t * 32 + j];
          const float o = lane < 32 ? y * c - pn * s : y * c + pn * s;
          const bf16_t ob = (bf16_t)f2bf(o); const int b = t >> 13, sp = t & 8191;
#pragma unroll
          for (int h = 0; h < 4; ++h) Kb[((size_t)(b * 4 + h) * SEQ + sp) * 192 + 128 + lane] = ob; }
    }
}
constexpr int BP = 68;
__device__ __forceinline__ void gla_decay(LAS float* Bm, const bf16_t* proj, const float* wgu, const float* bg, size_t row0, int h) {
    const int tid = opaque_tid(), d = tid & 63, wv = tid >> 6;
    float w[16];
#pragma unroll
    for (int r = 0; r < 16; ++r) w[r] = wgu[r * 256 + h * 64 + d];
    const float bias = bg[h * 64 + d];
#pragma unroll
    for (int i = 0; i < 8; ++i) { const int t = wv + 8 * i; const bf16_t* ga = proj + (row0 + t) * NIN + 1984;
        const u32x4 g0 = *(const u32x4*)ga, g1 = *(const u32x4*)(ga + 8);
        float x = bias;
#pragma unroll
        for (int e = 0; e < 4; ++e) { x += __uint_as_float(g0[e] << 16) * w[2 * e] + __uint_as_float(g0[e] & 0xffff0000u) * w[2 * e + 1];
                                      x += __uint_as_float(g1[e] << 16) * w[8 + 2 * e] + __uint_as_float(g1[e] & 0xffff0000u) * w[8 + 2 * e + 1]; }
        const float ls = fminf(x, 0.f) - log1pf(__expf(-fabsf(x)));
        Bm[t * BP + d] = ls * (1.0f / 16.0f); }
    __syncthreads();
    if (tid < 64) { float a = 0.f;
#pragma unroll 8
        for (int t = 0; t < 64; ++t) { a += Bm[t * BP + tid]; Bm[t * BP + tid] = a; } }
    __syncthreads();
}
__device__ __forceinline__ void gla_pass_a(LAS float* Bm, const bf16_t* proj, const float* wgu, const float* bg, float* Gst, float* Gdv) {
    const int tid = opaque_tid(), wv = tid >> 6, lane = tid & 63, r = lane & 31, hh = lane >> 5;
    for (int item = blockIdx.x; item < 16 * 128; item += gridDim.x) {
        const int bh = item >> 7, n = item & 127, b = bh >> 2, h = bh & 3; const size_t row0 = (size_t)b * SEQ + (size_t)n * 64;
        gla_decay(Bm, proj, wgu, bg, row0, h);
        const int dvb = wv & 3, dkb = wv >> 2, dk = 32 * dkb + r; const float bl = Bm[63 * BP + dk];
        f32x16 acc = {};
#pragma unroll
        for (int ks = 0; ks < 4; ++ks) { bf16x8 av, bv;
#pragma unroll
            for (int j = 0; j < 8; ++j) { const int t = 16 * ks + 8 * hh + j; const bf16_t* pr = proj + (row0 + t) * NIN;
                av[j] = (short)pr[512 + h * 128 + 32 * dvb + r];
                bv[j] = (short)f2bf(bf2f(pr[256 + h * 64 + dk]) * __expf(bl - Bm[t * BP + dk])); }
            acc = __builtin_amdgcn_mfma_f32_32x32x16_bf16(av, bv, acc, 0, 0, 0); }
        float* go = Gst + ((size_t)item * 128 + 32 * dvb) * 64 + dk;
#pragma unroll
        for (int i = 0; i < 16; ++i) go[(size_t)crow(i, hh) * 64] = acc[i];
        if (tid < 64) Gdv[(size_t)item * 64 + tid] = __expf(Bm[63 * BP + tid]);
        __syncthreads();
    }
}
__device__ __forceinline__ void gla_scan(float* Gst, const float* Gdv) {
    const int gt = blockIdx.x * 512 + opaque_tid(), GT = gridDim.x * 512;
    for (int e = gt; e < 16 * 8192; e += GT) { const int bh = e >> 13, idx = e & 8191, dk = idx & 63;
        float* base = Gst + (size_t)bh * 128 * 8192 + idx; const float* dvp = Gdv + (size_t)bh * 128 * 64 + dk;
        float s = 0.f;
        for (int n0 = 0; n0 < 128; n0 += 16) { float u[16], dd[16];
#pragma unroll
            for (int i = 0; i < 16; ++i) { u[i] = base[(size_t)(n0 + i) * 8192]; dd[i] = dvp[(n0 + i) * 64]; }
#pragma unroll
            for (int i = 0; i < 16; ++i) { base[(size_t)(n0 + i) * 8192] = s; s = dd[i] * s + u[i]; } }
    }
}
__device__ __forceinline__ void gla_pass_c(LAS float* Bm, const bf16_t* proj, const float* wgu, const float* bg, const float* Gst, const float* gout, bf16_t* mixed) {
    const int tid = opaque_tid(), wv = tid >> 6, lane = tid & 63, r = lane & 31, hh = lane >> 5;
    LAS float* Ps = Bm + 64 * BP;
    for (int item = blockIdx.x; item < 16 * 128; item += gridDim.x) {
        const int bh = item >> 7, n = item & 127, b = bh >> 2, h = bh & 3; const size_t row0 = (size_t)b * SEQ + (size_t)n * 64;
        gla_decay(Bm, proj, wgu, bg, row0, h);
        const int tb = wv & 1, dvb = wv >> 1, tl = 32 * tb + r;
        bf16x8 qe[4];
        { const bf16_t* qp = proj + (row0 + tl) * NIN + h * 64;
#pragma unroll
          for (int ks = 0; ks < 4; ++ks) { const u32x4 qw = *(const u32x4*)(qp + 16 * ks + 8 * hh); const LAS float* bp = Bm + tl * BP + 16 * ks + 8 * hh;
#pragma unroll
              for (int e = 0; e < 4; ++e) { const float lo = __uint_as_float(qw[e] << 16) * 0.125f * __expf(bp[2 * e]), hi = __uint_as_float(qw[e] & 0xffff0000u) * 0.125f * __expf(bp[2 * e + 1]);
                  qe[ks][2 * e] = (short)f2bf(lo); qe[ks][2 * e + 1] = (short)f2bf(hi); } } }
        f32x16 o = {};
        { const float* sp = Gst + ((size_t)item * 128 + 32 * dvb + r) * 64;
#pragma unroll
          for (int ks = 0; ks < 4; ++ks) { const f32x4 s0 = *(const f32x4*)(sp + 16 * ks + 8 * hh), s1 = *(const f32x4*)(sp + 16 * ks + 8 * hh + 4);
              u32x4 sw; sw.x = pk2(s0[0], s0[1]); sw.y = pk2(s0[2], s0[3]); sw.z = pk2(s1[0], s1[1]); sw.w = pk2(s1[2], s1[3]);
              o = __builtin_amdgcn_mfma_f32_32x32x16_bf16(qe[ks], __builtin_bit_cast(bf16x8, sw), o, 0, 0, 0); } }
#pragma unroll
        for (int sb = 0; sb < 2; ++sb) { if (sb <= tb) {
            f32x16 x = {};
            const int sl = 32 * sb + r; const bf16_t* kp = proj + (row0 + sl) * NIN + 256 + h * 64;
#pragma unroll
            for (int ks = 0; ks < 4; ++ks) { const u32x4 kw = *(const u32x4*)(kp + 16 * ks + 8 * hh); const LAS float* bp = Bm + sl * BP + 16 * ks + 8 * hh; bf16x8 ke;
#pragma unroll
                for (int e = 0; e < 4; ++e) { const float lo = __uint_as_float(kw[e] << 16) * __expf(-bp[2 * e]), hi = __uint_as_float(kw[e] & 0xffff0000u) * __expf(-bp[2 * e + 1]);
                    ke[2 * e] = (short)f2bf(lo); ke[2 * e + 1] = (short)f2bf(hi); }
                x = __builtin_amdgcn_mfma_f32_32x32x16_bf16(ke, qe[ks], x, 0, 0, 0); }
            if (sb == tb) {
#pragma unroll
                for (int i = 0; i < 16; ++i) if (crow(i, hh) > r) x[i] = 0.f; }
#pragma unroll
            for (int s2 = 0; s2 < 2; ++s2) { u32x4 xw; xw.x = pk2(x[8 * s2], x[8 * s2 + 1]); xw.y = pk2(x[8 * s2 + 2], x[8 * s2 + 3]); xw.z = pk2(x[8 * s2 + 4], x[8 * s2 + 5]); xw.w = pk2(x[8 * s2 + 6], x[8 * s2 + 7]);
                bf16x8 vb;
#pragma unroll
                for (int j = 0; j < 8; ++j) { const int sk = 32 * sb + 16 * s2 + 8 * (j >> 2) + 4 * hh + (j & 3); vb[j] = (short)proj[(row0 + sk) * NIN + 512 + h * 128 + 32 * dvb + r]; }
                o = __builtin_amdgcn_mfma_f32_32x32x16_bf16(__builtin_bit_cast(bf16x8, xw), vb, o, 0, 0, 0); } } }
        float ss[16];
#pragma unroll
        for (int i = 0; i < 16; ++i) ss[i] = half_sum32(o[i] * o[i]);
        if (r == 0) {
#pragma unroll
            for (int i = 0; i < 16; ++i) Ps[dvb * 64 + 32 * tb + crow(i, hh)] = ss[i]; }
        __syncthreads();
        const float gn = gout[32 * dvb + r];
#pragma unroll
        for (int i = 0; i < 16; ++i) { const int t = 32 * tb + crow(i, hh);
            const float tot = (Ps[t] + Ps[64 + t]) + (Ps[128 + t] + Ps[192 + t]);
            const float rr = 1.0f / sqrtf(tot * (1.0f / 128.0f) + EPS);
            const float g = bf2f(proj[(row0 + t) * NIN + 1024 + h * 128 + 32 * dvb + r]);
            const float val = o[i] * rr * gn * (g / (1.0f + __expf(-g)));
            mixed[(row0 + t) * DM + h * 128 + 32 * dvb + r] = (bf16_t)f2bf(val); }
        __syncthreads();
    }
}
}
#ifndef PHM
#define PHM 0xffff
#endif
struct Args { const float* in[20]; float* out; unsigned char* ws; float inv_freq[32]; };
__global__ void __launch_bounds__(512, 2) mega_fwd(Args a) {
    using namespace mk;
    extern __shared__ __attribute__((aligned(16))) unsigned char lds[];
    cg::grid_group grid = cg::this_grid();
    const int tid = opaque_tid(), lane = tid & 63, wave = __builtin_amdgcn_readfirstlane(tid >> 6);
    const int G = gridDim.x;
    PG8_LAS unsigned char* ldsl = (PG8_LAS unsigned char*)lds;
    LAS float* ldsf = (LAS float*)lds;
    unsigned char* ws = a.ws;
    const float* x_in = a.in[0]; const float* c_in = a.in[1]; const int* pos = (const int*)a.in[2];
    const float* w_ada = a.in[3]; const float* b_ada = a.in[4];
    float* mod = (float*)(ws + WS_MOD); float* cosT = (float*)(ws + WS_COS); float* sinT = (float*)(ws + WS_SIN);
    bf16_t* HN = (bf16_t*)(ws + WS_HN); bf16_t* QN = (bf16_t*)(ws + WS_QN); bf16_t* KVN = (bf16_t*)(ws + WS_KVN);
    float* GST = (float*)(ws + WS_GST); float* GDV = (float*)(ws + WS_GDV);
    bf16_t* PROJ = (bf16_t*)(ws + WS_R + R_PROJ); bf16_t* QB_ = (bf16_t*)(ws + WS_R + R_Q); bf16_t* KB_ = (bf16_t*)(ws + WS_R + R_K); bf16_t* VB_ = (bf16_t*)(ws + WS_R + R_V);
    bf16_t* HB = (bf16_t*)(ws + WS_R);
    float* xout = a.out;

#if (PHM >> 0) & 1
    for (int u = blockIdx.x; u < 192; u += G) adaln_unit(u, c_in, w_ada, b_ada, mod, ldsf);
    __syncthreads();
    { const int gt = blockIdx.x * 512 + tid, GT = G * 512;
      for (int e = gt; e < T * 32; e += GT) { const int t = e >> 5, j = e & 31;
          const float ang = (float)pos[t] * a.inv_freq[j];
          const double turns = (double)ang * 0.15915494309189535; const float fr = (float)(turns - rint(turns)) * 6.283185307179586f;
          cosT[e] = cosf(fr); sinT[e] = sinf(fr); } }
    { LAS float* scr = (LAS float*)(ldsl + wave * 16384);
      const int gw = blockIdx.x * 8 + wave, NGW = G * 8;
      constexpr int I_IN = 16 * 64, I_Q = 4 * 24, I_KV = 2 * 32, I_O = 16 * 32, I_1 = 16 * 128, I_2 = 64 * 32, I_L = I_IN + I_Q + I_KV + I_O + I_1 + I_2;
      for (int it = gw; it < DEPTH * I_L; it += NGW) { const int l = it / I_L; int r = it % I_L; unsigned char* wl = ws + WS_W + (size_t)l * W_LAYER;
          if (r < I_IN) { transpose_item(a.in[5] + (size_t)l * 1024 * 2000, 1024, 2000, 2048, (bf16_t*)(wl + W_IN), 1, scr, r, lane); continue; } r -= I_IN;
          if (r < I_Q) { transpose_item(a.in[10] + (size_t)l * 256 * 768, 256, 768, 768, (bf16_t*)(wl + W_Q), 2, scr, r, lane); continue; } r -= I_Q;
          if (r < I_KV) { transpose_item(a.in[12] + (size_t)l * 128 * 1024, 128, 1024, 1024, (bf16_t*)(wl + W_KV), 0, scr, r, lane); continue; } r -= I_KV;
          if (r < I_O) { transpose_item(a.in[17] + (size_t)l * 1024 * 1024, 1024, 1024, 1024, (bf16_t*)(wl + W_O), 0, scr, r, lane); continue; } r -= I_O;
          if (r < I_1) { transpose_item(a.in[18] + (size_t)l * 1024 * 4096, 1024, 4096, 4096, (bf16_t*)(wl + W_1), 0, scr, r, lane); continue; } r -= I_1;
          transpose_item(a.in[19] + (size_t)l * 4096 * 1024, 4096, 1024, 1024, (bf16_t*)(wl + W_2), 0, scr, r, lane); } }
#endif
    grid.sync();
#if (PHM >> 1) & 1
    norm_rows(x_in, HN, mod, 0, 1024);
#endif
    grid.sync();

#pragma unroll 1
    for (int l = 0; l < DEPTH; ++l) {
        const float* modl = mod + (size_t)l * 4 * NMOD;
        unsigned char* wl = ws + WS_W + (size_t)l * W_LAYER;
        const float* xin = l == 0 ? x_in : xout;
#if (PHM >> 2) & 1
        { pg8::Gemm g{HN, (const bf16_t*)(wl + W_IN), T, NIN, DM}; pg8::StaticOrder S; S.init(T, NIN, G, (int)blockIdx.x);
          pg8::EpiBf16<0> E{PROJ, NIN, nullptr, 0, 0, 1.f};
          pg8::gemm_phase<pg8::EpiBf16<0>, pg8::StaticOrder, true, true>(ldsl, g, S, E); }
#endif
        grid.sync();
#if (PHM >> 3) & 1
        prep_tokens(PROJ, QN, KVN, KB_, a.in[9] + l * 256, a.in[11] + l * 128, a.in[16] + l * 64, cosT, sinT);
#endif
#if (PHM >> 4) & 1
        gla_pass_a(ldsf, PROJ, a.in[6] + (size_t)l * 16 * 256, a.in[7] + l * 256, GST, GDV);
#endif
        grid.sync();
#if (PHM >> 5) & 1
        { int kq = 256; asm volatile("" : "+s"(kq));
          pg8::Gemm g{QN, (const bf16_t*)(wl + W_Q), T, 512, kq}; pg8::StaticOrder S; S.init(T, 512, G, (int)blockIdx.x);
          pg8::EpiQN E{QB_, a.in[13] + l * 128, (PG8_LAS float*)(ldsl + EPI_OFF)};
          pg8::gemm_phase<pg8::EpiQN, pg8::StaticOrder, true, true>(ldsl, g, S, E); }
#endif
#if (PHM >> 13) & 1
        { int kq = 256; asm volatile("" : "+s"(kq));
          pg8::Gemm g{QN, (const bf16_t*)(wl + W_Q) + 512 * 256, T, 256, kq}; pg8::StaticOrder S; S.init(T, 256, G, (int)blockIdx.x);
          pg8::EpiQR E{QB_, a.in[15] + l * 64, cosT, sinT};
          pg8::gemm_phase<pg8::EpiQR, pg8::StaticOrder, true, true>(ldsl, g, S, E); }
#endif
#if (PHM >> 6) & 1
        { int kk = 128; asm volatile("" : "+s"(kk));
          pg8::Gemm g{KVN, (const bf16_t*)(wl + W_KV), T, 1024, kk}; pg8::StaticOrder S; S.init(T, 1024, G, (int)blockIdx.x);
          pg8::EpiKV E{KB_, VB_, a.in[14] + l * 128, (PG8_LAS float*)(ldsl + EPI_OFF)};
          pg8::gemm_phase<pg8::EpiKV, pg8::StaticOrder, true, true>(ldsl, g, S, E); }
#endif
#if (PHM >> 7) & 1
        gla_scan(GST, GDV);
#endif
        grid.sync();
#if (PHM >> 8) & 1
        att::attn_phase((char*)lds, (const att::bf16*)QB_, (const att::bf16*)KB_, (const att::bf16*)VB_, (att::bf16*)HN);
#endif
        __syncthreads();
#if (PHM >> 9) & 1
        gla_pass_c(ldsf, PROJ, a.in[6] + (size_t)l * 16 * 256, a.in[7] + l * 256, GST, a.in[8] + l * 128, HN);
#endif
        grid.sync();
#if (PHM >> 10) & 1
        { pg8::Gemm g{HN, (const bf16_t*)(wl + W_O), T, DM, DM}; pg8::StaticOrder S; S.init(T, DM, G, (int)blockIdx.x);
          pg8::EpiResGate E{xin, xout, modl + 2048};
          pg8::gemm_phase<pg8::EpiResGate, pg8::StaticOrder, true, true>(ldsl, g, S, E); }
#endif
        grid.sync();
        norm_rows(xout, HN, modl, 3072, 4096);
        grid.sync();
#if (PHM >> 11) & 1
        { pg8::Gemm g{HN, (const bf16_t*)(wl + W_1), T, DFF, DM}; pg8::StaticOrder S; S.init(T, DFF, G, (int)blockIdx.x);
          pg8::EpiBf16<2> E{HB, DFF, nullptr, 0, 0, 1.f};
          pg8::gemm_phase<pg8::EpiBf16<2>, pg8::StaticOrder, true, true>(ldsl, g, S, E); }
#endif
        grid.sync();
#if (PHM >> 12) & 1
        { pg8::Gemm g{HB, (const bf16_t*)(wl + W_2), T, DM, DFF}; pg8::StaticOrder S; S.init(T, DM, G, (int)blockIdx.x);
          pg8::EpiResGate E{xout, xout, modl + 5120};
          pg8::gemm_phase<pg8::EpiResGate, pg8::StaticOrder, true, true>(ldsl, g, S, E); }
#endif
        if (l + 1 < DEPTH) {
            grid.sync();
            norm_rows(xout, HN, mod + (size_t)(l + 1) * 4 * NMOD, 0, 1024);
            grid.sync();
        }
    }
}

extern "C" void kernel_launch(void* const* d_in, const int* in_sizes, int n_in, void* d_out, int out_size, void* d_ws, size_t ws_size, hipStream_t stream) {
    static int grid = 0;
    if (grid == 0) {
        if (n_in != 20 || out_size != mk::T * mk::DM || ws_size < mk::WS_END) { fprintf(stderr, "kernel_launch: unexpected shapes (n_in %d out %d ws %zu)\n", n_in, out_size, ws_size); grid = -1; return; }
        int dev = 0, cus = 0, per = 0;
        (void)hipGetDevice(&dev); (void)hipDeviceGetAttribute(&cus, hipDeviceAttributeMultiprocessorCount, dev);
        (void)hipFuncSetAttribute((const void*)mega_fwd, hipFuncAttributeMaxDynamicSharedMemorySize, mk::LDS_BYTES);
        if (hipOccupancyMaxActiveBlocksPerMultiprocessor(&per, (const void*)mega_fwd, 512, mk::LDS_BYTES) != hipSuccess || per < 1) per = 1;
        (void)hipGetLastError();
        grid = cus * per; if (grid > 256) grid = 256;
    }
    if (grid < 0) return;
    Args a{};
    for (int i = 0; i < 20; ++i) a.in[i] = (const float*)d_in[i];
    a.out = (float*)d_out; a.ws = (unsigned char*)d_ws;
    for (int j = 0; j < 32; ++j) a.inv_freq[j] = powf(10000.0f, -(float)(2 * j) / 64.0f);
    void* args[] = {&a};
    hipError_t e = hipLaunchCooperativeKernel((const void*)mega_fwd, dim3(grid), dim3(512), args, mk::LDS_BYTES, stream);
    if (e != hipSuccess) fprintf(stderr, "kernel_launch: cooperative launch failed: %s (grid %d)\n", hipGetErrorString(e), grid);
}
```

```cpp
#include <hip/hip_runtime.h>
#include <hip/hip_bf16.h>
#include <hip/hip_cooperative_groups.h>
#include <cstdio>
#include <cstdint>
#include <cmath>
namespace cg = cooperative_groups;
#define LAS __attribute__((address_space(3)))
__device__ __forceinline__ int opaque_tid() { int t = threadIdx.x; asm volatile("" : "+v"(t)); return t; }
__device__ __forceinline__ int opaque_int(int v) { asm volatile("" : "+s"(v)); return v; }
namespace pg8 {
#define PG8_LAS __attribute__((address_space(3)))
typedef unsigned short bf16_t;
typedef short bf16x8 __attribute__((ext_vector_type(8)));
typedef float f32x4 __attribute__((ext_vector_type(4)));
typedef unsigned u32x4 __attribute__((ext_vector_type(4)));
constexpr int BM = 256, BK = 64, HALF = 128, HTB = HALF * BK * 2  , STAGE_BYTES = 8 * HTB, NXCD = 8, WGM = 8;

__host__ __device__ __forceinline__ int lds_byte(int r, int c) { const int st = (r >> 4) * 2 + (c >> 5), rr = r & 15, cc = c & 31, ob = rr * 64 + cc * 2; return st * 1024 + (ob ^ (((ob >> 9) & 1) << 5)); }
__host__ __device__ __forceinline__ void stage_rc(int b, int& R, int& C) { const int st = b / 1024, sb = b % 1024, swz = sb ^ (((sb >> 9) & 1) << 5); R = (st >> 1) * 16 + swz / 64; C = (st & 1) * 32 + (swz % 64) / 2; }
__host__ __device__ __forceinline__ int perm32(int rho) { const int n = rho >> 4, i = rho & 15; return 8 * (i >> 2) + 4 * n + (i & 3); }

struct Unit { int pm, pn; };
struct Gemm { const bf16_t* A; const bf16_t* Bt; int M, N, K; };

struct StaticOrder {
    int nM, nN, nwg, G, c;
    __host__ __device__ void init(int M, int N, int G_, int c_) { nM = M / BM; nN = N / BM; nwg = nM * nN; G = G_; c = c_; }
    __host__ __device__ bool next(int i, Unit& u) const {
        const long L = (long)i * G + c; if (L >= nwg) return false;
        int wgid = (int)L; { const int q = nwg / NXCD, r = nwg % NXCD, xcd = wgid % NXCD, off = wgid / NXCD; wgid = (xcd < r ? xcd * (q + 1) : r * (q + 1) + (xcd - r) * q) + off; }
        const int nig = WGM * nN, gid = wgid / nig, fm = gid * WGM, gsz = (nM - fm) < WGM ? (nM - fm) : WGM;
        u.pm = fm + ((wgid % nig) % gsz); u.pn = (wgid % nig) / gsz; return true;
    }
    __device__ __forceinline__ void a_ready(const Unit&) const {}
    __device__ __forceinline__ void done(const Unit&) const {}
};

__device__ __forceinline__ unsigned cvt_pk_bf16(float lo, float hi) { unsigned r; asm volatile("v_cvt_pk_bf16_f32 %0, %1, %2" : "=v"(r) : "v"(lo), "v"(hi)); return r; }
typedef float f32x2 __attribute__((ext_vector_type(2)));
__device__ __forceinline__ f32x2 gelu_pk(f32x2 v) {
    const f32x2 av = __builtin_elementwise_abs(v), d = av * 0.2316418882f + 1.0f;
    f32x2 t; t.x = __builtin_amdgcn_rcpf(d.x); t.y = __builtin_amdgcn_rcpf(d.y);
    f32x2 q = t * 0.5307027145f + (-0.7265760135f); q = q * t + 0.7107068705f; q = q * t + (-0.142248368f); q = q * t + 0.127414796f; q = q * t;
    const f32x2 s = (v * v) * (-0.72134752044f);
    f32x2 e; e.x = __builtin_amdgcn_exp2f(s.x); e.y = __builtin_amdgcn_exp2f(s.y);
    const f32x2 m = v * (q * e), r = v - m;
    f32x2 o; o.x = v.x < 0.f ? m.x : r.x; o.y = v.y < 0.f ? m.y : r.y; return o;
}

template <int ACT  > struct EpiBf16 {
    static constexpr bool PERM = true, AFTER_DRAIN = false; static_assert(ACT == 0 || ACT == 1 || ACT == 2, "EpiBf16: ACT is 0 (none), 1 (gelu_pk) or 2 (relu squared)");
    bf16_t* O; int ldc; const float* bias; int split_cols; size_t split_stride; float scale0;
    __device__ __forceinline__ void operator()(const f32x4 (&acc)[2][2][4][2], const Unit& u, int wr, int wc, int fr, int fq) const {
        const int row0 = u.pm * BM + wr * 64 + fr; int colt = u.pn * BM; bf16_t* base = O;
        float sc = 1.f; if (split_cols) { const int t = colt / split_cols; base += (size_t)t * split_stride; colt -= t * split_cols; if (t == 0) sc = scale0; }
        const int col0 = colt + wc * 32 + 8 * fq, bcol0 = u.pn * BM + wc * 32 + 8 * fq;
        f32x4 bv[2][2];
#pragma unroll
        for (int bj = 0; bj < 2; ++bj)
#pragma unroll
            for (int n = 0; n < 2; ++n) bv[bj][n] = bias ? *(const f32x4*)(bias + bcol0 + bj * HALF + 4 * n) : (f32x4){0.f, 0.f, 0.f, 0.f};
#pragma unroll
        for (int ai = 0; ai < 2; ++ai)
#pragma unroll
            for (int m = 0; m < 4; ++m) { bf16_t* rowp = base + (size_t)(row0 + ai * HALF + m * 16) * ldc + col0;
#pragma unroll
                for (int bj = 0; bj < 2; ++bj) { f32x4 v0 = acc[ai][bj][m][0] + bv[bj][0], v1 = acc[ai][bj][m][1] + bv[bj][1];
                    if (ACT == 1) { f32x2 a = gelu_pk((f32x2){v0[0], v0[1]}), b = gelu_pk((f32x2){v0[2], v0[3]}), c = gelu_pk((f32x2){v1[0], v1[1]}), d = gelu_pk((f32x2){v1[2], v1[3]});
                        v0 = (f32x4){a.x, a.y, b.x, b.y}; v1 = (f32x4){c.x, c.y, d.x, d.y}; }
                    if (ACT == 2) { v0 = __builtin_elementwise_max(v0, (f32x4){0.f, 0.f, 0.f, 0.f}); v1 = __builtin_elementwise_max(v1, (f32x4){0.f, 0.f, 0.f, 0.f}); v0 = v0 * v0; v1 = v1 * v1; }
                    v0 = v0 * sc; v1 = v1 * sc; u32x4 w; w.x = cvt_pk_bf16(v0[0], v0[1]); w.y = cvt_pk_bf16(v0[2], v0[3]); w.z = cvt_pk_bf16(v1[0], v1[1]); w.w = cvt_pk_bf16(v1[2], v1[3]);
                    *(u32x4*)(rowp + bj * HALF) = w; } }
    }
};
template <class Epi, class Sched, bool ALIGN_EPI = false, bool SP2 = false>
__device__ __forceinline__ void gemm_phase(PG8_LAS unsigned char* lds, const Gemm g, const Sched& S, const Epi& E) {
    const int tid = opaque_tid(), wid = __builtin_amdgcn_readfirstlane(tid >> 6), lane = tid & 63, wr = wid >> 2, wc = wid & 3, fr = lane & 15, fq = lane >> 4;
    const int K = g.K, nt = K / BK;
    unsigned voffA[2], voffB[2];
#pragma unroll
    for (int i = 0; i < 2; ++i) { int R, C; stage_rc(tid * 16 + i * 8192, R, C); const int Rb = Epi::PERM ? ((R & ~31) + perm32(R & 31)) : R;
        voffA[i] = (unsigned)(R * K + C) * 2u; voffB[i] = (unsigned)(Rb * K + C) * 2u; }
    const size_t kstep = (size_t)(BK * 2);
    const size_t hstep = (size_t)HALF * K * 2;
    const size_t tstep = 2 * hstep;
    const unsigned ldsw = (unsigned)wid * 1024u;
    const int aoff = lds_byte(wr * 64 + fr, fq * 8), boff = lds_byte(wc * 32 + fr, fq * 8);
#define PG8_SA(b, h) (((b) * 2 + (h)) * HTB)
#define PG8_SB(b, h) ((4 + (b) * 2 + (h)) * HTB)
#define PG8_STAGE(bufoff, gbase, voff) do { _Pragma("unroll") for (int _i = 0; _i < 2; ++_i) \
        __builtin_amdgcn_global_load_lds((const unsigned*)((const char*)(gbase) + (voff)[_i]), (PG8_LAS unsigned*)(lds + (bufoff) + ldsw + _i * 8192), 16, 0, 0); } while (0)
#define PG8_LDA(dst, b, h) do { _Pragma("unroll") for (int m = 0; m < 4; ++m) _Pragma("unroll") for (int k = 0; k < 2; ++k) dst[m][k] = *(const PG8_LAS bf16x8*)(lds + PG8_SA(b, h) + aoff + m * 2048 + k * 1024); } while (0)
#define PG8_LDB(dst, b, h) do { _Pragma("unroll") for (int n = 0; n < 2; ++n) _Pragma("unroll") for (int k = 0; k < 2; ++k) dst[n][k] = *(const PG8_LAS bf16x8*)(lds + PG8_SB(b, h) + boff + n * 2048 + k * 1024); } while (0)
#define PG8_MMA(ai, bj, At, Bt) do { __builtin_amdgcn_s_setprio(1); _Pragma("unroll") for (int m = 0; m < 4; ++m) _Pragma("unroll") for (int n = 0; n < 2; ++n) _Pragma("unroll") for (int k = 0; k < 2; ++k) \
        acc[ai][bj][m][n] = __builtin_amdgcn_mfma_f32_16x16x32_bf16(Bt[n][k], At[m][k], acc[ai][bj][m][n], 0, 0, 0); __builtin_amdgcn_s_setprio(0); } while (0)
#define PG8_WAIT_V(n) asm volatile("s_waitcnt vmcnt(" #n ")" ::: "memory")
#define PG8_WAIT_L(n) asm volatile("s_waitcnt lgkmcnt(" #n ")" ::: "memory")
#define PG8_BAR __builtin_amdgcn_s_barrier()
#define PG8_SCHED __builtin_amdgcn_sched_barrier(0)
    Unit cur, nxt; int ui = 0;
    if (!S.next(0, cur)) return;
    f32x4 acc[2][2][4][2];
#pragma unroll
    for (int a = 0; a < 2; ++a)
#pragma unroll
        for (int b = 0; b < 2; ++b)
#pragma unroll
            for (int m = 0; m < 4; ++m)
#pragma unroll
                for (int n = 0; n < 2; ++n) acc[a][b][m][n] = (f32x4){0.f, 0.f, 0.f, 0.f};
    bf16x8 At[4][2], B0[2][2], B1[2][2];
    const char* cA = (const char*)g.A + (size_t)cur.pm * tstep; const char* cB = (const char*)g.Bt + (size_t)cur.pn * tstep;
    S.a_ready(cur);
    if constexpr (SP2) {
        PG8_STAGE(PG8_SB(0, 0), cB, voffB); PG8_STAGE(PG8_SB(0, 1), cB + hstep, voffB); PG8_STAGE(PG8_SA(0, 0), cA, voffA); PG8_STAGE(PG8_SA(0, 1), cA + hstep, voffA);
        if (wr == 1) PG8_BAR;
        PG8_WAIT_V(2); PG8_BAR;
        PG8_STAGE(PG8_SB(1, 0), cB + kstep, voffB); PG8_STAGE(PG8_SA(1, 0), cA + kstep, voffA); PG8_STAGE(PG8_SB(1, 1), cB + hstep + kstep, voffB);
        PG8_WAIT_V(6); PG8_BAR;
    } else {
        PG8_STAGE(PG8_SB(0, 0), cB, voffB); PG8_STAGE(PG8_SA(0, 0), cA, voffA); PG8_STAGE(PG8_SB(0, 1), cB + hstep, voffB); PG8_STAGE(PG8_SA(0, 1), cA + hstep, voffA);
        if (wr == 1) PG8_BAR;
        PG8_WAIT_V(4); PG8_BAR;
        PG8_STAGE(PG8_SB(1, 0), cB + kstep, voffB); PG8_STAGE(PG8_SA(1, 0), cA + kstep, voffA); PG8_STAGE(PG8_SB(1, 1), cB + hstep + kstep, voffB);
        PG8_WAIT_V(6); PG8_BAR;
    }
    for (;;) {
        const bool has_next = S.next(ui + 1, nxt);
        const char* nA = has_next ? (const char*)g.A + (size_t)nxt.pm * tstep : cA; const char* nB = has_next ? (const char*)g.Bt + (size_t)nxt.pn * tstep : cB;
        for (int t = 0; t < nt; t += 2) {
            const bool last = (t == nt - 2);
            const char* a1 = cA + (size_t)(t + 1) * kstep;
            const char* a2 = last ? nA : cA + (size_t)(t + 2) * kstep; const char* b2 = last ? nB : cB + (size_t)(t + 2) * kstep;
            const char* a3 = a2 + kstep; const char* b3 = b2 + kstep;
            if (last && has_next) S.a_ready(nxt);
            if constexpr (SP2) {
            PG8_LDB(B0, 0, 0); PG8_LDB(B1, 0, 1); PG8_SCHED; PG8_LDA(At, 0, 0); PG8_STAGE(PG8_SA(1, 1), a1 + hstep, voffA);
            PG8_WAIT_V(8); PG8_WAIT_L(0); PG8_BAR; PG8_MMA(0, 0, At, B0); PG8_MMA(0, 1, At, B1); PG8_BAR; PG8_SCHED;
            PG8_LDA(At, 0, 1); PG8_STAGE(PG8_SB(0, 0), b2, voffB); PG8_STAGE(PG8_SB(0, 1), b2 + hstep, voffB); PG8_STAGE(PG8_SA(0, 0), a2, voffA);
            PG8_WAIT_V(8); PG8_WAIT_L(0); PG8_BAR; PG8_MMA(1, 0, At, B0); PG8_MMA(1, 1, At, B1); PG8_BAR; PG8_SCHED;
            PG8_LDB(B0, 1, 0); PG8_LDB(B1, 1, 1); PG8_SCHED; PG8_LDA(At, 1, 0); PG8_STAGE(PG8_SA(0, 1), a2 + hstep, voffA);
            PG8_WAIT_V(8); PG8_WAIT_L(0); PG8_BAR; PG8_MMA(0, 0, At, B0); PG8_MMA(0, 1, At, B1); PG8_BAR; PG8_SCHED;
            PG8_LDA(At, 1, 1); PG8_STAGE(PG8_SB(1, 0), b3, voffB); PG8_STAGE(PG8_SB(1, 1), b3 + hstep, voffB); PG8_STAGE(PG8_SA(1, 0), a3, voffA);
            PG8_WAIT_V(8); PG8_WAIT_L(0); PG8_BAR; PG8_MMA(1, 0, At, B0); PG8_MMA(1, 1, At, B1); PG8_BAR; PG8_SCHED;
            } else {
            PG8_LDB(B0, 0, 0); PG8_SCHED; PG8_LDA(At, 0, 0); PG8_STAGE(PG8_SA(1, 1), a1 + hstep, voffA);
            PG8_WAIT_L(8); PG8_BAR; PG8_WAIT_L(0); PG8_MMA(0, 0, At, B0); PG8_BAR; PG8_SCHED;
            PG8_LDB(B1, 0, 1); PG8_STAGE(PG8_SB(0, 0), b2, voffB);
            PG8_BAR; PG8_WAIT_L(0); PG8_MMA(0, 1, At, B1); PG8_BAR;
            PG8_LDA(At, 0, 1); PG8_STAGE(PG8_SA(0, 0), a2, voffA);
            PG8_BAR; PG8_WAIT_L(0); PG8_MMA(1, 0, At, B0); PG8_BAR; PG8_SCHED;
            PG8_STAGE(PG8_SB(0, 1), b2 + hstep, voffB);
            PG8_WAIT_V(6); PG8_BAR; PG8_MMA(1, 1, At, B1); PG8_BAR;
            PG8_LDB(B0, 1, 0); PG8_SCHED; PG8_LDA(At, 1, 0); PG8_STAGE(PG8_SA(0, 1), a2 + hstep, voffA);
            PG8_WAIT_L(8); PG8_BAR; PG8_WAIT_L(0); PG8_MMA(0, 0, At, B0); PG8_BAR; PG8_SCHED;
            PG8_LDB(B1, 1, 1); PG8_STAGE(PG8_SB(1, 0), b3, voffB);
            PG8_BAR; PG8_WAIT_L(0); PG8_MMA(0, 1, At, B1); PG8_BAR;
            PG8_LDA(At, 1, 1); PG8_STAGE(PG8_SA(1, 0), a3, voffA);
            PG8_BAR; PG8_WAIT_L(0); PG8_MMA(1, 0, At, B0); PG8_BAR; PG8_SCHED;
            PG8_STAGE(PG8_SB(1, 1), b3 + hstep, voffB);
            PG8_WAIT_V(6); PG8_BAR; PG8_MMA(1, 1, At, B1); PG8_BAR;
            }
        }
        if constexpr (ALIGN_EPI) { if (wr == 0) PG8_BAR; }
        if constexpr (!Epi::AFTER_DRAIN) { E(acc, cur, wr, wc, fr, fq); S.done(cur); }
        if (!has_next) break;
#pragma unroll
        for (int a = 0; a < 2; ++a)
#pragma unroll
            for (int b = 0; b < 2; ++b)
#pragma unroll
                for (int m = 0; m < 4; ++m)
#pragma unroll
                    for (int n = 0; n < 2; ++n) acc[a][b][m][n] = (f32x4){0.f, 0.f, 0.f, 0.f};
        cur = nxt; cA = nA; cB = nB; ++ui;
        if constexpr (ALIGN_EPI) { if (wr == 1) PG8_BAR; }
    }
    PG8_WAIT_V(0);
    if constexpr (!ALIGN_EPI) { if (wr == 0) PG8_BAR; }
    PG8_BAR;
    if constexpr (Epi::AFTER_DRAIN) { E.fused(acc, cur, wr, wc, fr, fq, lds, wid, lane); S.done(cur); }
#undef PG8_SA
#undef PG8_SB
#undef PG8_STAGE
#undef PG8_LDA
#undef PG8_LDB
#undef PG8_MMA
#undef PG8_WAIT_V
#undef PG8_WAIT_L
#undef PG8_BAR
#undef PG8_SCHED
}
typedef unsigned u32x2 __attribute__((ext_vector_type(2)));
constexpr float RMS_EPS_F = 1e-6f;
struct EpiResGate {
    static constexpr bool PERM = false, AFTER_DRAIN = false;
    const float* xin; float* xout; const float* gate;
    __device__ __forceinline__ void operator()(const f32x4 (&acc)[2][2][4][2], const Unit& u, int wr, int wc, int fr, int fq) const {
        const int b = u.pm >> 5;
        const int col0 = u.pn * BM + wc * 32 + 4 * fq;
        const float* gp = gate + (size_t)b * 6144 + col0;
        f32x4 gv[2][2];
#pragma unroll
        for (int bj = 0; bj < 2; ++bj)
#pragma unroll
            for (int n = 0; n < 2; ++n) gv[bj][n] = *(const f32x4*)(gp + bj * HALF + n * 16);
#pragma unroll
        for (int ai = 0; ai < 2; ++ai)
#pragma unroll
            for (int m = 0; m < 4; ++m) { const size_t off = (size_t)(u.pm * BM + ai * HALF + wr * 64 + m * 16 + fr) * 1024 + col0;
#pragma unroll
                for (int bj = 0; bj < 2; ++bj)
#pragma unroll
                    for (int n = 0; n < 2; ++n) { const f32x4 xi = *(const f32x4*)(xin + off + bj * HALF + n * 16);
                        *(f32x4*)(xout + off + bj * HALF + n * 16) = xi + gv[bj][n] * acc[ai][bj][m][n]; } }
    }
};
struct EpiQN {
    static constexpr bool PERM = false, AFTER_DRAIN = false;
    bf16_t* Q; const float* gn_nope; PG8_LAS float* P;
    __device__ __forceinline__ void operator()(const f32x4 (&acc)[2][2][4][2], const Unit& u, int wr_, int wc_, int fr_, int fq_) const {
        int tx = threadIdx.x; asm volatile("" : "+v"(tx));
        const int fr = tx & 15, fq = (tx >> 4) & 3, wc = (tx >> 6) & 3, wr = tx >> 8;
        const int b = u.pm >> 5, s0 = (u.pm & 31) * BM;
#pragma unroll
            for (int ai = 0; ai < 2; ++ai)
#pragma unroll
                for (int m = 0; m < 4; ++m)
#pragma unroll
                    for (int bj = 0; bj < 2; ++bj) { float s = 0.f;
#pragma unroll
                        for (int n = 0; n < 2; ++n) { const f32x4 x = acc[ai][bj][m][n]; s += (x[0] * x[0] + x[1] * x[1]) + (x[2] * x[2] + x[3] * x[3]); }
                        s += __shfl_xor(s, 16); s += __shfl_xor(s, 32);
                        if (fq == 0) P[((ai * HALF + wr * 64 + m * 16 + fr) * 2 + bj) * 4 + wc] = s; }
            asm volatile("s_waitcnt lgkmcnt(0)" ::: "memory"); __builtin_amdgcn_s_barrier(); asm volatile("" ::: "memory");
#pragma unroll
            for (int ai = 0; ai < 2; ++ai)
#pragma unroll
                for (int m = 0; m < 4; ++m) { int rl = ai * HALF + wr * 64 + m * 16 + fr; asm volatile("" : "+v"(rl));
#pragma unroll
                    for (int bj = 0; bj < 2; ++bj) { const f32x4 pp = *(const PG8_LAS f32x4*)(P + (rl * 2 + bj) * 4);
                        const float rr = 1.0f / sqrtf(((pp[0] + pp[1]) + (pp[2] + pp[3])) * (1.0f / 128.0f) + RMS_EPS_F);
                        const int head = 2 * u.pn + bj;
                        const unsigned qoff = (unsigned)(((b * 4 + head) * 8192 + s0 + rl) * 192 + wc * 32 + 4 * fq);
#pragma unroll
                        for (int n = 0; n < 2; ++n) { const f32x4 g = *(const f32x4*)(gn_nope + wc * 32 + n * 16 + 4 * fq);
                            const f32x4 v = acc[ai][bj][m][n] * rr * g; u32x2 w; w.x = cvt_pk_bf16(v[0], v[1]); w.y = cvt_pk_bf16(v[2], v[3]);
                            *(u32x2*)(Q + qoff + n * 16) = w; } }
                    asm volatile("" ::: "memory"); }
    }
};
struct EpiQR {
    static constexpr bool PERM = false, AFTER_DRAIN = false;
    bf16_t* Q; const float* gn_rope; const float* cosT; const float* sinT;
    __device__ __forceinline__ void operator()(const f32x4 (&acc)[2][2][4][2], const Unit& u, int wr_, int wc_, int fr_, int fq_) const {
        int tx = threadIdx.x; asm volatile("" : "+v"(tx));
        const int fr = tx & 15, fq = (tx >> 4) & 3, wc = (tx >> 6) & 3, wr = tx >> 8;
        const int b = u.pm >> 5, s0 = (u.pm & 31) * BM;
#pragma unroll
            for (int ai = 0; ai < 2; ++ai)
#pragma unroll
                for (int m = 0; m < 4; ++m) { int rl = ai * HALF + wr * 64 + m * 16 + fr; asm volatile("" : "+v"(rl)); float s = 0.f;
#pragma unroll
                    for (int bj = 0; bj < 2; ++bj)
#pragma unroll
                        for (int n = 0; n < 2; ++n) { const f32x4 x = acc[ai][bj][m][n]; s += (x[0] * x[0] + x[1] * x[1]) + (x[2] * x[2] + x[3] * x[3]); }
                    s += __shfl_xor(s, 16); s += __shfl_xor(s, 32);
                    const float rr = 1.0f / sqrtf(s * (1.0f / 64.0f) + RMS_EPS_F);
                    const size_t t = (size_t)u.pm * BM + rl;
                    bf16_t* qrow = Q + ((size_t)(b * 4 + wc) * 8192 + s0 + rl) * 192 + 128;
#pragma unroll
                    for (int n = 0; n < 2; ++n) { const int j0 = n * 16 + 4 * fq;
                        const f32x4 c4 = *(const f32x4*)(cosT + t * 32 + j0), s4 = *(const f32x4*)(sinT + t * 32 + j0);
                        const f32x4 g1 = *(const f32x4*)(gn_rope + j0), g2 = *(const f32x4*)(gn_rope + 32 + j0);
                        const f32x4 y1 = acc[ai][0][m][n] * rr * g1, y2 = acc[ai][1][m][n] * rr * g2;
                        const f32x4 o1 = y1 * c4 - y2 * s4, o2 = y2 * c4 + y1 * s4;
                        u32x2 w1, w2; w1.x = cvt_pk_bf16(o1[0], o1[1]); w1.y = cvt_pk_bf16(o1[2], o1[3]); w2.x = cvt_pk_bf16(o2[0], o2[1]); w2.y = cvt_pk_bf16(o2[2], o2[3]);
                        *(u32x2*)(qrow + j0) = w1; *(u32x2*)(qrow + 32 + j0) = w2; }
                    asm volatile("" ::: "memory"); }
    }
};
struct EpiKV {
    static constexpr bool PERM = false, AFTER_DRAIN = false;
    bf16_t* Kb; bf16_t* Vb; const float* gn_k; PG8_LAS float* P;
    __device__ __forceinline__ void operator()(const f32x4 (&acc)[2][2][4][2], const Unit& u, int wr_, int wc_, int fr_, int fq_) const {
        int tx = threadIdx.x; asm volatile("" : "+v"(tx));
        const int fr = tx & 15, fq = (tx >> 4) & 3, wc = (tx >> 6) & 3, wr = tx >> 8;
        const int b = u.pm >> 5, s0 = (u.pm & 31) * BM;
#pragma unroll
        for (int ai = 0; ai < 2; ++ai)
#pragma unroll
            for (int m = 0; m < 4; ++m) { float s = 0.f;
#pragma unroll
                for (int n = 0; n < 2; ++n) { const f32x4 x = acc[ai][0][m][n]; s += (x[0] * x[0] + x[1] * x[1]) + (x[2] * x[2] + x[3] * x[3]); }
                s += __shfl_xor(s, 16); s += __shfl_xor(s, 32);
                if (fq == 0) P[(ai * HALF + wr * 64 + m * 16 + fr) * 4 + wc] = s; }
        asm volatile("s_waitcnt lgkmcnt(0)" ::: "memory"); __builtin_amdgcn_s_barrier(); asm volatile("" ::: "memory");
#pragma unroll
        for (int ai = 0; ai < 2; ++ai)
#pragma unroll
            for (int m = 0; m < 4; ++m) { int rl = ai * HALF + wr * 64 + m * 16 + fr; asm volatile("" : "+v"(rl));
                const f32x4 pp = *(const PG8_LAS f32x4*)(P + rl * 4);
                const float rr = 1.0f / sqrtf(((pp[0] + pp[1]) + (pp[2] + pp[3])) * (1.0f / 128.0f) + RMS_EPS_F);
                const size_t tok = (size_t)(b * 4 + u.pn) * 8192 + s0 + rl;
                bf16_t* krow = Kb + tok * 192; bf16_t* vrow = Vb + tok * 128;
#pragma unroll
                for (int n = 0; n < 2; ++n) { const int d0 = wc * 32 + n * 16 + 4 * fq; const f32x4 g = *(const f32x4*)(gn_k + d0);
                    const f32x4 kx = acc[ai][0][m][n] * rr * g, vx = acc[ai][1][m][n];
                    u32x2 w1, w2; w1.x = cvt_pk_bf16(kx[0], kx[1]); w1.y = cvt_pk_bf16(kx[2], kx[3]); w2.x = cvt_pk_bf16(vx[0], vx[1]); w2.y = cvt_pk_bf16(vx[2], vx[3]);
                    *(u32x2*)(krow + d0) = w1; *(u32x2*)(vrow + d0) = w2; }
                asm volatile("" ::: "memory"); }
    }
};
}
namespace att {
using bf16 = __hip_bfloat16;
typedef short bf16x8 __attribute__((ext_vector_type(8)));
typedef short s16x4 __attribute__((ext_vector_type(4)));
typedef float f32x16 __attribute__((ext_vector_type(16)));
typedef float f32x4 __attribute__((ext_vector_type(4)));
typedef unsigned u32x4 __attribute__((ext_vector_type(4)));
constexpr int DQ = 192, DV = 128, LDO = 1024, SEQL = 8192;
constexpr float SCALE = 0.07216878364870322f;
constexpr float THR = 8.f;
constexpr int NW = 8, QBLK = 32, KVBLK = 64, QB = NW * QBLK;
constexpr int SHM_V = KVBLK * DV * 2, SHM_K = KVBLK * DQ * 2;
constexpr int KPITCH = DQ * 2;
constexpr int LDS_NEED = 2 * SHM_V + 2 * SHM_K + NW * 64 * 4;
#define KSWZ(row, colB) ((row) * 384 + ((colB) ^ (((row) & 7) << 4)))
#define SBAR() __builtin_amdgcn_sched_barrier(0)
__device__ __forceinline__ int v_st(int k, int c) { const int kk = (k & ~0xC) | ((k & 4) << 1) | ((k & 8) >> 1); return ((kk >> 3) * 4 + (c >> 5)) * 512 + ((kk & 7) * 32 + (c & 31)) * 2; }
__device__ __forceinline__ int v_rd_base(int lane) { return ((lane & 3) << 3) | (((lane >> 2) & 3) << 6) | (((lane >> 4) & 1) << 5) | (((lane >> 5) & 1) << 8); }
constexpr int v_rd_off(int d0, int ks, int half) { return d0 * 512 + ks * 4096 + half * 2048; }
__device__ __forceinline__ int crow(int r, int hi) { return (r & 3) + 8 * (r >> 2) + 4 * hi; }
__device__ __forceinline__ unsigned cvtpk(float lo, float hi) { unsigned r; asm volatile("v_cvt_pk_bf16_f32 %0, %1, %2" : "=v"(r) : "v"(lo), "v"(hi)); return r; }
__device__ __forceinline__ bf16x8 load8(const bf16* p) { return *reinterpret_cast<const bf16x8*>(p); }
__device__ __forceinline__ void mask_tile(f32x16& p0, f32x16& p1, int dq) {
    const float NEG = -__builtin_inff();
#pragma unroll
    for (int r = 0; r < 16; ++r) {
        const int c = (r & 3) + 8 * (r >> 2);
        if (dq - c < 0) p0[r] = NEG;
        if (dq - c - 32 < 0) p1[r] = NEG;
    }
}
__device__ __forceinline__ void partialSM(f32x16& p0, f32x16& p1, float& m_reg, float& mn, float& alpha) {
    float pmax = p0[0]; for (int r = 1; r < 16; ++r) pmax = fmaxf(pmax, p0[r]); for (int r = 0; r < 16; ++r) pmax = fmaxf(pmax, p1[r]);
    { auto rr = __builtin_amdgcn_permlane32_swap(__float_as_uint(pmax), __float_as_uint(pmax), false, false);
      pmax = fmaxf(__uint_as_float(rr[0]), __uint_as_float(rr[1])); }
    constexpr float C2 = 1.4426950408889634f * SCALE;
    if (__builtin_expect(__all((pmax - m_reg) * SCALE <= THR), 1)) { mn = m_reg; alpha = 1.f; }
    else { mn = fmaxf(m_reg, pmax); alpha = __builtin_amdgcn_exp2f((m_reg - mn) * C2); m_reg = mn; }
    const float mnL = -mn * C2;
    for (int r = 0; r < 16; ++r) p0[r] = fmaf(p0[r], C2, mnL); for (int r = 0; r < 16; ++r) p1[r] = fmaf(p1[r], C2, mnL);
    for (int r = 0; r < 16; ++r) p0[r] = __builtin_amdgcn_exp2f(p0[r]);
}
__device__ __forceinline__ void finishSM(f32x16& p0, f32x16& p1, float alpha, float& l_reg, bf16x8& pa0, bf16x8& pa1, bf16x8& pa2, bf16x8& pa3) {
    for (int r = 0; r < 16; ++r) p1[r] = __builtin_amdgcn_exp2f(p1[r]);
    float ps = 0; for (int r = 0; r < 16; ++r) ps += p0[r]; for (int r = 0; r < 16; ++r) ps += p1[r];
    { auto rr = __builtin_amdgcn_permlane32_swap(__float_as_uint(ps), __float_as_uint(ps), false, false);
      ps = __uint_as_float(rr[0]) + __uint_as_float(rr[1]); }
    l_reg = l_reg * alpha + ps;
#define PK4(P, B_, OUT) do { unsigned a0 = cvtpk(P[B_+0], P[B_+1]), a1 = cvtpk(P[B_+2], P[B_+3]);                          \
        unsigned b0 = cvtpk(P[B_+4], P[B_+5]), b1 = cvtpk(P[B_+6], P[B_+7]);                                             \
        auto r0 = __builtin_amdgcn_permlane32_swap(a0, b0, false, false); auto r1 = __builtin_amdgcn_permlane32_swap(a1, b1, false, false); \
        u32x4 w = {r0[0], r1[0], r0[1], r1[1]}; OUT = *reinterpret_cast<bf16x8*>(&w); } while (0)
    PK4(p0, 0, pa0); PK4(p0, 8, pa1); PK4(p1, 0, pa2); PK4(p1, 8, pa3);
#undef PK4
}
template <int KB>
__device__ __forceinline__ void qkt(f32x16& p0, f32x16& p1, const char* K_lds, int r32, int hi, const bf16x8* qr) {
    p0 = f32x16{}; p1 = f32x16{};
    const char* kb[4];
#pragma unroll
    for (int dd = 0; dd < 4; ++dd) kb[dd] = K_lds + KB * SHM_K + KSWZ(r32, (dd * 16 + hi * 8) * 2);
#pragma unroll
    for (int d0 = 0; d0 < 12; ++d0) { const char* a = kb[d0 & 3] + (d0 >> 2) * 128;
        bf16x8 b0 = *reinterpret_cast<const bf16x8*>(a);
        bf16x8 b1 = *reinterpret_cast<const bf16x8*>(a + 32 * KPITCH);
        p0 = __builtin_amdgcn_mfma_f32_32x32x16_bf16(b0, qr[d0], p0, 0, 0, 0);
        p1 = __builtin_amdgcn_mfma_f32_32x32x16_bf16(b1, qr[d0], p1, 0, 0, 0); }
}
template <int VB>
__device__ __forceinline__ void pv_tile(f32x16* o, int vb0, bf16x8 pa0, bf16x8 pa1, bf16x8 pa2, bf16x8 pa3) {
#define TRRD(dst, off) asm volatile("ds_read_b64_tr_b16 %0, %1 offset:%2" : "=&v"(dst) : "v"(vb0), "i"(off) : "memory")
#define PV_D0(d0) do { s16x4 l0, l1, l2, l3, h0, h1, h2, h3; constexpr int b_ = VB * SHM_V + v_rd_off(d0, 0, 0);     \
        TRRD(l0, b_); TRRD(h0, b_ + 2048); TRRD(l1, b_ + 4096); TRRD(h1, b_ + 6144); TRRD(l2, b_ + 8192); TRRD(h2, b_ + 10240); TRRD(l3, b_ + 12288); TRRD(h3, b_ + 14336); \
        asm volatile("s_waitcnt lgkmcnt(0)" ::: "memory"); SBAR();   \
        o[d0] = __builtin_amdgcn_mfma_f32_32x32x16_bf16(pa0, (bf16x8){l0[0], l0[1], l0[2], l0[3], h0[0], h0[1], h0[2], h0[3]}, o[d0], 0, 0, 0);   \
        o[d0] = __builtin_amdgcn_mfma_f32_32x32x16_bf16(pa1, (bf16x8){l1[0], l1[1], l1[2], l1[3], h1[0], h1[1], h1[2], h1[3]}, o[d0], 0, 0, 0);   \
        o[d0] = __builtin_amdgcn_mfma_f32_32x32x16_bf16(pa2, (bf16x8){l2[0], l2[1], l2[2], l2[3], h2[0], h2[1], h2[2], h2[3]}, o[d0], 0, 0, 0);   \
        o[d0] = __builtin_amdgcn_mfma_f32_32x32x16_bf16(pa3, (bf16x8){l3[0], l3[1], l3[2], l3[3], h3[0], h3[1], h3[2], h3[3]}, o[d0], 0, 0, 0); } while (0)
    PV_D0(0); PV_D0(1); PV_D0(2); PV_D0(3);
#undef PV_D0
#undef TRRD
}
struct BlockRef { const bf16* Q; const bf16* K; const bf16* V; bf16* O; int P0; };
struct Stage { bf16x8 st_v0, st_v1, st_k0, st_k1, st_k2; };
#define VMW() asm volatile("s_waitcnt vmcnt(0)" ::: "memory")
#define SLOAD_H(Kp, Vp, k0) do { const bf16* vt_ = (Vp) + (size_t)(k0) * DV; const bf16* kt_ = (Kp) + (size_t)(k0) * DQ;     \
                         S.st_v0 = load8(vt_ + voff); S.st_v1 = load8(vt_ + voff + 32 * DV);              \
                         S.st_k0 = load8(kt_ + koff); S.st_k1 = load8(kt_ + koff + 64); S.st_k2 = load8(kt_ + koff + 128); } while (0)
#define SWRITE_HK(bf) do { *(bf16x8*)(K_lds + (bf) * SHM_K + kws) = S.st_k0; *(bf16x8*)(K_lds + (bf) * SHM_K + kws + 128) = S.st_k1; *(bf16x8*)(K_lds + (bf) * SHM_K + kws + 256) = S.st_k2; } while (0)
#define SWRITE_HV(bf) do { *(bf16x8*)(V_lds + (bf) * SHM_V + vst0) = S.st_v0; *(bf16x8*)(V_lds + (bf) * SHM_V + vst1) = S.st_v1; } while (0)
#define SWRITE_H(bf) do { SWRITE_HV(bf); SWRITE_HK(bf); } while (0)
__device__ __forceinline__ void attn_block(const BlockRef& cur, char* lds) {
    const int tid = opaque_tid(), wid = __builtin_amdgcn_readfirstlane(tid >> 6), lane = tid & 63, r32 = lane & 31, hi = lane >> 5;
    const int NT = cur.P0 / KVBLK + QB / KVBLK;
    const int qlo = cur.P0 + wid * QBLK, qm = qlo + r32 - 4 * hi;
    char* V_lds = lds; char* K_lds = lds + 2 * SHM_V;
    float* ws = (float*)(lds + 2 * SHM_V + 2 * SHM_K) + wid * 64; float* li_l = ws, * al_l = ws + 32;
    float m_reg = -1e30f, l_reg = 0; f32x16 o[4] = {};
    const int sr = tid >> 4, sc = (tid & 15) * 8, vst0 = v_st(sr, sc), vst1 = v_st(32 + sr, sc);
    const int kr = tid >> 3, kc = tid & 7, kws = KSWZ(kr, kc * 16);
    const unsigned voff = (unsigned)(sr * DV + sc), koff = (unsigned)(kr * DQ + kc * 8);
    const int vb0 = (int)(uintptr_t)V_lds + v_rd_base(lane);
    const bf16* Kh = cur.K; const bf16* Vh = cur.V;
    Stage S; bf16x8 qr[12];
#pragma unroll
    for (int d0 = 0; d0 < 12; ++d0) qr[d0] = load8(cur.Q + (size_t)(wid * QBLK + r32) * DQ + d0 * 16 + hi * 8);
    SLOAD_H(Kh, Vh, 0); VMW(); SWRITE_H(0);
    __syncthreads();
#define RESC(a) do { if (__any((a) < 1.f)) { if (hi == 0) al_l[r32] = (a); asm volatile("s_waitcnt lgkmcnt(0)" ::: "memory");              \
                     for (int d_ = 0; d_ < 4; ++d_) for (int r = 0; r < 16; ++r) o[d_][r] *= al_l[crow(r, hi)]; } } while (0)
#define KBASE(t) ((t) * KVBLK)
#define MASKT(P0_, P1_, t) do { const int kb_ = KBASE(t); if (kb_ + KVBLK - 1 > qlo) mask_tile(P0_, P1_, qm - kb_); } while (0)
    f32x16 p0, p1; float mn, al; bf16x8 pa0, pa1, pa2, pa3;
#define STEP(t, BUF) do {                                                                                                     \
        qkt<BUF>(p0, p1, K_lds, r32, hi, qr); SBAR();                                                                         \
        if ((t) + 1 < NT) { SLOAD_H(Kh, Vh, KBASE((t) + 1)); SBAR(); }                                                        \
        MASKT(p0, p1, (t)); partialSM(p0, p1, m_reg, mn, al);                                                                 \
        RESC(al);                                                                                                             \
        finishSM(p0, p1, al, l_reg, pa0, pa1, pa2, pa3); SBAR();                                                              \
        pv_tile<BUF>(o, vb0, pa0, pa1, pa2, pa3); SBAR();                                                                     \
        if ((t) + 1 < NT) { VMW(); SWRITE_H(1 - BUF); }                                                                       \
        __syncthreads(); } while (0)
    for (int t = 0; t < NT; t += 2) { STEP(t, 0); STEP(t + 1, 1); }
    if (hi == 0) li_l[r32] = l_reg; asm volatile("s_waitcnt lgkmcnt(0)" ::: "memory");
    float rli[16];
#pragma unroll
    for (int r = 0; r < 16; ++r) rli[r] = __builtin_amdgcn_rcpf(li_l[crow(r, hi)]);
    bf16* Ow = cur.O + (size_t)(wid * QBLK) * LDO;
#pragma unroll
    for (int r = 0; r < 16; ++r) { const int orow = crow(r, hi);
#pragma unroll
        for (int d0 = 0; d0 < 4; ++d0) { const float v = o[d0][r] * rli[r];
            const float vn = __shfl_xor(v, 1);
            if ((r32 & 1) == 0) *(unsigned*)(Ow + (size_t)orow * LDO + d0 * 32 + r32) = cvtpk(v, vn); } }
    __syncthreads();
#undef RESC
#undef KBASE
#undef MASKT
#undef STEP
}
#undef VMW
#undef SLOAD_H
#undef SWRITE_HK
#undef SWRITE_HV
#undef SWRITE_H
struct Item { int bh, qb0, qb1; };
__device__ __forceinline__ Item decode(int L) { Item it; const int xcd = L & 7, k = L >> 3; it.bh = (k >> 4) * 8 + xcd; const int x = k & 15; it.qb0 = x; it.qb1 = 31 - x; return it; }
__device__ __forceinline__ BlockRef mkref(const Item& it, int pass, const bf16* Q, const bf16* K, const bf16* V, bf16* mixed) {
    const int qb = pass ? it.qb1 : it.qb0; BlockRef r;
    r.Q = Q + ((size_t)it.bh * SEQL + (size_t)qb * QB) * DQ; r.K = K + (size_t)it.bh * SEQL * DQ; r.V = V + (size_t)it.bh * SEQL * DV;
    r.O = mixed + ((size_t)(it.bh >> 2) * SEQL + (size_t)qb * QB) * LDO + 512 + (it.bh & 3) * 128; r.P0 = qb * QB;
    return r;
}
__device__ __forceinline__ void attn_phase(char* lds, const bf16* Q, const bf16* K, const bf16* V, bf16* mixed) {
    for (int L = blockIdx.x; L < 256; L += gridDim.x) {
        const Item it = decode(L);
        attn_block(mkref(it, 0, Q, K, V, mixed), lds);
        attn_block(mkref(it, 1, Q, K, V, mixed), lds);
    }
}
#undef KSWZ
#undef SBAR
}
namespace mk {
typedef unsigned short bf16_t;
typedef short bf16x8 __attribute__((ext_vector_type(8)));
typedef float f32x4 __attribute__((ext_vector_type(4)));
typedef float f32x2 __attribute__((ext_vector_type(2)));
typedef float f32x16 __attribute__((ext_vector_type(16)));
typedef unsigned u32x2 __attribute__((ext_vector_type(2)));
typedef unsigned u32x4 __attribute__((ext_vector_type(4)));
constexpr int NB = 4, SEQ = 8192, T = NB * SEQ, DM = 1024, DEPTH = 2, DFF = 4096, NIN = 2048, NMOD = 6 * DM;
constexpr float EPS = 1e-6f;
constexpr size_t MiB = 1u << 20;
constexpr size_t W_IN = 0, W_Q = 4 * MiB, W_KV = W_Q + 384 * 1024, W_O = W_KV + 256 * 1024, W_1 = W_O + 2 * MiB, W_2 = W_1 + 8 * MiB, W_LAYER = 23 * MiB;
static_assert(W_2 + 8 * MiB <= W_LAYER, "weights");
constexpr size_t WS_W = 0, WS_MOD = 46 * MiB, WS_COS = 47 * MiB, WS_SIN = 51 * MiB, WS_HN = 55 * MiB, WS_QN = 119 * MiB, WS_KVN = 135 * MiB,
                 WS_GST = 143 * MiB, WS_GDV = 207 * MiB, WS_R = 208 * MiB, WS_BT = 464 * MiB, WS_END = 496 * MiB;
constexpr size_t WS_BAR = WS_MOD + 512 * 1024;
constexpr size_t R_PROJ = 0, R_Q = 128 * MiB, R_K = 176 * MiB, R_V = 224 * MiB;
constexpr int LDS_BYTES = 139264 + 64;
constexpr int MISC_OFF = 139264;
constexpr int EPI_OFF = 131072;

__device__ __forceinline__ float bf2f(unsigned short v) { return __uint_as_float((unsigned)v << 16); }
__device__ __forceinline__ unsigned f2bf(float f) { unsigned u = __float_as_uint(f); return (u + 0x7fffu + ((u >> 16) & 1u)) >> 16; }
__device__ __forceinline__ unsigned pk2(float lo, float hi) { return f2bf(lo) | (f2bf(hi) << 16); }
__device__ __forceinline__ float wave_sum(float v) {
#pragma unroll
    for (int o = 1; o < 64; o <<= 1) v += __shfl_xor(v, o);
    return v;
}
__device__ __forceinline__ float half_sum32(float v) {
#pragma unroll
    for (int o = 1; o < 32; o <<= 1) v += __shfl_xor(v, o);
    return v;
}
__device__ __forceinline__ int crow(int r, int hi) { return (r & 3) + 8 * (r >> 2) + 4 * hi; }

__device__ __forceinline__ int src_col(int map, int n) {
    if (map == 1) { if (n < 1536) return n; if (n < 1984) return n + 16; if (n < 2000) return n - 1984 + 1536; return -1; }
    if (map == 2) { if (n < 512) return (n >> 7) * 192 + (n & 127); const int c = n - 512, bj = c >> 7, hd = (c & 127) >> 5, w = c & 31; return hd * 192 + 128 + 32 * bj + w; }
    return n;
}
__device__ __forceinline__ void transpose_item(const float* W, int K, int N, int NP, bf16_t* WT, int map, LAS float* scr, int item, int lane) {
    const int nblk = NP / 32, kb = item / nblk, nb = item % nblk, k0 = 64 * kb, n0 = 32 * nb;
    const int sc = src_col(map, n0 + (lane & 31));
#pragma unroll 8
    for (int i = 0; i < 32; ++i) { const int kk = 2 * i + (lane >> 5); scr[kk * 33 + (lane & 31)] = sc >= 0 ? W[(size_t)(k0 + kk) * N + sc] : 0.f; }
    asm volatile("s_waitcnt lgkmcnt(0)" ::: "memory");
    const int c = lane & 7;
#pragma unroll
    for (int j = 0; j < 4; ++j) { const int n = (lane >> 3) + 8 * j; const LAS float* s = scr + (8 * c) * 33 + n;
        u32x4 o; o.x = pk2(s[0 * 33], s[1 * 33]); o.y = pk2(s[2 * 33], s[3 * 33]); o.z = pk2(s[4 * 33], s[5 * 33]); o.w = pk2(s[6 * 33], s[7 * 33]);
        *(u32x4*)(WT + (size_t)(n0 + n) * K + k0 + 8 * c) = o; }
    asm volatile("s_waitcnt lgkmcnt(0)" ::: "memory");
}
__device__ __forceinline__ void adaln_unit(int u, const float* c, const float* w_ada, const float* b_ada, float* mod, LAS float* lds) {
    const int tid = opaque_tid(), wave = tid >> 6, lane = tid & 63;
    const int l = u / 96, n0 = (u % 96) * 64;
    LAS float* sc = lds; LAS float* red = lds + 4096;
    for (int i = tid; i < 4096; i += 512) { const float v = c[i]; sc[i] = v / (1.0f + __expf(-v)); }
    __syncthreads();
    const float* wp = w_ada + (size_t)l * DM * NMOD + n0 + lane;
    float a0 = 0.f, a1 = 0.f, a2 = 0.f, a3 = 0.f;
#pragma unroll 8
    for (int k = wave * 128; k < wave * 128 + 128; ++k) { const float w = wp[(size_t)k * NMOD]; a0 += sc[k] * w; a1 += sc[1024 + k] * w; a2 += sc[2048 + k] * w; a3 += sc[3072 + k] * w; }
    red[(wave * 4 + 0) * 64 + lane] = a0; red[(wave * 4 + 1) * 64 + lane] = a1; red[(wave * 4 + 2) * 64 + lane] = a2; red[(wave * 4 + 3) * 64 + lane] = a3;
    __syncthreads();
    if (tid < 256) { const int b = tid >> 6; float s = b_ada[(size_t)l * NMOD + n0 + lane];
#pragma unroll
        for (int w = 0; w < 8; ++w) s += red[(w * 4 + b) * 64 + lane];
        mod[((size_t)l * 4 + b) * NMOD + n0 + lane] = s; }
    __syncthreads();
}
__device__ __forceinline__ void norm_rows(const float* xin, bf16_t* hn, const float* modl, int soff, int coff) {
    const int tid = opaque_tid(), lane = tid & 63, gw = blockIdx.x * 8 + (tid >> 6), NGW = gridDim.x * 8;
    for (int t = gw; t < T; t += NGW) {
        const f32x4* xr = (const f32x4*)(xin + (size_t)t * DM) + lane; f32x4 v[4]; float ss = 0.f;
#pragma unroll
        for (int j = 0; j < 4; ++j) { v[j] = xr[64 * j]; ss += (v[j][0] * v[j][0] + v[j][1] * v[j][1]) + (v[j][2] * v[j][2] + v[j][3] * v[j][3]); }
        const float rr = 1.0f / sqrtf(wave_sum(ss) * (1.0f / DM) + EPS);
        const float* mb = modl + (size_t)(t >> 13) * NMOD;
#pragma unroll
        for (int j = 0; j < 4; ++j) { const int col = 256 * j + 4 * lane;
            const f32x4 sc = *(const f32x4*)(mb + coff + col), sh = *(const f32x4*)(mb + soff + col);
            const f32x4 h = v[j] * rr * (sc + 1.0f) + sh;
            u32x2 w; w.x = pk2(h[0], h[1]); w.y = pk2(h[2], h[3]); *(u32x2*)(hn + (size_t)t * DM + col) = w; }
    }
}
__device__ __forceinline__ void prep_tokens(const bf16_t* proj, bf16_t* qn, bf16_t* kvn, bf16_t* Kb, const float* qa, const float* kva, const float* kr,
                                            const float* cosT, const float* sinT) {
    const int tid = opaque_tid(), lane = tid & 63, gw = blockIdx.x * 8 + (tid >> 6), NGW = gridDim.x * 8;
    for (int t = gw; t < T; t += NGW) {
        const bf16_t* pr = proj + (size_t)t * NIN;
        { const u32x2 w = *(const u32x2*)(pr + 1536 + 4 * lane);
          const float q0 = __uint_as_float(w.x << 16), q1 = __uint_as_float(w.x & 0xffff0000u), q2 = __uint_as_float(w.y << 16), q3 = __uint_as_float(w.y & 0xffff0000u);
          const float rr = 1.0f / sqrtf(wave_sum((q0 * q0 + q1 * q1) + (q2 * q2 + q3 * q3)) * (1.0f / 256.0f) + EPS);
          const f32x4 g = *(const f32x4*)(qa + 4 * lane);
          u32x2 o; o.x = pk2(q0 * rr * g[0], q1 * rr * g[1]); o.y = pk2(q2 * rr * g[2], q3 * rr * g[3]); *(u32x2*)(qn + (size_t)t * 256 + 4 * lane) = o; }
        { const unsigned w = *(const unsigned*)(pr + 1792 + 2 * lane);
          const float k0 = __uint_as_float(w << 16), k1 = __uint_as_float(w & 0xffff0000u);
          const float rr = 1.0f / sqrtf(wave_sum(k0 * k0 + k1 * k1) * (1.0f / 128.0f) + EPS);
          const f32x2 g = *(const f32x2*)(kva + 2 * lane);
          *(unsigned*)(kvn + (size_t)t * 128 + 2 * lane) = pk2(k0 * rr * g[0], k1 * rr * g[1]); }
        { float y = bf2f(pr[1920 + lane]);
          const float rr = 1.0f / sqrtf(wave_sum(y * y) * (1.0f / 64.0f) + EPS);
          y = y * rr * kr[lane];
          const float pn = __shfl_xor(y, 32); const int j = lane & 31;
          const float c = cosT[(size_t)t * 32 + j], s = sinT[(size_t)t * 32 + j];
          const float o = lane < 32 ? y * c - pn * s : y * c + pn * s;
          const bf16_t ob = (bf16_t)f2bf(o); const int b = t >> 13, sp = t & 8191;
#pragma unroll
          for (int h = 0; h < 4; ++h) Kb[((size_t)(b * 4 + h) * SEQ + sp) * 192 + 128 + lane] = ob; }
    }
}
__device__ __forceinline__ void gla_pass_a(LAS float* ldsf, const bf16_t* proj, const float* wgu, const float* bg, float* Btab, float* Gst, float* Gdv) {
    const int tid = opaque_tid(), lane = tid & 63, r = lane & 31, hh = lane >> 5, wv = tid >> 6, gw = blockIdx.x * 8 + wv, NGW = gridDim.x * 8;
    LAS float* Bw = ldsf + wv * 4096;
    for (int u = gw; u < 16 * 128 * 2; u += NGW) { const int item = u >> 1, dkb = u & 1;
        const int bh = item >> 7, n = item & 127, b = bh >> 2, h = bh & 3; const size_t row0 = (size_t)b * SEQ + (size_t)n * 64;
        const int dk = 32 * dkb + r;
        float bl;
        { float w[16];
#pragma unroll
          for (int q = 0; q < 16; ++q) w[q] = wgu[q * 256 + h * 64 + dk];
          const float bias = bg[h * 64 + dk];
          float loc[32]; float a = 0.f;
#pragma unroll
          for (int t0 = 0; t0 < 32; t0 += 8) { u32x4 g0[8], g1[8];
#pragma unroll
              for (int i = 0; i < 8; ++i) { const bf16_t* ga = proj + (row0 + 32 * hh + t0 + i) * NIN + 1984; g0[i] = *(const u32x4*)ga; g1[i] = *(const u32x4*)(ga + 8); }
#pragma unroll
              for (int i = 0; i < 8; ++i) { float x = bias;
#pragma unroll
                  for (int e2 = 0; e2 < 4; ++e2) { x += __uint_as_float(g0[i][e2] << 16) * w[2 * e2] + __uint_as_float(g0[i][e2] & 0xffff0000u) * w[2 * e2 + 1];
                                                   x += __uint_as_float(g1[i][e2] << 16) * w[8 + 2 * e2] + __uint_as_float(g1[i][e2] & 0xffff0000u) * w[8 + 2 * e2 + 1]; }
                  a += (fminf(x, 0.f) - log1pf(__expf(-fabsf(x)))) * (1.0f / 16.0f);
                  loc[t0 + i] = a; } }
          const float tot0 = __shfl(a, r);
          const float off = hh ? tot0 : 0.f;
#pragma unroll
          for (int t = 0; t < 32; ++t) { const float v = loc[t] + off; Bw[(32 * hh + t) * 33 + r] = v; Btab[(row0 + 32 * hh + t) * 256 + h * 64 + dk] = v; }
          asm volatile("s_waitcnt lgkmcnt(0)" ::: "memory");
          bl = Bw[63 * 33 + r]; }
        f32x16 acc[4] = {};
#pragma unroll
        for (int ks = 0; ks < 4; ++ks) { bf16x8 bv;
#pragma unroll
            for (int j = 0; j < 8; ++j) { const int t = 16 * ks + 8 * hh + j;
                bv[j] = (short)f2bf(bf2f(proj[(row0 + t) * NIN + 256 + h * 64 + dk]) * __expf(bl - Bw[t * 33 + r])); }
#pragma unroll
            for (int dvb = 0; dvb < 4; ++dvb) { bf16x8 av;
#pragma unroll
                for (int j = 0; j < 8; ++j) { const int t = 16 * ks + 8 * hh + j; av[j] = (short)proj[(row0 + t) * NIN + 512 + h * 128 + 32 * dvb + r]; }
                acc[dvb] = __builtin_amdgcn_mfma_f32_32x32x16_bf16(av, bv, acc[dvb], 0, 0, 0); } }
#pragma unroll
        for (int dvb = 0; dvb < 4; ++dvb) { float* go = Gst + ((size_t)item * 128 + 32 * dvb) * 64 + dk;
#pragma unroll
            for (int i = 0; i < 16; ++i) go[(size_t)crow(i, hh) * 64] = acc[dvb][i]; }
        if (hh == 0) Gdv[(size_t)item * 64 + dk] = __expf(bl);
        asm volatile("s_waitcnt lgkmcnt(0)" ::: "memory");
    }
}
__device__ __forceinline__ void gla_scan(float* Gst, const float* Gdv) {
    const int gt = blockIdx.x * 512 + opaque_tid(), GT = gridDim.x * 512;
    for (int e = gt; e < 16 * 8192; e += GT) { const int bh = e >> 13, idx = e & 8191, dk = idx & 63;
        float* base = Gst + (size_t)bh * 128 * 8192 + idx; const float* dvp = Gdv + (size_t)bh * 128 * 64 + dk;
        float s = 0.f;
        for (int n0 = 0; n0 < 128; n0 += 16) { float u[16], dd[16];
#pragma unroll
            for (int i = 0; i < 16; ++i) { u[i] = base[(size_t)(n0 + i) * 8192]; dd[i] = dvp[(n0 + i) * 64]; }
#pragma unroll
            for (int i = 0; i < 16; ++i) { base[(size_t)(n0 + i) * 8192] = s; s = dd[i] * s + u[i]; } }
    }
}
__device__ __forceinline__ void gla_pass_c(const bf16_t* proj, const float* Btab, const float* Gst, const float* gout, bf16_t* mixed) {
    const int tid = opaque_tid(), lane = tid & 63, r = lane & 31, hh = lane >> 5, gw = blockIdx.x * 8 + (tid >> 6), NGW = gridDim.x * 8;
    for (int u = gw; u < 16 * 128 * 2; u += NGW) { const int item = u >> 1, tb = __builtin_amdgcn_readfirstlane(u & 1);
        const int bh = item >> 7, n = item & 127, b = bh >> 2, h = bh & 3; const size_t row0 = (size_t)b * SEQ + (size_t)n * 64;
        const int tl = 32 * tb + r;
        bf16x8 qe[4];
        { const bf16_t* qp = proj + (row0 + tl) * NIN + h * 64; const float* bp = Btab + (row0 + tl) * 256 + h * 64;
#pragma unroll
          for (int ks = 0; ks < 4; ++ks) { const u32x4 qw = *(const u32x4*)(qp + 16 * ks + 8 * hh); const f32x4 b0 = *(const f32x4*)(bp + 16 * ks + 8 * hh), b1 = *(const f32x4*)(bp + 16 * ks + 8 * hh + 4);
              u32x4 w; w.x = pk2(__uint_as_float(qw[0] << 16) * 0.125f * __expf(b0[0]), __uint_as_float(qw[0] & 0xffff0000u) * 0.125f * __expf(b0[1]));
                       w.y = pk2(__uint_as_float(qw[1] << 16) * 0.125f * __expf(b0[2]), __uint_as_float(qw[1] & 0xffff0000u) * 0.125f * __expf(b0[3]));
                       w.z = pk2(__uint_as_float(qw[2] << 16) * 0.125f * __expf(b1[0]), __uint_as_float(qw[2] & 0xffff0000u) * 0.125f * __expf(b1[1]));
                       w.w = pk2(__uint_as_float(qw[3] << 16) * 0.125f * __expf(b1[2]), __uint_as_float(qw[3] & 0xffff0000u) * 0.125f * __expf(b1[3]));
              qe[ks] = __builtin_bit_cast(bf16x8, w); } }
        f32x16 o[4] = {};
#pragma unroll
        for (int dvb = 0; dvb < 4; ++dvb) { const float* sp = Gst + ((size_t)item * 128 + 32 * dvb + r) * 64;
#pragma unroll
          for (int ks = 0; ks < 4; ++ks) { const f32x4 s0 = *(const f32x4*)(sp + 16 * ks + 8 * hh), s1 = *(const f32x4*)(sp + 16 * ks + 8 * hh + 4);
              u32x4 sw; sw.x = pk2(s0[0], s0[1]); sw.y = pk2(s0[2], s0[3]); sw.z = pk2(s1[0], s1[1]); sw.w = pk2(s1[2], s1[3]);
              o[dvb] = __builtin_amdgcn_mfma_f32_32x32x16_bf16(qe[ks], __builtin_bit_cast(bf16x8, sw), o[dvb], 0, 0, 0); } }
        for (int sb = 0; sb <= tb; ++sb) {
            f32x16 x = {};
            const int sl = 32 * sb + r; const bf16_t* kp = proj + (row0 + sl) * NIN + 256 + h * 64; const float* bp = Btab + (row0 + sl) * 256 + h * 64;
#pragma unroll
            for (int ks = 0; ks < 4; ++ks) { const u32x4 kw = *(const u32x4*)(kp + 16 * ks + 8 * hh); const f32x4 b0 = *(const f32x4*)(bp + 16 * ks + 8 * hh), b1 = *(const f32x4*)(bp + 16 * ks + 8 * hh + 4);
                u32x4 w; w.x = pk2(__uint_as_float(kw[0] << 16) * __expf(-b0[0]), __uint_as_float(kw[0] & 0xffff0000u) * __expf(-b0[1]));
                         w.y = pk2(__uint_as_float(kw[1] << 16) * __expf(-b0[2]), __uint_as_float(kw[1] & 0xffff0000u) * __expf(-b0[3]));
                         w.z = pk2(__uint_as_float(kw[2] << 16) * __expf(-b1[0]), __uint_as_float(kw[2] & 0xffff0000u) * __expf(-b1[1]));
                         w.w = pk2(__uint_as_float(kw[3] << 16) * __expf(-b1[2]), __uint_as_float(kw[3] & 0xffff0000u) * __expf(-b1[3]));
                x = __builtin_amdgcn_mfma_f32_32x32x16_bf16(__builtin_bit_cast(bf16x8, w), qe[ks], x, 0, 0, 0); }
            if (sb == tb) {
#pragma unroll
                for (int i = 0; i < 16; ++i) if (crow(i, hh) > r) x[i] = 0.f; }
#pragma unroll
            for (int s2 = 0; s2 < 2; ++s2) { u32x4 xw; xw.x = pk2(x[8 * s2], x[8 * s2 + 1]); xw.y = pk2(x[8 * s2 + 2], x[8 * s2 + 3]); xw.z = pk2(x[8 * s2 + 4], x[8 * s2 + 5]); xw.w = pk2(x[8 * s2 + 6], x[8 * s2 + 7]);
#pragma unroll
                for (int dvb = 0; dvb < 4; ++dvb) { bf16x8 vb;
#pragma unroll
                    for (int j = 0; j < 8; ++j) { const int sk = 32 * sb + 16 * s2 + 8 * (j >> 2) + 4 * hh + (j & 3); vb[j] = (short)proj[(row0 + sk) * NIN + 512 + h * 128 + 32 * dvb + r]; }
                    o[dvb] = __builtin_amdgcn_mfma_f32_32x32x16_bf16(__builtin_bit_cast(bf16x8, xw), vb, o[dvb], 0, 0, 0); } } }
#pragma unroll
        for (int i = 0; i < 16; ++i) { const int t = 32 * tb + crow(i, hh);
            const float tot = half_sum32((o[0][i] * o[0][i] + o[1][i] * o[1][i]) + (o[2][i] * o[2][i] + o[3][i] * o[3][i]));
            const float rr = 1.0f / sqrtf(tot * (1.0f / 128.0f) + EPS);
#pragma unroll
            for (int dvb = 0; dvb < 4; ++dvb) { const float g = bf2f(proj[(row0 + t) * NIN + 1024 + h * 128 + 32 * dvb + r]);
                const float val = o[dvb][i] * rr * gout[32 * dvb + r] * (g / (1.0f + __expf(-g)));
                mixed[(row0 + t) * DM + h * 128 + 32 * dvb + r] = (bf16_t)f2bf(val); } }
    }
}
}
#define XB_TMO      128
#define XB_XCNT(j)  (256  + 64 * (j))
#define XB_XSUB(j)  (1280 + 64 * (j))
#define XB_XGEN(j)  (2304 + 64 * (j))
#define XB_TOP      3328
#define XB_TOPGEN   3392
#define XCD_BAR_WORDS 3456
#define XB_SPIN_CAP (1u << 18)

__device__ __forceinline__ unsigned xb_ld(unsigned* p)              { return __hip_atomic_load(p, __ATOMIC_RELAXED, __HIP_MEMORY_SCOPE_AGENT); }
__device__ __forceinline__ unsigned xb_add(unsigned* p, unsigned v) { return __hip_atomic_fetch_add(p, v, __ATOMIC_RELAXED, __HIP_MEMORY_SCOPE_AGENT); }
__device__ __forceinline__ unsigned xb_xcc_id() { return (unsigned)__builtin_amdgcn_s_getreg((3 << 11) | 20) & 0xFu; }
#define XB_SPIN(cond, bar) do { unsigned _sp = 0; while (cond) { __builtin_amdgcn_s_sleep(1); \
    if ((++_sp & 255u) == 0u) { if (xb_ld(&(bar)[XB_TMO])) break; if (_sp > XB_SPIN_CAP) { atomicAdd(&(bar)[XB_TMO], 1u); break; } } } } while (0)

struct XcdBarrier {
    unsigned* bar; unsigned x;
    volatile LAS unsigned* st;
};

__device__ __forceinline__ XcdBarrier xcd_barrier_post(unsigned* bar, volatile LAS unsigned* st) {
    XcdBarrier b; b.bar = bar; b.x = xb_xcc_id(); b.st = st;
    if (threadIdx.x == 0) (void)xb_add(&bar[XB_XCNT(b.x)], 1u);
    return b;
}
__device__ __forceinline__ void xcd_barrier_complete(unsigned* bar, unsigned x, unsigned& nloc, unsigned& nx) {
    const unsigned G = gridDim.x * gridDim.y * gridDim.z;
    unsigned sum, cnt, mine, sp = 0u;
    for (;;) {
        sum = 0u; cnt = 0u; mine = 0u;
#pragma unroll
        for (unsigned j = 0; j < 16; ++j) { const unsigned c = xb_ld(&bar[XB_XCNT(j)]); sum += c; cnt += (c > 0u) ? 1u : 0u; mine = (j == x) ? c : mine; }
        if (sum == G) break;
        __builtin_amdgcn_s_sleep(1);
        if ((++sp & 255u) == 0u) { if (xb_ld(&bar[XB_TMO])) break; if (sp > XB_SPIN_CAP) { atomicAdd(&bar[XB_TMO], 1u); break; } }
    }
    nloc = mine > 0u ? mine : 1u; nx = cnt > 0u ? cnt : 1u;
}

__device__ __forceinline__ void xcd_barrier(const XcdBarrier& b) {
    asm volatile("s_waitcnt vmcnt(0)" ::: "memory");
    __syncthreads();
    if (threadIdx.x == 0) {
        unsigned* bar = b.bar;
        __builtin_amdgcn_s_waitcnt(0);
        unsigned nloc = b.st[0], nx = b.st[1];
        if (nloc == 0u) { xcd_barrier_complete(bar, b.x, nloc, nx); b.st[0] = nloc; b.st[1] = nx; }
        const unsigned old = xb_add(&bar[XB_XSUB(b.x)], 1u);
        const unsigned gen = old / nloc;
        if (old + 1u == (gen + 1u) * nloc) {
            __builtin_amdgcn_fence(__ATOMIC_RELEASE, "agent");
            asm volatile("s_waitcnt vmcnt(0)" ::: "memory");
            const unsigned og = xb_add(&bar[XB_TOP], 1u);
            const unsigned tg = og / nx;
            if (og + 1u == (tg + 1u) * nx) xb_add(&bar[XB_TOPGEN], 1u);
            else XB_SPIN(xb_ld(&bar[XB_TOPGEN]) == tg, bar);
            __builtin_amdgcn_fence(__ATOMIC_ACQUIRE, "agent");
            xb_add(&bar[XB_XGEN(b.x)], 1u);
            asm volatile("s_waitcnt vmcnt(0)" ::: "memory");
        } else {
            XB_SPIN(xb_ld(&bar[XB_XGEN(b.x)]) == gen, bar);
            __builtin_amdgcn_fence(__ATOMIC_ACQUIRE, "agent");
            asm volatile("s_waitcnt vmcnt(0)" ::: "memory");
        }
    }
    __syncthreads();
}
#ifndef PHM
#define PHM 0xffff
#endif
#ifndef REP
#define REP 0
#endif
#ifndef USE_XB
#define USE_XB 1
#endif
#if USE_XB
#define GSYNC() xcd_barrier(xbar)
#else
#define GSYNC() grid.sync()
#endif
#if REP
#define REPEAT(k) _Pragma("unroll 1") for (int rep_ = 0, nrep_ = opaque_int((((REP) >> (k)) & 1) + 1); rep_ < nrep_; ++rep_)
#else
#define REPEAT(k)
#endif
struct Args { const float* in[20]; float* out; unsigned char* ws; float inv_freq[32]; };
__global__ void __launch_bounds__(512, 2) mega_fwd(Args a) {
    using namespace mk;
    extern __shared__ __attribute__((aligned(16))) unsigned char lds[];
    cg::grid_group grid = cg::this_grid();
    const int tid = opaque_tid(), lane = tid & 63, wave = __builtin_amdgcn_readfirstlane(tid >> 6);
    const int G = gridDim.x;
    PG8_LAS unsigned char* ldsl = (PG8_LAS unsigned char*)lds;
    LAS float* ldsf = (LAS float*)lds;
    unsigned char* ws = a.ws;
    const float* x_in = a.in[0]; const float* c_in = a.in[1]; const int* pos = (const int*)a.in[2];
    const float* w_ada = a.in[3]; const float* b_ada = a.in[4];
    float* mod = (float*)(ws + WS_MOD); float* cosT = (float*)(ws + WS_COS); float* sinT = (float*)(ws + WS_SIN);
    bf16_t* HN = (bf16_t*)(ws + WS_HN); bf16_t* QN = (bf16_t*)(ws + WS_QN); bf16_t* KVN = (bf16_t*)(ws + WS_KVN);
    float* GST = (float*)(ws + WS_GST); float* GDV = (float*)(ws + WS_GDV); float* BT = (float*)(ws + WS_BT);
    bf16_t* PROJ = (bf16_t*)(ws + WS_R + R_PROJ); bf16_t* QB_ = (bf16_t*)(ws + WS_R + R_Q); bf16_t* KB_ = (bf16_t*)(ws + WS_R + R_K); bf16_t* VB_ = (bf16_t*)(ws + WS_R + R_V);
    bf16_t* HB = (bf16_t*)(ws + WS_R);
    float* xout = a.out;
#if USE_XB
    volatile LAS unsigned* MISC = (volatile LAS unsigned*)(ldsl + MISC_OFF);
    if (tid < 16) MISC[tid] = 0u;
    __syncthreads();
    const XcdBarrier xbar = xcd_barrier_post((unsigned*)(ws + WS_BAR), MISC);
#endif

#if (PHM >> 0) & 1
    for (int u = blockIdx.x; u < 192; u += G) adaln_unit(u, c_in, w_ada, b_ada, mod, ldsf);
    __syncthreads();
    { const int gt = blockIdx.x * 512 + tid, GT = G * 512;
      for (int e = gt; e < T * 32; e += GT) { const int t = e >> 5, j = e & 31;
          const float ang = (float)pos[t] * a.inv_freq[j];
          const double turns = (double)ang * 0.15915494309189535; const float fr = (float)(turns - rint(turns)) * 6.283185307179586f;
          cosT[e] = cosf(fr); sinT[e] = sinf(fr); } }
    { LAS float* scr = (LAS float*)(ldsl + wave * 16384);
      const int gw = blockIdx.x * 8 + wave, NGW = G * 8;
      constexpr int I_IN = 16 * 64, I_Q = 4 * 24, I_KV = 2 * 32, I_O = 16 * 32, I_1 = 16 * 128, I_2 = 64 * 32, I_L = I_IN + I_Q + I_KV + I_O + I_1 + I_2;
      for (int it = gw; it < DEPTH * I_L; it += NGW) { const int l = it / I_L; int r = it % I_L; unsigned char* wl = ws + WS_W + (size_t)l * W_LAYER;
          if (r < I_IN) { transpose_item(a.in[5] + (size_t)l * 1024 * 2000, 1024, 2000, 2048, (bf16_t*)(wl + W_IN), 1, scr, r, lane); continue; } r -= I_IN;
          if (r < I_Q) { transpose_item(a.in[10] + (size_t)l * 256 * 768, 256, 768, 768, (bf16_t*)(wl + W_Q), 2, scr, r, lane); continue; } r -= I_Q;
          if (r < I_KV) { transpose_item(a.in[12] + (size_t)l * 128 * 1024, 128, 1024, 1024, (bf16_t*)(wl + W_KV), 0, scr, r, lane); continue; } r -= I_KV;
          if (r < I_O) { transpose_item(a.in[17] + (size_t)l * 1024 * 1024, 1024, 1024, 1024, (bf16_t*)(wl + W_O), 0, scr, r, lane); continue; } r -= I_O;
          if (r < I_1) { transpose_item(a.in[18] + (size_t)l * 1024 * 4096, 1024, 4096, 4096, (bf16_t*)(wl + W_1), 0, scr, r, lane); continue; } r -= I_1;
          transpose_item(a.in[19] + (size_t)l * 4096 * 1024, 4096, 1024, 1024, (bf16_t*)(wl + W_2), 0, scr, r, lane); } }
#endif
    grid.sync();
#if (PHM >> 1) & 1
    norm_rows(x_in, HN, mod, 0, 1024);
#endif
    GSYNC();

#pragma unroll 1
    for (int l = 0; l < DEPTH; ++l) {
        const float* modl = mod + (size_t)l * 4 * NMOD;
        unsigned char* wl = ws + WS_W + (size_t)l * W_LAYER;
        const float* xin = l == 0 ? x_in : xout;
#if (PHM >> 2) & 1
        REPEAT(2) { pg8::Gemm g{HN, (const bf16_t*)(wl + W_IN), T, NIN, DM}; pg8::StaticOrder S; S.init(T, NIN, G, (int)blockIdx.x);
          pg8::EpiBf16<0> E{PROJ, NIN, nullptr, 0, 0, 1.f};
          pg8::gemm_phase<pg8::EpiBf16<0>, pg8::StaticOrder, true, true>(ldsl, g, S, E); }
#endif
        GSYNC();
#if (PHM >> 3) & 1
        REPEAT(3) prep_tokens(PROJ, QN, KVN, KB_, a.in[9] + l * 256, a.in[11] + l * 128, a.in[16] + l * 64, cosT, sinT);
#endif
#if (PHM >> 4) & 1
        REPEAT(4) gla_pass_a(ldsf, PROJ, a.in[6] + (size_t)l * 16 * 256, a.in[7] + l * 256, BT, GST, GDV);
#endif
        GSYNC();
#if (PHM >> 5) & 1
        REPEAT(5) { int kq = 256; asm volatile("" : "+s"(kq));
          pg8::Gemm g{QN, (const bf16_t*)(wl + W_Q), T, 512, kq}; pg8::StaticOrder S; S.init(T, 512, G, (int)blockIdx.x);
          pg8::EpiQN E{QB_, a.in[13] + l * 128, (PG8_LAS float*)(ldsl + EPI_OFF)};
          pg8::gemm_phase<pg8::EpiQN, pg8::StaticOrder, true, true>(ldsl, g, S, E); }
#endif
#if (PHM >> 13) & 1
        REPEAT(5) { int kq = 256; asm volatile("" : "+s"(kq));
          pg8::Gemm g{QN, (const bf16_t*)(wl + W_Q) + 512 * 256, T, 256, kq}; pg8::StaticOrder S; S.init(T, 256, G, (int)blockIdx.x);
          pg8::EpiQR E{QB_, a.in[15] + l * 64, cosT, sinT};
          pg8::gemm_phase<pg8::EpiQR, pg8::StaticOrder, true, true>(ldsl, g, S, E); }
#endif
#if (PHM >> 6) & 1
        REPEAT(5) { int kk = 128; asm volatile("" : "+s"(kk));
          pg8::Gemm g{KVN, (const bf16_t*)(wl + W_KV), T, 1024, kk}; pg8::StaticOrder S; S.init(T, 1024, G, (int)blockIdx.x);
          pg8::EpiKV E{KB_, VB_, a.in[14] + l * 128, (PG8_LAS float*)(ldsl + EPI_OFF)};
          pg8::gemm_phase<pg8::EpiKV, pg8::StaticOrder, true, true>(ldsl, g, S, E); }
#endif
#if (PHM >> 7) & 1
        gla_scan(GST, GDV);
#endif
        GSYNC();
#if (PHM >> 8) & 1
        REPEAT(8) att::attn_phase((char*)lds, (const att::bf16*)QB_, (const att::bf16*)KB_, (const att::bf16*)VB_, (att::bf16*)HN);
#endif
        __syncthreads();
#if (PHM >> 9) & 1
        REPEAT(9) gla_pass_c(PROJ, BT, GST, a.in[8] + l * 128, HN);
#endif
        GSYNC();
#if (PHM >> 10) & 1
        { pg8::Gemm g{HN, (const bf16_t*)(wl + W_O), T, DM, DM}; pg8::StaticOrder S; S.init(T, DM, G, (int)blockIdx.x);
          pg8::EpiResGate E{xin, xout, modl + 2048};
          pg8::gemm_phase<pg8::EpiResGate, pg8::StaticOrder, true, true>(ldsl, g, S, E); }
#endif
        GSYNC();
        REPEAT(14) norm_rows(xout, HN, modl, 3072, 4096);
        GSYNC();
#if (PHM >> 11) & 1
        REPEAT(11) { pg8::Gemm g{HN, (const bf16_t*)(wl + W_1), T, DFF, DM}; pg8::StaticOrder S; S.init(T, DFF, G, (int)blockIdx.x);
          pg8::EpiBf16<2> E{HB, DFF, nullptr, 0, 0, 1.f};
          pg8::gemm_phase<pg8::EpiBf16<2>, pg8::StaticOrder, true, true>(ldsl, g, S, E); }
#endif
        GSYNC();
#if (PHM >> 12) & 1
        { pg8::Gemm g{HB, (const bf16_t*)(wl + W_2), T, DM, DFF}; pg8::StaticOrder S; S.init(T, DM, G, (int)blockIdx.x);
          pg8::EpiResGate E{xout, xout, modl + 5120};
          pg8::gemm_phase<pg8::EpiResGate, pg8::StaticOrder, true, true>(ldsl, g, S, E); }
#endif
        if (l + 1 < DEPTH) {
            GSYNC();
            norm_rows(xout, HN, mod + (size_t)(l + 1) * 4 * NMOD, 0, 1024);
            GSYNC();
        }
    }
}

extern "C" void kernel_launch(void* const* d_in, const int* in_sizes, int n_in, void* d_out, int out_size, void* d_ws, size_t ws_size, hipStream_t stream) {
    static int grid = 0;
    if (grid == 0) {
        if (n_in != 20 || out_size != mk::T * mk::DM || ws_size < mk::WS_END) { fprintf(stderr, "kernel_launch: unexpected shapes (n_in %d out %d ws %zu)\n", n_in, out_size, ws_size); grid = -1; return; }
        int dev = 0, cus = 0, per = 0;
        (void)hipGetDevice(&dev); (void)hipDeviceGetAttribute(&cus, hipDeviceAttributeMultiprocessorCount, dev);
        (void)hipFuncSetAttribute((const void*)mega_fwd, hipFuncAttributeMaxDynamicSharedMemorySize, mk::LDS_BYTES);
        if (hipOccupancyMaxActiveBlocksPerMultiprocessor(&per, (const void*)mega_fwd, 512, mk::LDS_BYTES) != hipSuccess || per < 1) per = 1;
        (void)hipGetLastError();
        grid = cus * per; if (grid > 256) grid = 256;
    }
    if (grid < 0) return;
    (void)hipMemsetAsync((unsigned char*)d_ws + mk::WS_BAR, 0, XCD_BAR_WORDS * sizeof(unsigned), stream);
    Args a{};
    for (int i = 0; i < 20; ++i) a.in[i] = (const float*)d_in[i];
    a.out = (float*)d_out; a.ws = (unsigned char*)d_ws;
    for (int j = 0; j < 32; ++j) a.inv_freq[j] = powf(10000.0f, -(float)(2 * j) / 64.0f);
    void* args[] = {&a};
    hipError_t e = hipLaunchCooperativeKernel((const void*)mega_fwd, dim3(grid), dim3(512), args, mk::LDS_BYTES, stream);
    if (e != hipSuccess) fprintf(stderr, "kernel_launch: cooperative launch failed: %s (grid %d)\n", hipGetErrorString(e), grid);
}
```

```cpp
#include <hip/hip_runtime.h>
#include <hip/hip_bf16.h>
#include <hip/hip_cooperative_groups.h>
#include <cstdio>
#include <cstdint>
#include <cmath>
namespace cg = cooperative_groups;
#define LAS __attribute__((address_space(3)))
__device__ __forceinline__ int opaque_tid() { int t = threadIdx.x; asm volatile("" : "+v"(t)); return t; }
__device__ __forceinline__ int opaque_int(int v) { asm volatile("" : "+s"(v)); return v; }
namespace pg8 {
#define PG8_LAS __attribute__((address_space(3)))
typedef unsigned short bf16_t;
typedef short bf16x8 __attribute__((ext_vector_type(8)));
typedef float f32x4 __attribute__((ext_vector_type(4)));
typedef unsigned u32x4 __attribute__((ext_vector_type(4)));
constexpr int BM = 256, BK = 64, HALF = 128, HTB = HALF * BK * 2  , STAGE_BYTES = 8 * HTB, NXCD = 8, WGM = 8;

__host__ __device__ __forceinline__ int lds_byte(int r, int c) { const int st = (r >> 4) * 2 + (c >> 5), rr = r & 15, cc = c & 31, ob = rr * 64 + cc * 2; return st * 1024 + (ob ^ (((ob >> 9) & 1) << 5)); }
__host__ __device__ __forceinline__ void stage_rc(int b, int& R, int& C) { const int st = b / 1024, sb = b % 1024, swz = sb ^ (((sb >> 9) & 1) << 5); R = (st >> 1) * 16 + swz / 64; C = (st & 1) * 32 + (swz % 64) / 2; }
__host__ __device__ __forceinline__ int perm32(int rho) { const int n = rho >> 4, i = rho & 15; return 8 * (i >> 2) + 4 * n + (i & 3); }

struct Unit { int pm, pn; };
struct Gemm { const bf16_t* A; const bf16_t* Bt; int M, N, K; };

struct StaticOrder {
    int nM, nN, nwg, G, c;
    __host__ __device__ void init(int M, int N, int G_, int c_) { nM = M / BM; nN = N / BM; nwg = nM * nN; G = G_; c = c_; }
    __host__ __device__ bool next(int i, Unit& u) const {
        const long L = (long)i * G + c; if (L >= nwg) return false;
        int wgid = (int)L; { const int q = nwg / NXCD, r = nwg % NXCD, xcd = wgid % NXCD, off = wgid / NXCD; wgid = (xcd < r ? xcd * (q + 1) : r * (q + 1) + (xcd - r) * q) + off; }
        const int nig = WGM * nN, gid = wgid / nig, fm = gid * WGM, gsz = (nM - fm) < WGM ? (nM - fm) : WGM;
        u.pm = fm + ((wgid % nig) % gsz); u.pn = (wgid % nig) / gsz; return true;
    }
    __device__ __forceinline__ void a_ready(const Unit&) const {}
    __device__ __forceinline__ void done(const Unit&) const {}
};

__device__ __forceinline__ unsigned cvt_pk_bf16(float lo, float hi) { unsigned r; asm volatile("v_cvt_pk_bf16_f32 %0, %1, %2" : "=v"(r) : "v"(lo), "v"(hi)); return r; }
typedef float f32x2 __attribute__((ext_vector_type(2)));
__device__ __forceinline__ f32x2 gelu_pk(f32x2 v) {
    const f32x2 av = __builtin_elementwise_abs(v), d = av * 0.2316418882f + 1.0f;
    f32x2 t; t.x = __builtin_amdgcn_rcpf(d.x); t.y = __builtin_amdgcn_rcpf(d.y);
    f32x2 q = t * 0.5307027145f + (-0.7265760135f); q = q * t + 0.7107068705f; q = q * t + (-0.142248368f); q = q * t + 0.127414796f; q = q * t;
    const f32x2 s = (v * v) * (-0.72134752044f);
    f32x2 e; e.x = __builtin_amdgcn_exp2f(s.x); e.y = __builtin_amdgcn_exp2f(s.y);
    const f32x2 m = v * (q * e), r = v - m;
    f32x2 o; o.x = v.x < 0.f ? m.x : r.x; o.y = v.y < 0.f ? m.y : r.y; return o;
}

template <int ACT  > struct EpiBf16 {
    static constexpr bool PERM = true, AFTER_DRAIN = false; static_assert(ACT == 0 || ACT == 1 || ACT == 2, "EpiBf16: ACT is 0 (none), 1 (gelu_pk) or 2 (relu squared)");
    bf16_t* O; int ldc; const float* bias; int split_cols; size_t split_stride; float scale0; const float* rowss = nullptr; int bstride = 0;
    __device__ __forceinline__ void operator()(const f32x4 (&acc)[2][2][4][2], const Unit& u, int wr, int wc, int fr, int fq) const {
        const int row0 = u.pm * BM + wr * 64 + fr; int colt = u.pn * BM; bf16_t* base = O;
        float sc = 1.f; if (split_cols) { const int t = colt / split_cols; base += (size_t)t * split_stride; colt -= t * split_cols; if (t == 0) sc = scale0; }
        const int col0 = colt + wc * 32 + 8 * fq, bcol0 = u.pn * BM + wc * 32 + 8 * fq;
        const float* bias = this->bias ? this->bias + (size_t)(u.pm >> 5) * bstride : nullptr;
        f32x4 bv[2][2];
#pragma unroll
        for (int bj = 0; bj < 2; ++bj)
#pragma unroll
            for (int n = 0; n < 2; ++n) bv[bj][n] = bias ? *(const f32x4*)(bias + bcol0 + bj * HALF + 4 * n) : (f32x4){0.f, 0.f, 0.f, 0.f};
#pragma unroll
        for (int ai = 0; ai < 2; ++ai)
#pragma unroll
            for (int m = 0; m < 4; ++m) { bf16_t* rowp = base + (size_t)(row0 + ai * HALF + m * 16) * ldc + col0;
                const float rs = rowss ? __builtin_amdgcn_rsqf(rowss[row0 + ai * HALF + m * 16] * (1.0f / 1024.0f) + 1e-6f) : 1.0f;
#pragma unroll
                for (int bj = 0; bj < 2; ++bj) { f32x4 v0 = acc[ai][bj][m][0] * rs + bv[bj][0], v1 = acc[ai][bj][m][1] * rs + bv[bj][1];
                    if (ACT == 1) { f32x2 a = gelu_pk((f32x2){v0[0], v0[1]}), b = gelu_pk((f32x2){v0[2], v0[3]}), c = gelu_pk((f32x2){v1[0], v1[1]}), d = gelu_pk((f32x2){v1[2], v1[3]});
                        v0 = (f32x4){a.x, a.y, b.x, b.y}; v1 = (f32x4){c.x, c.y, d.x, d.y}; }
                    if (ACT == 2) { v0 = __builtin_elementwise_max(v0, (f32x4){0.f, 0.f, 0.f, 0.f}); v1 = __builtin_elementwise_max(v1, (f32x4){0.f, 0.f, 0.f, 0.f}); v0 = v0 * v0; v1 = v1 * v1; }
                    v0 = v0 * sc; v1 = v1 * sc; u32x4 w; w.x = cvt_pk_bf16(v0[0], v0[1]); w.y = cvt_pk_bf16(v0[2], v0[3]); w.z = cvt_pk_bf16(v1[0], v1[1]); w.w = cvt_pk_bf16(v1[2], v1[3]);
                    *(u32x4*)(rowp + bj * HALF) = w; } }
    }
};
template <class Epi, class Sched, bool ALIGN_EPI = false, bool SP2 = false>
__device__ __forceinline__ void gemm_phase(PG8_LAS unsigned char* lds, const Gemm g, const Sched& S, const Epi& E) {
    const int tid = opaque_tid(), wid = __builtin_amdgcn_readfirstlane(tid >> 6), lane = tid & 63, wr = wid >> 2, wc = wid & 3, fr = lane & 15, fq = lane >> 4;
    const int K = g.K, nt = K / BK;
    unsigned voffA[2], voffB[2];
#pragma unroll
    for (int i = 0; i < 2; ++i) { int R, C; stage_rc(tid * 16 + i * 8192, R, C); const int Rb = Epi::PERM ? ((R & ~31) + perm32(R & 31)) : R;
        voffA[i] = (unsigned)(R * K + C) * 2u; voffB[i] = (unsigned)(Rb * K + C) * 2u; }
    const size_t kstep = (size_t)(BK * 2);
    const size_t hstep = (size_t)HALF * K * 2;
    const size_t tstep = 2 * hstep;
    const unsigned ldsw = (unsigned)wid * 1024u;
    const int aoff = lds_byte(wr * 64 + fr, fq * 8), boff = lds_byte(wc * 32 + fr, fq * 8);
#define PG8_SA(b, h) (((b) * 2 + (h)) * HTB)
#define PG8_SB(b, h) ((4 + (b) * 2 + (h)) * HTB)
#define PG8_STAGE(bufoff, gbase, voff) do { _Pragma("unroll") for (int _i = 0; _i < 2; ++_i) \
        __builtin_amdgcn_global_load_lds((const unsigned*)((const char*)(gbase) + (voff)[_i]), (PG8_LAS unsigned*)(lds + (bufoff) + ldsw + _i * 8192), 16, 0, 0); } while (0)
#define PG8_LDA(dst, b, h) do { _Pragma("unroll") for (int m = 0; m < 4; ++m) _Pragma("unroll") for (int k = 0; k < 2; ++k) dst[m][k] = *(const PG8_LAS bf16x8*)(lds + PG8_SA(b, h) + aoff + m * 2048 + k * 1024); } while (0)
#define PG8_LDB(dst, b, h) do { _Pragma("unroll") for (int n = 0; n < 2; ++n) _Pragma("unroll") for (int k = 0; k < 2; ++k) dst[n][k] = *(const PG8_LAS bf16x8*)(lds + PG8_SB(b, h) + boff + n * 2048 + k * 1024); } while (0)
#define PG8_MMA(ai, bj, At, Bt) do { __builtin_amdgcn_s_setprio(1); _Pragma("unroll") for (int m = 0; m < 4; ++m) _Pragma("unroll") for (int n = 0; n < 2; ++n) _Pragma("unroll") for (int k = 0; k < 2; ++k) \
        acc[ai][bj][m][n] = __builtin_amdgcn_mfma_f32_16x16x32_bf16(Bt[n][k], At[m][k], acc[ai][bj][m][n], 0, 0, 0); __builtin_amdgcn_s_setprio(0); } while (0)
#define PG8_WAIT_V(n) asm volatile("s_waitcnt vmcnt(" #n ")" ::: "memory")
#define PG8_WAIT_L(n) asm volatile("s_waitcnt lgkmcnt(" #n ")" ::: "memory")
#define PG8_BAR __builtin_amdgcn_s_barrier()
#define PG8_SCHED __builtin_amdgcn_sched_barrier(0)
    Unit cur, nxt; int ui = 0;
    if (!S.next(0, cur)) return;
    f32x4 acc[2][2][4][2];
#pragma unroll
    for (int a = 0; a < 2; ++a)
#pragma unroll
        for (int b = 0; b < 2; ++b)
#pragma unroll
            for (int m = 0; m < 4; ++m)
#pragma unroll
                for (int n = 0; n < 2; ++n) acc[a][b][m][n] = (f32x4){0.f, 0.f, 0.f, 0.f};
    bf16x8 At[4][2], B0[2][2], B1[2][2];
    const char* cA = (const char*)g.A + (size_t)cur.pm * tstep; const char* cB = (const char*)g.Bt + (size_t)cur.pn * tstep;
    S.a_ready(cur);
    if constexpr (SP2) {
        PG8_STAGE(PG8_SB(0, 0), cB, voffB); PG8_STAGE(PG8_SB(0, 1), cB + hstep, voffB); PG8_STAGE(PG8_SA(0, 0), cA, voffA); PG8_STAGE(PG8_SA(0, 1), cA + hstep, voffA);
        if (wr == 1) PG8_BAR;
        PG8_WAIT_V(2); PG8_BAR;
        PG8_STAGE(PG8_SB(1, 0), cB + kstep, voffB); PG8_STAGE(PG8_SA(1, 0), cA + kstep, voffA); PG8_STAGE(PG8_SB(1, 1), cB + hstep + kstep, voffB);
        PG8_WAIT_V(6); PG8_BAR;
    } else {
        PG8_STAGE(PG8_SB(0, 0), cB, voffB); PG8_STAGE(PG8_SA(0, 0), cA, voffA); PG8_STAGE(PG8_SB(0, 1), cB + hstep, voffB); PG8_STAGE(PG8_SA(0, 1), cA + hstep, voffA);
        if (wr == 1) PG8_BAR;
        PG8_WAIT_V(4); PG8_BAR;
        PG8_STAGE(PG8_SB(1, 0), cB + kstep, voffB); PG8_STAGE(PG8_SA(1, 0), cA + kstep, voffA); PG8_STAGE(PG8_SB(1, 1), cB + hstep + kstep, voffB);
        PG8_WAIT_V(6); PG8_BAR;
    }
    for (;;) {
        const bool has_next = S.next(ui + 1, nxt);
        const char* nA = has_next ? (const char*)g.A + (size_t)nxt.pm * tstep : cA; const char* nB = has_next ? (const char*)g.Bt + (size_t)nxt.pn * tstep : cB;
        for (int t = 0; t < nt; t += 2) {
            const bool last = (t == nt - 2);
            const char* a1 = cA + (size_t)(t + 1) * kstep;
            const char* a2 = last ? nA : cA + (size_t)(t + 2) * kstep; const char* b2 = last ? nB : cB + (size_t)(t + 2) * kstep;
            const char* a3 = a2 + kstep; const char* b3 = b2 + kstep;
            if (last && has_next) S.a_ready(nxt);
            if constexpr (SP2) {
            PG8_LDB(B0, 0, 0); PG8_LDB(B1, 0, 1); PG8_SCHED; PG8_LDA(At, 0, 0); PG8_STAGE(PG8_SA(1, 1), a1 + hstep, voffA);
            PG8_WAIT_V(8); PG8_WAIT_L(0); PG8_BAR; PG8_MMA(0, 0, At, B0); PG8_MMA(0, 1, At, B1); PG8_BAR; PG8_SCHED;
            PG8_LDA(At, 0, 1); PG8_STAGE(PG8_SB(0, 0), b2, voffB); PG8_STAGE(PG8_SB(0, 1), b2 + hstep, voffB); PG8_STAGE(PG8_SA(0, 0), a2, voffA);
            PG8_WAIT_V(8); PG8_WAIT_L(0); PG8_BAR; PG8_MMA(1, 0, At, B0); PG8_MMA(1, 1, At, B1); PG8_BAR; PG8_SCHED;
            PG8_LDB(B0, 1, 0); PG8_LDB(B1, 1, 1); PG8_SCHED; PG8_LDA(At, 1, 0); PG8_STAGE(PG8_SA(0, 1), a2 + hstep, voffA);
            PG8_WAIT_V(8); PG8_WAIT_L(0); PG8_BAR; PG8_MMA(0, 0, At, B0); PG8_MMA(0, 1, At, B1); PG8_BAR; PG8_SCHED;
            PG8_LDA(At, 1, 1); PG8_STAGE(PG8_SB(1, 0), b3, voffB); PG8_STAGE(PG8_SB(1, 1), b3 + hstep, voffB); PG8_STAGE(PG8_SA(1, 0), a3, voffA);
            PG8_WAIT_V(8); PG8_WAIT_L(0); PG8_BAR; PG8_MMA(1, 0, At, B0); PG8_MMA(1, 1, At, B1); PG8_BAR; PG8_SCHED;
            } else {
            PG8_LDB(B0, 0, 0); PG8_SCHED; PG8_LDA(At, 0, 0); PG8_STAGE(PG8_SA(1, 1), a1 + hstep, voffA);
            PG8_WAIT_L(8); PG8_BAR; PG8_WAIT_L(0); PG8_MMA(0, 0, At, B0); PG8_BAR; PG8_SCHED;
            PG8_LDB(B1, 0, 1); PG8_STAGE(PG8_SB(0, 0), b2, voffB);
            PG8_BAR; PG8_WAIT_L(0); PG8_MMA(0, 1, At, B1); PG8_BAR;
            PG8_LDA(At, 0, 1); PG8_STAGE(PG8_SA(0, 0), a2, voffA);
            PG8_BAR; PG8_WAIT_L(0); PG8_MMA(1, 0, At, B0); PG8_BAR; PG8_SCHED;
            PG8_STAGE(PG8_SB(0, 1), b2 + hstep, voffB);
            PG8_WAIT_V(6); PG8_BAR; PG8_MMA(1, 1, At, B1); PG8_BAR;
            PG8_LDB(B0, 1, 0); PG8_SCHED; PG8_LDA(At, 1, 0); PG8_STAGE(PG8_SA(0, 1), a2 + hstep, voffA);
            PG8_WAIT_L(8); PG8_BAR; PG8_WAIT_L(0); PG8_MMA(0, 0, At, B0); PG8_BAR; PG8_SCHED;
            PG8_LDB(B1, 1, 1); PG8_STAGE(PG8_SB(1, 0), b3, voffB);
            PG8_BAR; PG8_WAIT_L(0); PG8_MMA(0, 1, At, B1); PG8_BAR;
            PG8_LDA(At, 1, 1); PG8_STAGE(PG8_SA(1, 0), a3, voffA);
            PG8_BAR; PG8_WAIT_L(0); PG8_MMA(1, 0, At, B0); PG8_BAR; PG8_SCHED;
            PG8_STAGE(PG8_SB(1, 1), b3 + hstep, voffB);
            PG8_WAIT_V(6); PG8_BAR; PG8_MMA(1, 1, At, B1); PG8_BAR;
            }
        }
        if constexpr (ALIGN_EPI) { if (wr == 0) PG8_BAR; }
        if constexpr (!Epi::AFTER_DRAIN) { E(acc, cur, wr, wc, fr, fq); S.done(cur); }
        if (!has_next) break;
#pragma unroll
        for (int a = 0; a < 2; ++a)
#pragma unroll
            for (int b = 0; b < 2; ++b)
#pragma unroll
                for (int m = 0; m < 4; ++m)
#pragma unroll
                    for (int n = 0; n < 2; ++n) acc[a][b][m][n] = (f32x4){0.f, 0.f, 0.f, 0.f};
        cur = nxt; cA = nA; cB = nB; ++ui;
        if constexpr (ALIGN_EPI) { if (wr == 1) PG8_BAR; }
    }
    PG8_WAIT_V(0);
    if constexpr (!ALIGN_EPI) { if (wr == 0) PG8_BAR; }
    PG8_BAR;
    if constexpr (Epi::AFTER_DRAIN) { E.fused(acc, cur, wr, wc, fr, fq, lds, wid, lane); S.done(cur); }
#undef PG8_SA
#undef PG8_SB
#undef PG8_STAGE
#undef PG8_LDA
#undef PG8_LDB
#undef PG8_MMA
#undef PG8_WAIT_V
#undef PG8_WAIT_L
#undef PG8_BAR
#undef PG8_SCHED
}
typedef unsigned u32x2 __attribute__((ext_vector_type(2)));
constexpr float RMS_EPS_F = 1e-6f;
struct EpiResGate {
    static constexpr bool PERM = false, AFTER_DRAIN = false;
    const float* xin; float* xout; const float* gate;
    bf16_t* anext; const float* scale_next; float* rss_next;
    __device__ __forceinline__ void operator()(const f32x4 (&acc)[2][2][4][2], const Unit& u, int wr_, int wc_, int fr_, int fq_) const {
        int tx = threadIdx.x; asm volatile("" : "+v"(tx));
        const int fr = tx & 15, fq = (tx >> 4) & 3, wc = (tx >> 6) & 3, wr = tx >> 8;
        const int b = u.pm >> 5;
        const int col0 = u.pn * BM + wc * 32 + 4 * fq;
        const float* gp = gate + (size_t)b * 6144 + col0;
        f32x4 gv[2][2], sv[2][2];
#pragma unroll
        for (int bj = 0; bj < 2; ++bj)
#pragma unroll
            for (int n = 0; n < 2; ++n) { gv[bj][n] = *(const f32x4*)(gp + bj * HALF + n * 16);
                sv[bj][n] = anext ? *(const f32x4*)(scale_next + (size_t)b * 6144 + col0 + bj * HALF + n * 16) + 1.0f : (f32x4){0.f, 0.f, 0.f, 0.f}; }
#pragma unroll
        for (int ai = 0; ai < 2; ++ai)
#pragma unroll
            for (int m = 0; m < 4; ++m) { int row = u.pm * BM + ai * HALF + wr * 64 + m * 16 + fr; asm volatile("" : "+v"(row));
                const size_t off = (size_t)row * 1024 + col0; float ss = 0.f;
#pragma unroll
                for (int bj = 0; bj < 2; ++bj)
#pragma unroll
                    for (int n = 0; n < 2; ++n) { const f32x4 xi = *(const f32x4*)(xin + off + bj * HALF + n * 16);
                        const f32x4 xn = xi + gv[bj][n] * acc[ai][bj][m][n];
                        *(f32x4*)(xout + off + bj * HALF + n * 16) = xn;
                        if (anext) { ss += (xn[0] * xn[0] + xn[1] * xn[1]) + (xn[2] * xn[2] + xn[3] * xn[3]);
                            const f32x4 an = xn * sv[bj][n]; u32x2 w; w.x = cvt_pk_bf16(an[0], an[1]); w.y = cvt_pk_bf16(an[2], an[3]);
                            *(u32x2*)(anext + off + bj * HALF + n * 16) = w; } }
                if (anext) { ss += __shfl_xor(ss, 16); ss += __shfl_xor(ss, 32); if (fq == 0) atomicAdd(rss_next + row, ss); }
                asm volatile("" ::: "memory"); }
    }
};
struct EpiQN {
    static constexpr bool PERM = false, AFTER_DRAIN = false;
    bf16_t* Q; const float* gn_nope; PG8_LAS float* P;
    __device__ __forceinline__ void operator()(const f32x4 (&acc)[2][2][4][2], const Unit& u, int wr_, int wc_, int fr_, int fq_) const {
        int tx = threadIdx.x; asm volatile("" : "+v"(tx));
        const int fr = tx & 15, fq = (tx >> 4) & 3, wc = (tx >> 6) & 3, wr = tx >> 8;
        const int b = u.pm >> 5, s0 = (u.pm & 31) * BM;
#pragma unroll
            for (int ai = 0; ai < 2; ++ai)
#pragma unroll
                for (int m = 0; m < 4; ++m)
#pragma unroll
                    for (int bj = 0; bj < 2; ++bj) { float s = 0.f;
#pragma unroll
                        for (int n = 0; n < 2; ++n) { const f32x4 x = acc[ai][bj][m][n]; s += (x[0] * x[0] + x[1] * x[1]) + (x[2] * x[2] + x[3] * x[3]); }
                        s += __shfl_xor(s, 16); s += __shfl_xor(s, 32);
                        if (fq == 0) P[((ai * HALF + wr * 64 + m * 16 + fr) * 2 + bj) * 4 + wc] = s; }
            asm volatile("s_waitcnt lgkmcnt(0)" ::: "memory"); __builtin_amdgcn_s_barrier(); asm volatile("" ::: "memory");
#pragma unroll
            for (int ai = 0; ai < 2; ++ai)
#pragma unroll
                for (int m = 0; m < 4; ++m) { int rl = ai * HALF + wr * 64 + m * 16 + fr; asm volatile("" : "+v"(rl));
#pragma unroll
                    for (int bj = 0; bj < 2; ++bj) { const f32x4 pp = *(const PG8_LAS f32x4*)(P + (rl * 2 + bj) * 4);
                        const float rr = 1.0f / sqrtf(((pp[0] + pp[1]) + (pp[2] + pp[3])) * (1.0f / 128.0f) + RMS_EPS_F);
                        const int head = 2 * u.pn + bj;
                        const unsigned qoff = (unsigned)(((b * 4 + head) * 8192 + s0 + rl) * 192 + wc * 32 + 4 * fq);
#pragma unroll
                        for (int n = 0; n < 2; ++n) { const f32x4 g = *(const f32x4*)(gn_nope + wc * 32 + n * 16 + 4 * fq);
                            const f32x4 v = acc[ai][bj][m][n] * rr * g; u32x2 w; w.x = cvt_pk_bf16(v[0], v[1]); w.y = cvt_pk_bf16(v[2], v[3]);
                            *(u32x2*)(Q + qoff + n * 16) = w; } }
                    asm volatile("" ::: "memory"); }
    }
};
struct EpiQR {
    static constexpr bool PERM = false, AFTER_DRAIN = false;
    bf16_t* Q; const float* gn_rope; const float* cosT; const float* sinT;
    __device__ __forceinline__ void operator()(const f32x4 (&acc)[2][2][4][2], const Unit& u, int wr_, int wc_, int fr_, int fq_) const {
        int tx = threadIdx.x; asm volatile("" : "+v"(tx));
        const int fr = tx & 15, fq = (tx >> 4) & 3, wc = (tx >> 6) & 3, wr = tx >> 8;
        const int b = u.pm >> 5, s0 = (u.pm & 31) * BM;
#pragma unroll
            for (int ai = 0; ai < 2; ++ai)
#pragma unroll
                for (int m = 0; m < 4; ++m) { int rl = ai * HALF + wr * 64 + m * 16 + fr; asm volatile("" : "+v"(rl)); float s = 0.f;
#pragma unroll
                    for (int bj = 0; bj < 2; ++bj)
#pragma unroll
                        for (int n = 0; n < 2; ++n) { const f32x4 x = acc[ai][bj][m][n]; s += (x[0] * x[0] + x[1] * x[1]) + (x[2] * x[2] + x[3] * x[3]); }
                    s += __shfl_xor(s, 16); s += __shfl_xor(s, 32);
                    const float rr = 1.0f / sqrtf(s * (1.0f / 64.0f) + RMS_EPS_F);
                    const size_t t = (size_t)u.pm * BM + rl;
                    bf16_t* qrow = Q + ((size_t)(b * 4 + wc) * 8192 + s0 + rl) * 192 + 128;
#pragma unroll
                    for (int n = 0; n < 2; ++n) { const int j0 = n * 16 + 4 * fq;
                        const f32x4 c4 = *(const f32x4*)(cosT + t * 32 + j0), s4 = *(const f32x4*)(sinT + t * 32 + j0);
                        const f32x4 g1 = *(const f32x4*)(gn_rope + j0), g2 = *(const f32x4*)(gn_rope + 32 + j0);
                        const f32x4 y1 = acc[ai][0][m][n] * rr * g1, y2 = acc[ai][1][m][n] * rr * g2;
                        const f32x4 o1 = y1 * c4 - y2 * s4, o2 = y2 * c4 + y1 * s4;
                        u32x2 w1, w2; w1.x = cvt_pk_bf16(o1[0], o1[1]); w1.y = cvt_pk_bf16(o1[2], o1[3]); w2.x = cvt_pk_bf16(o2[0], o2[1]); w2.y = cvt_pk_bf16(o2[2], o2[3]);
                        *(u32x2*)(qrow + j0) = w1; *(u32x2*)(qrow + 32 + j0) = w2; }
                    asm volatile("" ::: "memory"); }
    }
};
struct EpiKV {
    static constexpr bool PERM = false, AFTER_DRAIN = false;
    bf16_t* Kb; bf16_t* Vb; const float* gn_k; PG8_LAS float* P;
    __device__ __forceinline__ void operator()(const f32x4 (&acc)[2][2][4][2], const Unit& u, int wr_, int wc_, int fr_, int fq_) const {
        int tx = threadIdx.x; asm volatile("" : "+v"(tx));
        const int fr = tx & 15, fq = (tx >> 4) & 3, wc = (tx >> 6) & 3, wr = tx >> 8;
        const int b = u.pm >> 5, s0 = (u.pm & 31) * BM;
#pragma unroll
        for (int ai = 0; ai < 2; ++ai)
#pragma unroll
            for (int m = 0; m < 4; ++m) { float s = 0.f;
#pragma unroll
                for (int n = 0; n < 2; ++n) { const f32x4 x = acc[ai][0][m][n]; s += (x[0] * x[0] + x[1] * x[1]) + (x[2] * x[2] + x[3] * x[3]); }
                s += __shfl_xor(s, 16); s += __shfl_xor(s, 32);
                if (fq == 0) P[(ai * HALF + wr * 64 + m * 16 + fr) * 4 + wc] = s; }
        asm volatile("s_waitcnt lgkmcnt(0)" ::: "memory"); __builtin_amdgcn_s_barrier(); asm volatile("" ::: "memory");
#pragma unroll
        for (int ai = 0; ai < 2; ++ai)
#pragma unroll
            for (int m = 0; m < 4; ++m) { int rl = ai * HALF + wr * 64 + m * 16 + fr; asm volatile("" : "+v"(rl));
                const f32x4 pp = *(const PG8_LAS f32x4*)(P + rl * 4);
                const float rr = 1.0f / sqrtf(((pp[0] + pp[1]) + (pp[2] + pp[3])) * (1.0f / 128.0f) + RMS_EPS_F);
                const size_t tok = (size_t)(b * 4 + u.pn) * 8192 + s0 + rl;
                bf16_t* krow = Kb + tok * 192; bf16_t* vrow = Vb + tok * 128;
#pragma unroll
                for (int n = 0; n < 2; ++n) { const int d0 = wc * 32 + n * 16 + 4 * fq; const f32x4 g = *(const f32x4*)(gn_k + d0);
                    const f32x4 kx = acc[ai][0][m][n] * rr * g, vx = acc[ai][1][m][n];
                    u32x2 w1, w2; w1.x = cvt_pk_bf16(kx[0], kx[1]); w1.y = cvt_pk_bf16(kx[2], kx[3]); w2.x = cvt_pk_bf16(vx[0], vx[1]); w2.y = cvt_pk_bf16(vx[2], vx[3]);
                    *(u32x2*)(krow + d0) = w1; *(u32x2*)(vrow + d0) = w2; }
                asm volatile("" ::: "memory"); }
    }
};
}
namespace att {
using bf16 = __hip_bfloat16;
typedef short bf16x8 __attribute__((ext_vector_type(8)));
typedef short s16x4 __attribute__((ext_vector_type(4)));
typedef float f32x16 __attribute__((ext_vector_type(16)));
typedef float f32x4 __attribute__((ext_vector_type(4)));
typedef unsigned u32x4 __attribute__((ext_vector_type(4)));
constexpr int DQ = 192, DV = 128, LDO = 1024, SEQL = 8192;
constexpr float SCALE = 0.07216878364870322f;
constexpr float THR = 8.f;
constexpr int NW = 8, QBLK = 32, KVBLK = 64, QB = NW * QBLK;
constexpr int SHM_V = KVBLK * DV * 2, SHM_K = KVBLK * DQ * 2;
constexpr int KPITCH = DQ * 2;
constexpr int LDS_NEED = 2 * SHM_V + 2 * SHM_K + NW * 64 * 4;
#define KSWZ(row, colB) ((row) * 384 + ((colB) ^ (((row) & 7) << 4)))
#define SBAR() __builtin_amdgcn_sched_barrier(0)
__device__ __forceinline__ int v_st(int k, int c) { const int kk = (k & ~0xC) | ((k & 4) << 1) | ((k & 8) >> 1); return ((kk >> 3) * 4 + (c >> 5)) * 512 + ((kk & 7) * 32 + (c & 31)) * 2; }
__device__ __forceinline__ int v_rd_base(int lane) { return ((lane & 3) << 3) | (((lane >> 2) & 3) << 6) | (((lane >> 4) & 1) << 5) | (((lane >> 5) & 1) << 8); }
constexpr int v_rd_off(int d0, int ks, int half) { return d0 * 512 + ks * 4096 + half * 2048; }
__device__ __forceinline__ int crow(int r, int hi) { return (r & 3) + 8 * (r >> 2) + 4 * hi; }
__device__ __forceinline__ unsigned cvtpk(float lo, float hi) { unsigned r; asm volatile("v_cvt_pk_bf16_f32 %0, %1, %2" : "=v"(r) : "v"(lo), "v"(hi)); return r; }
__device__ __forceinline__ bf16x8 load8(const bf16* p) { return *reinterpret_cast<const bf16x8*>(p); }
__device__ __forceinline__ void mask_tile(f32x16& p0, f32x16& p1, int dq) {
    const float NEG = -__builtin_inff();
#pragma unroll
    for (int r = 0; r < 16; ++r) {
        const int c = (r & 3) + 8 * (r >> 2);
        if (dq - c < 0) p0[r] = NEG;
        if (dq - c - 32 < 0) p1[r] = NEG;
    }
}
__device__ __forceinline__ void partialSM(f32x16& p0, f32x16& p1, float& m_reg, float& mn, float& alpha) {
    float pmax = p0[0]; for (int r = 1; r < 16; ++r) pmax = fmaxf(pmax, p0[r]); for (int r = 0; r < 16; ++r) pmax = fmaxf(pmax, p1[r]);
    { auto rr = __builtin_amdgcn_permlane32_swap(__float_as_uint(pmax), __float_as_uint(pmax), false, false);
      pmax = fmaxf(__uint_as_float(rr[0]), __uint_as_float(rr[1])); }
    constexpr float C2 = 1.4426950408889634f * SCALE;
    if (__builtin_expect(__all((pmax - m_reg) * SCALE <= THR), 1)) { mn = m_reg; alpha = 1.f; }
    else { mn = fmaxf(m_reg, pmax); alpha = __builtin_amdgcn_exp2f((m_reg - mn) * C2); m_reg = mn; }
    const float mnL = -mn * C2;
    for (int r = 0; r < 16; ++r) p0[r] = fmaf(p0[r], C2, mnL); for (int r = 0; r < 16; ++r) p1[r] = fmaf(p1[r], C2, mnL);
    for (int r = 0; r < 16; ++r) p0[r] = __builtin_amdgcn_exp2f(p0[r]);
}
__device__ __forceinline__ void finishSM(f32x16& p0, f32x16& p1, float alpha, float& l_reg, bf16x8& pa0, bf16x8& pa1, bf16x8& pa2, bf16x8& pa3) {
    for (int r = 0; r < 16; ++r) p1[r] = __builtin_amdgcn_exp2f(p1[r]);
    float ps = 0; for (int r = 0; r < 16; ++r) ps += p0[r]; for (int r = 0; r < 16; ++r) ps += p1[r];
    { auto rr = __builtin_amdgcn_permlane32_swap(__float_as_uint(ps), __float_as_uint(ps), false, false);
      ps = __uint_as_float(rr[0]) + __uint_as_float(rr[1]); }
    l_reg = l_reg * alpha + ps;
#define PK4(P, B_, OUT) do { unsigned a0 = cvtpk(P[B_+0], P[B_+1]), a1 = cvtpk(P[B_+2], P[B_+3]);                          \
        unsigned b0 = cvtpk(P[B_+4], P[B_+5]), b1 = cvtpk(P[B_+6], P[B_+7]);                                             \
        auto r0 = __builtin_amdgcn_permlane32_swap(a0, b0, false, false); auto r1 = __builtin_amdgcn_permlane32_swap(a1, b1, false, false); \
        u32x4 w = {r0[0], r1[0], r0[1], r1[1]}; OUT = *reinterpret_cast<bf16x8*>(&w); } while (0)
    PK4(p0, 0, pa0); PK4(p0, 8, pa1); PK4(p1, 0, pa2); PK4(p1, 8, pa3);
#undef PK4
}
template <int KB>
__device__ __forceinline__ void qkt(f32x16& p0, f32x16& p1, const char* K_lds, int r32, int hi, const bf16x8* qr) {
    p0 = f32x16{}; p1 = f32x16{};
    const char* kb[4];
#pragma unroll
    for (int dd = 0; dd < 4; ++dd) kb[dd] = K_lds + KB * SHM_K + KSWZ(r32, (dd * 16 + hi * 8) * 2);
#pragma unroll
    for (int d0 = 0; d0 < 12; ++d0) { const char* a = kb[d0 & 3] + (d0 >> 2) * 128;
        bf16x8 b0 = *reinterpret_cast<const bf16x8*>(a);
        bf16x8 b1 = *reinterpret_cast<const bf16x8*>(a + 32 * KPITCH);
        p0 = __builtin_amdgcn_mfma_f32_32x32x16_bf16(b0, qr[d0], p0, 0, 0, 0);
        p1 = __builtin_amdgcn_mfma_f32_32x32x16_bf16(b1, qr[d0], p1, 0, 0, 0); }
}
template <int VB>
__device__ __forceinline__ void pv_tile(f32x16* o, int vb0, bf16x8 pa0, bf16x8 pa1, bf16x8 pa2, bf16x8 pa3) {
#define TRRD(dst, off) asm volatile("ds_read_b64_tr_b16 %0, %1 offset:%2" : "=&v"(dst) : "v"(vb0), "i"(off) : "memory")
#define PV_D0(d0) do { s16x4 l0, l1, l2, l3, h0, h1, h2, h3; constexpr int b_ = VB * SHM_V + v_rd_off(d0, 0, 0);     \
        TRRD(l0, b_); TRRD(h0, b_ + 2048); TRRD(l1, b_ + 4096); TRRD(h1, b_ + 6144); TRRD(l2, b_ + 8192); TRRD(h2, b_ + 10240); TRRD(l3, b_ + 12288); TRRD(h3, b_ + 14336); \
        asm volatile("s_waitcnt lgkmcnt(0)" ::: "memory"); SBAR();   \
        o[d0] = __builtin_amdgcn_mfma_f32_32x32x16_bf16(pa0, (bf16x8){l0[0], l0[1], l0[2], l0[3], h0[0], h0[1], h0[2], h0[3]}, o[d0], 0, 0, 0);   \
        o[d0] = __builtin_amdgcn_mfma_f32_32x32x16_bf16(pa1, (bf16x8){l1[0], l1[1], l1[2], l1[3], h1[0], h1[1], h1[2], h1[3]}, o[d0], 0, 0, 0);   \
        o[d0] = __builtin_amdgcn_mfma_f32_32x32x16_bf16(pa2, (bf16x8){l2[0], l2[1], l2[2], l2[3], h2[0], h2[1], h2[2], h2[3]}, o[d0], 0, 0, 0);   \
        o[d0] = __builtin_amdgcn_mfma_f32_32x32x16_bf16(pa3, (bf16x8){l3[0], l3[1], l3[2], l3[3], h3[0], h3[1], h3[2], h3[3]}, o[d0], 0, 0, 0); } while (0)
    PV_D0(0); PV_D0(1); PV_D0(2); PV_D0(3);
#undef PV_D0
#undef TRRD
}
struct BlockRef { const bf16* Q; const bf16* K; const bf16* V; bf16* O; int P0; };
struct Stage { bf16x8 st_v0, st_v1, st_k0, st_k1, st_k2; };
#define VMW() asm volatile("s_waitcnt vmcnt(0)" ::: "memory")
#define SLOAD_H(Kp, Vp, k0) do { const bf16* vt_ = (Vp) + (size_t)(k0) * DV; const bf16* kt_ = (Kp) + (size_t)(k0) * DQ;     \
                         S.st_v0 = load8(vt_ + voff); S.st_v1 = load8(vt_ + voff + 32 * DV);              \
                         S.st_k0 = load8(kt_ + koff); S.st_k1 = load8(kt_ + koff + 64); S.st_k2 = load8(kt_ + koff + 128); } while (0)
#define SWRITE_HK(bf) do { *(bf16x8*)(K_lds + (bf) * SHM_K + kws) = S.st_k0; *(bf16x8*)(K_lds + (bf) * SHM_K + kws + 128) = S.st_k1; *(bf16x8*)(K_lds + (bf) * SHM_K + kws + 256) = S.st_k2; } while (0)
#define SWRITE_HV(bf) do { *(bf16x8*)(V_lds + (bf) * SHM_V + vst0) = S.st_v0; *(bf16x8*)(V_lds + (bf) * SHM_V + vst1) = S.st_v1; } while (0)
#define SWRITE_H(bf) do { SWRITE_HV(bf); SWRITE_HK(bf); } while (0)
__device__ __forceinline__ void attn_block(const BlockRef& cur, char* lds) {
    const int tid = opaque_tid(), wid = __builtin_amdgcn_readfirstlane(tid >> 6), lane = tid & 63, r32 = lane & 31, hi = lane >> 5;
    const int NT = cur.P0 / KVBLK + QB / KVBLK;
    const int qlo = cur.P0 + wid * QBLK, qm = qlo + r32 - 4 * hi;
    char* V_lds = lds; char* K_lds = lds + 2 * SHM_V;
    float* ws = (float*)(lds + 2 * SHM_V + 2 * SHM_K) + wid * 64; float* li_l = ws, * al_l = ws + 32;
    float m_reg = -1e30f, l_reg = 0; f32x16 o[4] = {};
    const int sr = tid >> 4, sc = (tid & 15) * 8, vst0 = v_st(sr, sc), vst1 = v_st(32 + sr, sc);
    const int kr = tid >> 3, kc = tid & 7, kws = KSWZ(kr, kc * 16);
    const unsigned voff = (unsigned)(sr * DV + sc), koff = (unsigned)(kr * DQ + kc * 8);
    const int vb0 = (int)(uintptr_t)V_lds + v_rd_base(lane);
    const bf16* Kh = cur.K; const bf16* Vh = cur.V;
    Stage S; bf16x8 qr[12];
#pragma unroll
    for (int d0 = 0; d0 < 12; ++d0) qr[d0] = load8(cur.Q + (size_t)(wid * QBLK + r32) * DQ + d0 * 16 + hi * 8);
    SLOAD_H(Kh, Vh, 0); VMW(); SWRITE_H(0);
    __syncthreads();
#define RESC(a) do { if (__any((a) < 1.f)) { if (hi == 0) al_l[r32] = (a); asm volatile("s_waitcnt lgkmcnt(0)" ::: "memory");              \
                     for (int d_ = 0; d_ < 4; ++d_) for (int r = 0; r < 16; ++r) o[d_][r] *= al_l[crow(r, hi)]; } } while (0)
#define KBASE(t) ((t) * KVBLK)
#define MASKT(P0_, P1_, t) do { const int kb_ = KBASE(t); if (kb_ + KVBLK - 1 > qlo) mask_tile(P0_, P1_, qm - kb_); } while (0)
    f32x16 p0, p1; float mn, al; bf16x8 pa0, pa1, pa2, pa3;
#define STEP(t, BUF) do {                                                                                                     \
        qkt<BUF>(p0, p1, K_lds, r32, hi, qr); SBAR();                                                                         \
        if ((t) + 1 < NT) { SLOAD_H(Kh, Vh, KBASE((t) + 1)); SBAR(); }                                                        \
        MASKT(p0, p1, (t)); partialSM(p0, p1, m_reg, mn, al);                                                                 \
        RESC(al);                                                                                                             \
        finishSM(p0, p1, al, l_reg, pa0, pa1, pa2, pa3); SBAR();                                                              \
        pv_tile<BUF>(o, vb0, pa0, pa1, pa2, pa3); SBAR();                                                                     \
        if ((t) + 1 < NT) { VMW(); SWRITE_H(1 - BUF); }                                                                       \
        __syncthreads(); } while (0)
    for (int t = 0; t < NT; t += 2) { STEP(t, 0); STEP(t + 1, 1); }
    if (hi == 0) li_l[r32] = l_reg; asm volatile("s_waitcnt lgkmcnt(0)" ::: "memory");
    float rli[16];
#pragma unroll
    for (int r = 0; r < 16; ++r) rli[r] = __builtin_amdgcn_rcpf(li_l[crow(r, hi)]);
    bf16* Ow = cur.O + (size_t)(wid * QBLK) * LDO;
#pragma unroll
    for (int r = 0; r < 16; ++r) { const int orow = crow(r, hi);
#pragma unroll
        for (int d0 = 0; d0 < 4; ++d0) { const float v = o[d0][r] * rli[r];
            const float vn = __shfl_xor(v, 1);
            if ((r32 & 1) == 0) *(unsigned*)(Ow + (size_t)orow * LDO + d0 * 32 + r32) = cvtpk(v, vn); } }
    __syncthreads();
#undef RESC
#undef KBASE
#undef MASKT
#undef STEP
}
#undef VMW
#undef SLOAD_H
#undef SWRITE_HK
#undef SWRITE_HV
#undef SWRITE_H
struct Item { int bh, qb0, qb1; };
__device__ __forceinline__ Item decode(int L) { Item it; const int xcd = L & 7, k = L >> 3; it.bh = (k >> 4) * 8 + xcd; const int x = k & 15; it.qb0 = x; it.qb1 = 31 - x; return it; }
__device__ __forceinline__ BlockRef mkref(const Item& it, int pass, const bf16* Q, const bf16* K, const bf16* V, bf16* mixed) {
    const int qb = pass ? it.qb1 : it.qb0; BlockRef r;
    r.Q = Q + ((size_t)it.bh * SEQL + (size_t)qb * QB) * DQ; r.K = K + (size_t)it.bh * SEQL * DQ; r.V = V + (size_t)it.bh * SEQL * DV;
    r.O = mixed + ((size_t)(it.bh >> 2) * SEQL + (size_t)qb * QB) * LDO + 512 + (it.bh & 3) * 128; r.P0 = qb * QB;
    return r;
}
__device__ __forceinline__ void attn_phase(char* lds, const bf16* Q, const bf16* K, const bf16* V, bf16* mixed) {
    for (int L = blockIdx.x; L < 256; L += gridDim.x) {
        const Item it = decode(L);
        attn_block(mkref(it, 0, Q, K, V, mixed), lds);
        attn_block(mkref(it, 1, Q, K, V, mixed), lds);
    }
}
#undef KSWZ
#undef SBAR
}
namespace mk {
typedef unsigned short bf16_t;
typedef short bf16x8 __attribute__((ext_vector_type(8)));
typedef float f32x4 __attribute__((ext_vector_type(4)));
typedef float f32x2 __attribute__((ext_vector_type(2)));
typedef float f32x16 __attribute__((ext_vector_type(16)));
typedef unsigned u32x2 __attribute__((ext_vector_type(2)));
typedef unsigned u32x4 __attribute__((ext_vector_type(4)));
constexpr int NB = 4, SEQ = 8192, T = NB * SEQ, DM = 1024, DEPTH = 2, DFF = 4096, NIN = 2048, NMOD = 6 * DM;
constexpr float EPS = 1e-6f;
constexpr size_t MiB = 1u << 20;
constexpr size_t W_IN = 0, W_Q = 4 * MiB, W_KV = W_Q + 384 * 1024, W_O = W_KV + 256 * 1024, W_1 = W_O + 2 * MiB, W_2 = W_1 + 8 * MiB, W_LAYER = 23 * MiB;
static_assert(W_2 + 8 * MiB <= W_LAYER, "weights");
constexpr size_t WS_W = 0, WS_MOD = 46 * MiB, WS_COS = 47 * MiB, WS_SIN = 51 * MiB, WS_HN = 55 * MiB, WS_QN = 119 * MiB, WS_KVN = 135 * MiB,
                 WS_GST = 143 * MiB, WS_GDV = 207 * MiB, WS_R = 208 * MiB, WS_BT = 464 * MiB, WS_RSS = 496 * MiB, WS_BIAS = 497 * MiB, WS_END = 498 * MiB;
constexpr size_t WS_BAR = WS_MOD + 512 * 1024;
constexpr size_t R_PROJ = 0, R_Q = 128 * MiB, R_K = 176 * MiB, R_V = 224 * MiB;
constexpr int LDS_BYTES = 139264 + 64;
constexpr int MISC_OFF = 139264;
constexpr int EPI_OFF = 131072;

__device__ __forceinline__ float bf2f(unsigned short v) { return __uint_as_float((unsigned)v << 16); }
__device__ __forceinline__ unsigned f2bf(float f) { unsigned u = __float_as_uint(f); return (u + 0x7fffu + ((u >> 16) & 1u)) >> 16; }
__device__ __forceinline__ unsigned pk2(float lo, float hi) { return f2bf(lo) | (f2bf(hi) << 16); }
__device__ __forceinline__ float wave_sum(float v) {
#pragma unroll
    for (int o = 1; o < 64; o <<= 1) v += __shfl_xor(v, o);
    return v;
}
__device__ __forceinline__ float half_sum32(float v) {
#pragma unroll
    for (int o = 1; o < 32; o <<= 1) v += __shfl_xor(v, o);
    return v;
}
__device__ __forceinline__ int crow(int r, int hi) { return (r & 3) + 8 * (r >> 2) + 4 * hi; }

__device__ __forceinline__ int src_col(int map, int n) {
    if (map == 1) { if (n < 1536) return n; if (n < 1984) return n + 16; if (n < 2000) return n - 1984 + 1536; return -1; }
    if (map == 2) { if (n < 512) return (n >> 7) * 192 + (n & 127); const int c = n - 512, bj = c >> 7, hd = (c & 127) >> 5, w = c & 31; return hd * 192 + 128 + 32 * bj + w; }
    return n;
}
__device__ __forceinline__ void transpose_item(const float* W, int K, int N, int NP, bf16_t* WT, int map, LAS float* scr, int item, int lane) {
    const int nblk = NP / 32, kb = item / nblk, nb = item % nblk, k0 = 64 * kb, n0 = 32 * nb;
    const int sc = src_col(map, n0 + (lane & 31));
#pragma unroll 8
    for (int i = 0; i < 32; ++i) { const int kk = 2 * i + (lane >> 5); scr[kk * 33 + (lane & 31)] = sc >= 0 ? W[(size_t)(k0 + kk) * N + sc] : 0.f; }
    asm volatile("s_waitcnt lgkmcnt(0)" ::: "memory");
    const int c = lane & 7;
#pragma unroll
    for (int j = 0; j < 4; ++j) { const int n = (lane >> 3) + 8 * j; const LAS float* s = scr + (8 * c) * 33 + n;
        u32x4 o; o.x = pk2(s[0 * 33], s[1 * 33]); o.y = pk2(s[2 * 33], s[3 * 33]); o.z = pk2(s[4 * 33], s[5 * 33]); o.w = pk2(s[6 * 33], s[7 * 33]);
        *(u32x4*)(WT + (size_t)(n0 + n) * K + k0 + 8 * c) = o; }
    asm volatile("s_waitcnt lgkmcnt(0)" ::: "memory");
}
__device__ __forceinline__ void adaln_unit(int u, const float* c, const float* w_ada, const float* b_ada, float* mod, LAS float* lds) {
    const int tid = opaque_tid(), wave = tid >> 6, lane = tid & 63;
    const int l = u / 96, n0 = (u % 96) * 64;
    LAS float* sc = lds; LAS float* red = lds + 4096;
    for (int i = tid; i < 4096; i += 512) { const float v = c[i]; sc[i] = v / (1.0f + __expf(-v)); }
    __syncthreads();
    const float* wp = w_ada + (size_t)l * DM * NMOD + n0 + lane;
    float a0 = 0.f, a1 = 0.f, a2 = 0.f, a3 = 0.f;
#pragma unroll 8
    for (int k = wave * 128; k < wave * 128 + 128; ++k) { const float w = wp[(size_t)k * NMOD]; a0 += sc[k] * w; a1 += sc[1024 + k] * w; a2 += sc[2048 + k] * w; a3 += sc[3072 + k] * w; }
    red[(wave * 4 + 0) * 64 + lane] = a0; red[(wave * 4 + 1) * 64 + lane] = a1; red[(wave * 4 + 2) * 64 + lane] = a2; red[(wave * 4 + 3) * 64 + lane] = a3;
    __syncthreads();
    if (tid < 256) { const int b = tid >> 6; float s = b_ada[(size_t)l * NMOD + n0 + lane];
#pragma unroll
        for (int w = 0; w < 8; ++w) s += red[(w * 4 + b) * 64 + lane];
        mod[((size_t)l * 4 + b) * NMOD + n0 + lane] = s; }
    __syncthreads();
}
__device__ __forceinline__ void prenorm_rows(const float* xin, bf16_t* an, float* rss, const float* modl, int coff) {
    const int tid = opaque_tid(), lane = tid & 63, gw = blockIdx.x * 8 + (tid >> 6), NGW = gridDim.x * 8;
    for (int t = gw; t < T; t += NGW) {
        const f32x4* xr = (const f32x4*)(xin + (size_t)t * DM) + lane; f32x4 v[4]; float ss = 0.f;
#pragma unroll
        for (int j = 0; j < 4; ++j) { v[j] = xr[64 * j]; ss += (v[j][0] * v[j][0] + v[j][1] * v[j][1]) + (v[j][2] * v[j][2] + v[j][3] * v[j][3]); }
        ss = wave_sum(ss); if (lane == 0) rss[t] = ss;
        const float* mb = modl + (size_t)(t >> 13) * NMOD;
#pragma unroll
        for (int j = 0; j < 4; ++j) { const int col = 256 * j + 4 * lane;
            const f32x4 sc = *(const f32x4*)(mb + coff + col);
            const f32x4 h = v[j] * (sc + 1.0f);
            u32x2 w; w.x = pk2(h[0], h[1]); w.y = pk2(h[2], h[3]); *(u32x2*)(an + (size_t)t * DM + col) = w; }
    }
}
__device__ __forceinline__ void bias_rows(const bf16_t* Wt, int N, const float* modl, int soff, float* bias) {
    const int tid = opaque_tid(), lane = tid & 63, gw = blockIdx.x * 8 + (tid >> 6), NGW = gridDim.x * 8;
    for (int n = gw; n < N; n += NGW) {
        const u32x4 w0 = *(const u32x4*)(Wt + (size_t)n * 1024 + 16 * lane), w1 = *(const u32x4*)(Wt + (size_t)n * 1024 + 16 * lane + 8);
        float wf[16];
#pragma unroll
        for (int e2 = 0; e2 < 4; ++e2) { wf[2 * e2] = __uint_as_float(w0[e2] << 16); wf[2 * e2 + 1] = __uint_as_float(w0[e2] & 0xffff0000u);
                                         wf[8 + 2 * e2] = __uint_as_float(w1[e2] << 16); wf[8 + 2 * e2 + 1] = __uint_as_float(w1[e2] & 0xffff0000u); }
#pragma unroll
        for (int b = 0; b < 4; ++b) { const float* sp = modl + (size_t)b * NMOD + soff + 16 * lane; float s = 0.f;
#pragma unroll
            for (int q = 0; q < 4; ++q) { const f32x4 sv = *(const f32x4*)(sp + 4 * q); s += (sv[0] * wf[4 * q] + sv[1] * wf[4 * q + 1]) + (sv[2] * wf[4 * q + 2] + sv[3] * wf[4 * q + 3]); }
            s = wave_sum(s); if (lane == 0) bias[(size_t)b * N + n] = s; }
    }
}
__device__ __forceinline__ void prep_tokens(const bf16_t* proj, bf16_t* qn, bf16_t* kvn, bf16_t* Kb, const float* qa, const float* kva, const float* kr,
                                            const float* cosT, const float* sinT) {
    const int tid = opaque_tid(), lane = tid & 63, gw = blockIdx.x * 8 + (tid >> 6), NGW = gridDim.x * 8;
    for (int t = gw; t < T; t += NGW) {
        const bf16_t* pr = proj + (size_t)t * NIN;
        { const u32x2 w = *(const u32x2*)(pr + 1536 + 4 * lane);
          const float q0 = __uint_as_float(w.x << 16), q1 = __uint_as_float(w.x & 0xffff0000u), q2 = __uint_as_float(w.y << 16), q3 = __uint_as_float(w.y & 0xffff0000u);
          const float rr = 1.0f / sqrtf(wave_sum((q0 * q0 + q1 * q1) + (q2 * q2 + q3 * q3)) * (1.0f / 256.0f) + EPS);
          const f32x4 g = *(const f32x4*)(qa + 4 * lane);
          u32x2 o; o.x = pk2(q0 * rr * g[0], q1 * rr * g[1]); o.y = pk2(q2 * rr * g[2], q3 * rr * g[3]); *(u32x2*)(qn + (size_t)t * 256 + 4 * lane) = o; }
        { const unsigned w = *(const unsigned*)(pr + 1792 + 2 * lane);
          const float k0 = __uint_as_float(w << 16), k1 = __uint_as_float(w & 0xffff0000u);
          const float rr = 1.0f / sqrtf(wave_sum(k0 * k0 + k1 * k1) * (1.0f / 128.0f) + EPS);
          const f32x2 g = *(const f32x2*)(kva + 2 * lane);
          *(unsigned*)(kvn + (size_t)t * 128 + 2 * lane) = pk2(k0 * rr * g[0], k1 * rr * g[1]); }
        { float y = bf2f(pr[1920 + lane]);
          const float rr = 1.0f / sqrtf(wave_sum(y * y) * (1.0f / 64.0f) + EPS);
          y = y * rr * kr[lane];
          const float pn = __shfl_xor(y, 32); const int j = lane & 31;
          const float c = cosT[(size_t)t * 32 + j], s = sinT[(size_t)t * 32 + j];
          const float o = lane < 32 ? y * c - pn * s : y * c + pn * s;
          const bf16_t ob = (bf16_t)f2bf(o); const int b = t >> 13, sp = t & 8191;
#pragma unroll
          for (int h = 0; h < 4; ++h) Kb[((size_t)(b * 4 + h) * SEQ + sp) * 192 + 128 + lane] = ob; }
    }
}
__device__ __forceinline__ void gla_pass_a(LAS float* ldsf, const bf16_t* proj, const float* wgu, const float* bg, float* Btab, float* Gst, float* Gdv) {
    const int tid = opaque_tid(), lane = tid & 63, r = lane & 31, hh = lane >> 5, wv = tid >> 6, gw = blockIdx.x * 8 + wv, NGW = gridDim.x * 8;
    LAS float* Bw = ldsf + wv * 4096;
    for (int u = gw; u < 16 * 128 * 2; u += NGW) { const int item = u >> 1, dkb = u & 1;
        const int bh = item >> 7, n = item & 127, b = bh >> 2, h = bh & 3; const size_t row0 = (size_t)b * SEQ + (size_t)n * 64;
        const int dk = 32 * dkb + r;
        float bl;
        { float w[16];
#pragma unroll
          for (int q = 0; q < 16; ++q) w[q] = wgu[q * 256 + h * 64 + dk];
          const float bias = bg[h * 64 + dk];
          float loc[32]; float a = 0.f;
#pragma unroll
          for (int t0 = 0; t0 < 32; t0 += 8) { u32x4 g0[8], g1[8];
#pragma unroll
              for (int i = 0; i < 8; ++i) { const bf16_t* ga = proj + (row0 + 32 * hh + t0 + i) * NIN + 1984; g0[i] = *(const u32x4*)ga; g1[i] = *(const u32x4*)(ga + 8); }
#pragma unroll
              for (int i = 0; i < 8; ++i) { float x = bias;
#pragma unroll
                  for (int e2 = 0; e2 < 4; ++e2) { x += __uint_as_float(g0[i][e2] << 16) * w[2 * e2] + __uint_as_float(g0[i][e2] & 0xffff0000u) * w[2 * e2 + 1];
                                                   x += __uint_as_float(g1[i][e2] << 16) * w[8 + 2 * e2] + __uint_as_float(g1[i][e2] & 0xffff0000u) * w[8 + 2 * e2 + 1]; }
                  a += (fminf(x, 0.f) - __logf(1.0f + __expf(-fabsf(x)))) * (1.0f / 16.0f);
                  loc[t0 + i] = a; } }
          const float tot0 = __shfl(a, r);
          const float off = hh ? tot0 : 0.f;
#pragma unroll
          for (int t = 0; t < 32; ++t) { const float v = loc[t] + off; Bw[(32 * hh + t) * 33 + r] = v; Btab[(row0 + 32 * hh + t) * 256 + h * 64 + dk] = v; }
          asm volatile("s_waitcnt lgkmcnt(0)" ::: "memory");
          bl = Bw[63 * 33 + r]; }
        f32x16 acc[4] = {};
#pragma unroll
        for (int ks = 0; ks < 4; ++ks) { bf16x8 bv;
#pragma unroll
            for (int j = 0; j < 8; ++j) { const int t = 16 * ks + 8 * hh + j;
                bv[j] = (short)f2bf(bf2f(proj[(row0 + t) * NIN + 256 + h * 64 + dk]) * __expf(bl - Bw[t * 33 + r])); }
#pragma unroll
            for (int dvb = 0; dvb < 4; ++dvb) { bf16x8 av;
#pragma unroll
                for (int j = 0; j < 8; ++j) { const int t = 16 * ks + 8 * hh + j; av[j] = (short)proj[(row0 + t) * NIN + 512 + h * 128 + 32 * dvb + r]; }
                acc[dvb] = __builtin_amdgcn_mfma_f32_32x32x16_bf16(av, bv, acc[dvb], 0, 0, 0); } }
#pragma unroll
        for (int dvb = 0; dvb < 4; ++dvb) { float* go = Gst + ((size_t)item * 128 + 32 * dvb) * 64 + dk;
#pragma unroll
            for (int i = 0; i < 16; ++i) go[(size_t)crow(i, hh) * 64] = acc[dvb][i]; }
        if (hh == 0) Gdv[(size_t)item * 64 + dk] = __expf(bl);
        asm volatile("s_waitcnt lgkmcnt(0)" ::: "memory");
    }
}
__device__ __forceinline__ void gla_scan(float* Gst, const float* Gdv) {
    const int gt = blockIdx.x * 512 + opaque_tid(), GT = gridDim.x * 512;
    for (int e = gt; e < 16 * 8192; e += GT) { const int bh = e >> 13, idx = e & 8191, dk = idx & 63;
        float* base = Gst + (size_t)bh * 128 * 8192 + idx; const float* dvp = Gdv + (size_t)bh * 128 * 64 + dk;
        float s = 0.f;
        for (int n0 = 0; n0 < 128; n0 += 16) { float u[16], dd[16];
#pragma unroll
            for (int i = 0; i < 16; ++i) { u[i] = base[(size_t)(n0 + i) * 8192]; dd[i] = dvp[(n0 + i) * 64]; }
#pragma unroll
            for (int i = 0; i < 16; ++i) { base[(size_t)(n0 + i) * 8192] = s; s = dd[i] * s + u[i]; } }
    }
}
__device__ __forceinline__ void gla_pass_c(const bf16_t* proj, const float* Btab, const float* Gst, const float* gout, bf16_t* mixed) {
    const int tid = opaque_tid(), lane = tid & 63, r = lane & 31, hh = lane >> 5, gw = blockIdx.x * 8 + (tid >> 6), NGW = gridDim.x * 8;
    for (int u = gw; u < 16 * 128 * 2; u += NGW) { const int item = u >> 1, tb = __builtin_amdgcn_readfirstlane(u & 1);
        const int bh = item >> 7, n = item & 127, b = bh >> 2, h = bh & 3; const size_t row0 = (size_t)b * SEQ + (size_t)n * 64;
        const int tl = 32 * tb + r;
        bf16x8 qe[4];
        { const bf16_t* qp = proj + (row0 + tl) * NIN + h * 64; const float* bp = Btab + (row0 + tl) * 256 + h * 64;
#pragma unroll
          for (int ks = 0; ks < 4; ++ks) { const u32x4 qw = *(const u32x4*)(qp + 16 * ks + 8 * hh); const f32x4 b0 = *(const f32x4*)(bp + 16 * ks + 8 * hh), b1 = *(const f32x4*)(bp + 16 * ks + 8 * hh + 4);
              u32x4 w; w.x = pk2(__uint_as_float(qw[0] << 16) * 0.125f * __expf(b0[0]), __uint_as_float(qw[0] & 0xffff0000u) * 0.125f * __expf(b0[1]));
                       w.y = pk2(__uint_as_float(qw[1] << 16) * 0.125f * __expf(b0[2]), __uint_as_float(qw[1] & 0xffff0000u) * 0.125f * __expf(b0[3]));
                       w.z = pk2(__uint_as_float(qw[2] << 16) * 0.125f * __expf(b1[0]), __uint_as_float(qw[2] & 0xffff0000u) * 0.125f * __expf(b1[1]));
                       w.w = pk2(__uint_as_float(qw[3] << 16) * 0.125f * __expf(b1[2]), __uint_as_float(qw[3] & 0xffff0000u) * 0.125f * __expf(b1[3]));
              qe[ks] = __builtin_bit_cast(bf16x8, w); } }
        f32x16 o[4] = {};
#pragma unroll
        for (int dvb = 0; dvb < 4; ++dvb) { const float* sp = Gst + ((size_t)item * 128 + 32 * dvb + r) * 64;
#pragma unroll
          for (int ks = 0; ks < 4; ++ks) { const f32x4 s0 = *(const f32x4*)(sp + 16 * ks + 8 * hh), s1 = *(const f32x4*)(sp + 16 * ks + 8 * hh + 4);
              u32x4 sw; sw.x = pk2(s0[0], s0[1]); sw.y = pk2(s0[2], s0[3]); sw.z = pk2(s1[0], s1[1]); sw.w = pk2(s1[2], s1[3]);
              o[dvb] = __builtin_amdgcn_mfma_f32_32x32x16_bf16(qe[ks], __builtin_bit_cast(bf16x8, sw), o[dvb], 0, 0, 0); } }
        for (int sb = 0; sb <= tb; ++sb) {
            f32x16 x = {};
            const int sl = 32 * sb + r; const bf16_t* kp = proj + (row0 + sl) * NIN + 256 + h * 64; const float* bp = Btab + (row0 + sl) * 256 + h * 64;
#pragma unroll
            for (int ks = 0; ks < 4; ++ks) { const u32x4 kw = *(const u32x4*)(kp + 16 * ks + 8 * hh); const f32x4 b0 = *(const f32x4*)(bp + 16 * ks + 8 * hh), b1 = *(const f32x4*)(bp + 16 * ks + 8 * hh + 4);
                u32x4 w; w.x = pk2(__uint_as_float(kw[0] << 16) * __expf(-b0[0]), __uint_as_float(kw[0] & 0xffff0000u) * __expf(-b0[1]));
                         w.y = pk2(__uint_as_float(kw[1] << 16) * __expf(-b0[2]), __uint_as_float(kw[1] & 0xffff0000u) * __expf(-b0[3]));
                         w.z = pk2(__uint_as_float(kw[2] << 16) * __expf(-b1[0]), __uint_as_float(kw[2] & 0xffff0000u) * __expf(-b1[1]));
                         w.w = pk2(__uint_as_float(kw[3] << 16) * __expf(-b1[2]), __uint_as_float(kw[3] & 0xffff0000u) * __expf(-b1[3]));
                x = __builtin_amdgcn_mfma_f32_32x32x16_bf16(__builtin_bit_cast(bf16x8, w), qe[ks], x, 0, 0, 0); }
            if (sb == tb) {
#pragma unroll
                for (int i = 0; i < 16; ++i) if (crow(i, hh) > r) x[i] = 0.f; }
#pragma unroll
            for (int s2 = 0; s2 < 2; ++s2) { u32x4 xw; xw.x = pk2(x[8 * s2], x[8 * s2 + 1]); xw.y = pk2(x[8 * s2 + 2], x[8 * s2 + 3]); xw.z = pk2(x[8 * s2 + 4], x[8 * s2 + 5]); xw.w = pk2(x[8 * s2 + 6], x[8 * s2 + 7]);
#pragma unroll
                for (int dvb = 0; dvb < 4; ++dvb) { bf16x8 vb;
#pragma unroll
                    for (int j = 0; j < 8; ++j) { const int sk = 32 * sb + 16 * s2 + 8 * (j >> 2) + 4 * hh + (j & 3); vb[j] = (short)proj[(row0 + sk) * NIN + 512 + h * 128 + 32 * dvb + r]; }
                    o[dvb] = __builtin_amdgcn_mfma_f32_32x32x16_bf16(__builtin_bit_cast(bf16x8, xw), vb, o[dvb], 0, 0, 0); } } }
        float gn[4];
#pragma unroll
        for (int dvb = 0; dvb < 4; ++dvb) gn[dvb] = gout[32 * dvb + r];
#pragma unroll
        for (int i = 0; i < 16; ++i) { const int t = 32 * tb + crow(i, hh);
            const float tot = half_sum32((o[0][i] * o[0][i] + o[1][i] * o[1][i]) + (o[2][i] * o[2][i] + o[3][i] * o[3][i]));
            const float rr = __builtin_amdgcn_rsqf(tot * (1.0f / 128.0f) + EPS);
#pragma unroll
            for (int dvb = 0; dvb < 4; ++dvb) { const float g = bf2f(proj[(row0 + t) * NIN + 1024 + h * 128 + 32 * dvb + r]);
                const float val = o[dvb][i] * rr * gn[dvb] * (g * __builtin_amdgcn_rcpf(1.0f + __expf(-g)));
                mixed[(row0 + t) * DM + h * 128 + 32 * dvb + r] = (bf16_t)f2bf(val); } }
    }
}
}
#define XB_TMO      128
#define XB_XCNT(j)  (256  + 64 * (j))
#define XB_XSUB(j)  (1280 + 64 * (j))
#define XB_XGEN(j)  (2304 + 64 * (j))
#define XB_TOP      3328
#define XB_TOPGEN   3392
#define XCD_BAR_WORDS 3456
#define XB_SPIN_CAP (1u << 18)

__device__ __forceinline__ unsigned xb_ld(unsigned* p)              { return __hip_atomic_load(p, __ATOMIC_RELAXED, __HIP_MEMORY_SCOPE_AGENT); }
__device__ __forceinline__ unsigned xb_add(unsigned* p, unsigned v) { return __hip_atomic_fetch_add(p, v, __ATOMIC_RELAXED, __HIP_MEMORY_SCOPE_AGENT); }
__device__ __forceinline__ unsigned xb_xcc_id() { return (unsigned)__builtin_amdgcn_s_getreg((3 << 11) | 20) & 0xFu; }
#define XB_SPIN(cond, bar) do { unsigned _sp = 0; while (cond) { __builtin_amdgcn_s_sleep(1); \
    if ((++_sp & 255u) == 0u) { if (xb_ld(&(bar)[XB_TMO])) break; if (_sp > XB_SPIN_CAP) { atomicAdd(&(bar)[XB_TMO], 1u); break; } } } } while (0)

struct XcdBarrier {
    unsigned* bar; unsigned x;
    volatile LAS unsigned* st;
};

__device__ __forceinline__ XcdBarrier xcd_barrier_post(unsigned* bar, volatile LAS unsigned* st) {
    XcdBarrier b; b.bar = bar; b.x = xb_xcc_id(); b.st = st;
    if (threadIdx.x == 0) (void)xb_add(&bar[XB_XCNT(b.x)], 1u);
    return b;
}
__device__ __forceinline__ void xcd_barrier_complete(unsigned* bar, unsigned x, unsigned& nloc, unsigned& nx) {
    const unsigned G = gridDim.x * gridDim.y * gridDim.z;
    unsigned sum, cnt, mine, sp = 0u;
    for (;;) {
        sum = 0u; cnt = 0u; mine = 0u;
#pragma unroll
        for (unsigned j = 0; j < 16; ++j) { const unsigned c = xb_ld(&bar[XB_XCNT(j)]); sum += c; cnt += (c > 0u) ? 1u : 0u; mine = (j == x) ? c : mine; }
        if (sum == G) break;
        __builtin_amdgcn_s_sleep(1);
        if ((++sp & 255u) == 0u) { if (xb_ld(&bar[XB_TMO])) break; if (sp > XB_SPIN_CAP) { atomicAdd(&bar[XB_TMO], 1u); break; } }
    }
    nloc = mine > 0u ? mine : 1u; nx = cnt > 0u ? cnt : 1u;
}

__device__ __forceinline__ void xcd_barrier(const XcdBarrier& b) {
    asm volatile("s_waitcnt vmcnt(0)" ::: "memory");
    __syncthreads();
    if (threadIdx.x == 0) {
        unsigned* bar = b.bar;
        __builtin_amdgcn_s_waitcnt(0);
        unsigned nloc = b.st[0], nx = b.st[1];
        if (nloc == 0u) { xcd_barrier_complete(bar, b.x, nloc, nx); b.st[0] = nloc; b.st[1] = nx; }
        const unsigned old = xb_add(&bar[XB_XSUB(b.x)], 1u);
        const unsigned gen = old / nloc;
        if (old + 1u == (gen + 1u) * nloc) {
            __builtin_amdgcn_fence(__ATOMIC_RELEASE, "agent");
            asm volatile("s_waitcnt vmcnt(0)" ::: "memory");
            const unsigned og = xb_add(&bar[XB_TOP], 1u);
            const unsigned tg = og / nx;
            if (og + 1u == (tg + 1u) * nx) xb_add(&bar[XB_TOPGEN], 1u);
            else XB_SPIN(xb_ld(&bar[XB_TOPGEN]) == tg, bar);
            __builtin_amdgcn_fence(__ATOMIC_ACQUIRE, "agent");
            xb_add(&bar[XB_XGEN(b.x)], 1u);
            asm volatile("s_waitcnt vmcnt(0)" ::: "memory");
        } else {
            XB_SPIN(xb_ld(&bar[XB_XGEN(b.x)]) == gen, bar);
            __builtin_amdgcn_fence(__ATOMIC_ACQUIRE, "agent");
            asm volatile("s_waitcnt vmcnt(0)" ::: "memory");
        }
    }
    __syncthreads();
}
#ifndef PHM
#define PHM 0xffff
#endif
#ifndef REP
#define REP 0
#endif
#ifndef USE_XB
#define USE_XB 1
#endif
#if USE_XB
#define GSYNC() xcd_barrier(xbar)
#else
#define GSYNC() grid.sync()
#endif
#if REP
#define REPEAT(k) _Pragma("unroll 1") for (int rep_ = 0, nrep_ = opaque_int((((REP) >> (k)) & 1) + 1); rep_ < nrep_; ++rep_)
#else
#define REPEAT(k)
#endif
struct Args { const float* in[20]; float* out; unsigned char* ws; float inv_freq[32]; };
__global__ void __launch_bounds__(512, 2) mega_fwd(Args a) {
    using namespace mk;
    extern __shared__ __attribute__((aligned(16))) unsigned char lds[];
    cg::grid_group grid = cg::this_grid();
    const int tid = opaque_tid(), lane = tid & 63, wave = __builtin_amdgcn_readfirstlane(tid >> 6);
    const int G = gridDim.x;
    PG8_LAS unsigned char* ldsl = (PG8_LAS unsigned char*)lds;
    LAS float* ldsf = (LAS float*)lds;
    unsigned char* ws = a.ws;
    const float* x_in = a.in[0]; const float* c_in = a.in[1]; const int* pos = (const int*)a.in[2];
    const float* w_ada = a.in[3]; const float* b_ada = a.in[4];
    float* mod = (float*)(ws + WS_MOD); float* cosT = (float*)(ws + WS_COS); float* sinT = (float*)(ws + WS_SIN);
    bf16_t* HN = (bf16_t*)(ws + WS_HN); bf16_t* QN = (bf16_t*)(ws + WS_QN); bf16_t* KVN = (bf16_t*)(ws + WS_KVN);
    float* GST = (float*)(ws + WS_GST); float* GDV = (float*)(ws + WS_GDV); float* BT = (float*)(ws + WS_BT);
    bf16_t* PROJ = (bf16_t*)(ws + WS_R + R_PROJ); bf16_t* QB_ = (bf16_t*)(ws + WS_R + R_Q); bf16_t* KB_ = (bf16_t*)(ws + WS_R + R_K); bf16_t* VB_ = (bf16_t*)(ws + WS_R + R_V);
    bf16_t* HB = (bf16_t*)(ws + WS_R);
    float* xout = a.out;
    float* RSS = (float*)(ws + WS_RSS); float* BIAS = (float*)(ws + WS_BIAS); bf16_t* AN1 = (bf16_t*)(ws + WS_GST);
#if USE_XB
    volatile LAS unsigned* MISC = (volatile LAS unsigned*)(ldsl + MISC_OFF);
    if (tid < 16) MISC[tid] = 0u;
    __syncthreads();
    const XcdBarrier xbar = xcd_barrier_post((unsigned*)(ws + WS_BAR), MISC);
#endif

#if (PHM >> 0) & 1
    for (int u = blockIdx.x; u < 192; u += G) adaln_unit(u, c_in, w_ada, b_ada, mod, ldsf);
    __syncthreads();
    { const int gt = blockIdx.x * 512 + tid, GT = G * 512;
      for (int e = gt; e < T * 32; e += GT) { const int t = e >> 5, j = e & 31;
          const float ang = (float)pos[t] * a.inv_freq[j];
          const double turns = (double)ang * 0.15915494309189535; const float fr = (float)(turns - rint(turns)) * 6.283185307179586f;
          cosT[e] = cosf(fr); sinT[e] = sinf(fr); } }
    { float* rz = (float*)(ws + WS_RSS) + T; const int gt = blockIdx.x * 512 + tid, GT = G * 512; for (int e = gt; e < 3 * T; e += GT) rz[e] = 0.f; }
    { LAS float* scr = (LAS float*)(ldsl + wave * 16384);
      const int gw = blockIdx.x * 8 + wave, NGW = G * 8;
      constexpr int I_IN = 16 * 64, I_Q = 4 * 24, I_KV = 2 * 32, I_O = 16 * 32, I_1 = 16 * 128, I_2 = 64 * 32, I_L = I_IN + I_Q + I_KV + I_O + I_1 + I_2;
      for (int it = gw; it < DEPTH * I_L; it += NGW) { const int l = it / I_L; int r = it % I_L; unsigned char* wl = ws + WS_W + (size_t)l * W_LAYER;
          if (r < I_IN) { transpose_item(a.in[5] + (size_t)l * 1024 * 2000, 1024, 2000, 2048, (bf16_t*)(wl + W_IN), 1, scr, r, lane); continue; } r -= I_IN;
          if (r < I_Q) { transpose_item(a.in[10] + (size_t)l * 256 * 768, 256, 768, 768, (bf16_t*)(wl + W_Q), 2, scr, r, lane); continue; } r -= I_Q;
          if (r < I_KV) { transpose_item(a.in[12] + (size_t)l * 128 * 1024, 128, 1024, 1024, (bf16_t*)(wl + W_KV), 0, scr, r, lane); continue; } r -= I_KV;
          if (r < I_O) { transpose_item(a.in[17] + (size_t)l * 1024 * 1024, 1024, 1024, 1024, (bf16_t*)(wl + W_O), 0, scr, r, lane); continue; } r -= I_O;
          if (r < I_1) { transpose_item(a.in[18] + (size_t)l * 1024 * 4096, 1024, 4096, 4096, (bf16_t*)(wl + W_1), 0, scr, r, lane); continue; } r -= I_1;
          transpose_item(a.in[19] + (size_t)l * 4096 * 1024, 4096, 1024, 1024, (bf16_t*)(wl + W_2), 0, scr, r, lane); } }
#endif
    grid.sync();
    prenorm_rows(x_in, HN, RSS, mod, 1024);
    for (int l = 0; l < DEPTH; ++l) { unsigned char* wl = ws + WS_W + (size_t)l * W_LAYER; const float* modl = mod + (size_t)l * 4 * NMOD;
        bias_rows((const bf16_t*)(wl + W_IN), NIN, modl, 0, BIAS + (size_t)l * 4 * NIN);
        bias_rows((const bf16_t*)(wl + W_1), DFF, modl, 3072, BIAS + 2 * 4 * NIN + (size_t)l * 4 * DFF); }
    GSYNC();

#pragma unroll 1
    for (int l = 0; l < DEPTH; ++l) {
        const float* modl = mod + (size_t)l * 4 * NMOD;
        unsigned char* wl = ws + WS_W + (size_t)l * W_LAYER;
        const float* xin = l == 0 ? x_in : xout;
#if (PHM >> 2) & 1
        REPEAT(2) { pg8::Gemm g{HN, (const bf16_t*)(wl + W_IN), T, NIN, DM}; pg8::StaticOrder S; S.init(T, NIN, G, (int)blockIdx.x);
          pg8::EpiBf16<0> E{PROJ, NIN, BIAS + (size_t)l * 4 * NIN, 0, 0, 1.f, RSS + (size_t)(2 * l) * T, NIN};
          pg8::gemm_phase<pg8::EpiBf16<0>, pg8::StaticOrder, true, true>(ldsl, g, S, E); }
#endif
        GSYNC();
#if (PHM >> 3) & 1
        REPEAT(3) prep_tokens(PROJ, QN, KVN, KB_, a.in[9] + l * 256, a.in[11] + l * 128, a.in[16] + l * 64, cosT, sinT);
#endif
#if (PHM >> 4) & 1
        REPEAT(4) gla_pass_a(ldsf, PROJ, a.in[6] + (size_t)l * 16 * 256, a.in[7] + l * 256, BT, GST, GDV);
#endif
        GSYNC();
#if (PHM >> 5) & 1
        REPEAT(5) { int kq = 256; asm volatile("" : "+s"(kq));
          pg8::Gemm g{QN, (const bf16_t*)(wl + W_Q), T, 512, kq}; pg8::StaticOrder S; S.init(T, 512, G, (int)blockIdx.x);
          pg8::EpiQN E{QB_, a.in[13] + l * 128, (PG8_LAS float*)(ldsl + EPI_OFF)};
          pg8::gemm_phase<pg8::EpiQN, pg8::StaticOrder, true, true>(ldsl, g, S, E); }
#endif
#if (PHM >> 13) & 1
        REPEAT(5) { int kq = 256; asm volatile("" : "+s"(kq));
          pg8::Gemm g{QN, (const bf16_t*)(wl + W_Q) + 512 * 256, T, 256, kq}; pg8::StaticOrder S; S.init(T, 256, G, (int)blockIdx.x);
          pg8::EpiQR E{QB_, a.in[15] + l * 64, cosT, sinT};
          pg8::gemm_phase<pg8::EpiQR, pg8::StaticOrder, true, true>(ldsl, g, S, E); }
#endif
#if (PHM >> 6) & 1
        REPEAT(5) { int kk = 128; asm volatile("" : "+s"(kk));
          pg8::Gemm g{KVN, (const bf16_t*)(wl + W_KV), T, 1024, kk}; pg8::StaticOrder S; S.init(T, 1024, G, (int)blockIdx.x);
          pg8::EpiKV E{KB_, VB_, a.in[14] + l * 128, (PG8_LAS float*)(ldsl + EPI_OFF)};
          pg8::gemm_phase<pg8::EpiKV, pg8::StaticOrder, true, true>(ldsl, g, S, E); }
#endif
#if (PHM >> 7) & 1
        gla_scan(GST, GDV);
#endif
        GSYNC();
#if (PHM >> 8) & 1
        REPEAT(8) att::attn_phase((char*)lds, (const att::bf16*)QB_, (const att::bf16*)KB_, (const att::bf16*)VB_, (att::bf16*)HN);
#endif
        __syncthreads();
#if (PHM >> 9) & 1
        REPEAT(9) gla_pass_c(PROJ, BT, GST, a.in[8] + l * 128, HN);
#endif
        GSYNC();
#if (PHM >> 10) & 1
        { pg8::Gemm g{HN, (const bf16_t*)(wl + W_O), T, DM, DM}; pg8::StaticOrder S; S.init(T, DM, G, (int)blockIdx.x);
          pg8::EpiResGate E{xin, xout, modl + 2048, AN1, modl + 4096, RSS + (size_t)(2 * l + 1) * T};
          pg8::gemm_phase<pg8::EpiResGate, pg8::StaticOrder, true, true>(ldsl, g, S, E); }
#endif
        GSYNC();
#if (PHM >> 11) & 1
        REPEAT(11) { pg8::Gemm g{AN1, (const bf16_t*)(wl + W_1), T, DFF, DM}; pg8::StaticOrder S; S.init(T, DFF, G, (int)blockIdx.x);
          pg8::EpiBf16<2> E{HB, DFF, BIAS + 2 * 4 * NIN + (size_t)l * 4 * DFF, 0, 0, 1.f, RSS + (size_t)(2 * l + 1) * T, DFF};
          pg8::gemm_phase<pg8::EpiBf16<2>, pg8::StaticOrder, true, true>(ldsl, g, S, E); }
#endif
        GSYNC();
#if (PHM >> 12) & 1
        { pg8::Gemm g{HB, (const bf16_t*)(wl + W_2), T, DM, DFF}; pg8::StaticOrder S; S.init(T, DM, G, (int)blockIdx.x);
          const bool more = l + 1 < DEPTH;
          pg8::EpiResGate E{xout, xout, modl + 5120, more ? HN : nullptr, mod + (size_t)(l + 1) * 4 * NMOD + 1024, RSS + (size_t)(2 * l + 2) * T};
          pg8::gemm_phase<pg8::EpiResGate, pg8::StaticOrder, true, true>(ldsl, g, S, E); }
#endif
        if (l + 1 < DEPTH) GSYNC();
    }
}

extern "C" void kernel_launch(void* const* d_in, const int* in_sizes, int n_in, void* d_out, int out_size, void* d_ws, size_t ws_size, hipStream_t stream) {
    static int grid = 0;
    if (grid == 0) {
        if (n_in != 20 || out_size != mk::T * mk::DM || ws_size < mk::WS_END) { fprintf(stderr, "kernel_launch: unexpected shapes (n_in %d out %d ws %zu)\n", n_in, out_size, ws_size); grid = -1; return; }
        int dev = 0, cus = 0, per = 0;
        (void)hipGetDevice(&dev); (void)hipDeviceGetAttribute(&cus, hipDeviceAttributeMultiprocessorCount, dev);
        (void)hipFuncSetAttribute((const void*)mega_fwd, hipFuncAttributeMaxDynamicSharedMemorySize, mk::LDS_BYTES);
        if (hipOccupancyMaxActiveBlocksPerMultiprocessor(&per, (const void*)mega_fwd, 512, mk::LDS_BYTES) != hipSuccess || per < 1) per = 1;
        (void)hipGetLastError();
        grid = cus * per; if (grid > 256) grid = 256;
    }
    if (grid < 0) return;
    (void)hipMemsetAsync((unsigned char*)d_ws + mk::WS_BAR, 0, XCD_BAR_WORDS * sizeof(unsigned), stream);
    Args a{};
    for (int i = 0; i < 20; ++i) a.in[i] = (const float*)d_in[i];
    a.out = (float*)d_out; a.ws = (unsigned char*)d_ws;
    for (int j = 0; j < 32; ++j) a.inv_freq[j] = powf(10000.0f, -(float)(2 * j) / 64.0f);
    void* args[] = {&a};
    hipError_t e = hipLaunchCooperativeKernel((const void*)mega_fwd, dim3(grid), dim3(512), args, mk::LDS_BYTES, stream);
    if (e != hipSuccess) fprintf(stderr, "kernel_launch: cooperative launch failed: %s (grid %d)\n", hipGetErrorString(e), grid);
}
```

```cpp
#include <hip/hip_runtime.h>
#include <hip/hip_bf16.h>
#include <hip/hip_cooperative_groups.h>
#include <cstdio>
#include <cstdint>
#include <cmath>
namespace cg = cooperative_groups;
#define LAS __attribute__((address_space(3)))
__device__ __forceinline__ int opaque_tid() { int t = threadIdx.x; asm volatile("" : "+v"(t)); return t; }
__device__ __forceinline__ int opaque_int(int v) { asm volatile("" : "+s"(v)); return v; }
constexpr int GRID = 256;
namespace pg8 {
#define PG8_LAS __attribute__((address_space(3)))
typedef unsigned short bf16_t;
typedef short bf16x8 __attribute__((ext_vector_type(8)));
typedef float f32x4 __attribute__((ext_vector_type(4)));
typedef unsigned u32x4 __attribute__((ext_vector_type(4)));
constexpr int BM = 256, BK = 64, HALF = 128, HTB = HALF * BK * 2  , STAGE_BYTES = 8 * HTB, NXCD = 8, WGM = 8;

__host__ __device__ __forceinline__ int lds_byte(int r, int c) { const int st = (r >> 4) * 2 + (c >> 5), rr = r & 15, cc = c & 31, ob = rr * 64 + cc * 2; return st * 1024 + (ob ^ (((ob >> 9) & 1) << 5)); }
__host__ __device__ __forceinline__ void stage_rc(int b, int& R, int& C) { const int st = b / 1024, sb = b % 1024, swz = sb ^ (((sb >> 9) & 1) << 5); R = (st >> 1) * 16 + swz / 64; C = (st & 1) * 32 + (swz % 64) / 2; }
__host__ __device__ __forceinline__ int perm32(int rho) { const int n = rho >> 4, i = rho & 15; return 8 * (i >> 2) + 4 * n + (i & 3); }

struct Unit { int pm, pn; };
struct Gemm { const bf16_t* A; const bf16_t* Bt; int M, N, K; };

struct StaticOrder {
    int nM, nN, nwg, G, c;
    __host__ __device__ void init(int M, int N, int G_, int c_) { nM = M / BM; nN = N / BM; nwg = nM * nN; G = G_; c = c_; }
    __host__ __device__ bool next(int i, Unit& u) const {
        const long L = (long)i * G + c; if (L >= nwg) return false;
        int wgid = (int)L; { const int q = nwg / NXCD, r = nwg % NXCD, xcd = wgid % NXCD, off = wgid / NXCD; wgid = (xcd < r ? xcd * (q + 1) : r * (q + 1) + (xcd - r) * q) + off; }
        const int nig = WGM * nN, gid = wgid / nig, fm = gid * WGM, gsz = (nM - fm) < WGM ? (nM - fm) : WGM;
        u.pm = fm + ((wgid % nig) % gsz); u.pn = (wgid % nig) / gsz; return true;
    }
    __device__ __forceinline__ void a_ready(const Unit&) const {}
    __device__ __forceinline__ void done(const Unit&) const {}
};

__device__ __forceinline__ unsigned cvt_pk_bf16(float lo, float hi) { unsigned r; asm volatile("v_cvt_pk_bf16_f32 %0, %1, %2" : "=v"(r) : "v"(lo), "v"(hi)); return r; }
typedef float f32x2 __attribute__((ext_vector_type(2)));
__device__ __forceinline__ f32x2 gelu_pk(f32x2 v) {
    const f32x2 av = __builtin_elementwise_abs(v), d = av * 0.2316418882f + 1.0f;
    f32x2 t; t.x = __builtin_amdgcn_rcpf(d.x); t.y = __builtin_amdgcn_rcpf(d.y);
    f32x2 q = t * 0.5307027145f + (-0.7265760135f); q = q * t + 0.7107068705f; q = q * t + (-0.142248368f); q = q * t + 0.127414796f; q = q * t;
    const f32x2 s = (v * v) * (-0.72134752044f);
    f32x2 e; e.x = __builtin_amdgcn_exp2f(s.x); e.y = __builtin_amdgcn_exp2f(s.y);
    const f32x2 m = v * (q * e), r = v - m;
    f32x2 o; o.x = v.x < 0.f ? m.x : r.x; o.y = v.y < 0.f ? m.y : r.y; return o;
}

template <int ACT  > struct EpiBf16 {
    static constexpr bool PERM = true, AFTER_DRAIN = false; static_assert(ACT == 0 || ACT == 1 || ACT == 2, "EpiBf16: ACT is 0 (none), 1 (gelu_pk) or 2 (relu squared)");
    bf16_t* O; int ldc; const float* bias; int split_cols; size_t split_stride; float scale0; const float* rowss = nullptr; int bstride = 0;
    __device__ __forceinline__ void operator()(const f32x4 (&acc)[2][2][4][2], const Unit& u, int wr, int wc, int fr, int fq) const {
        const int row0 = u.pm * BM + wr * 64 + fr; int colt = u.pn * BM; bf16_t* base = O;
        float sc = 1.f; if (split_cols) { const int t = colt / split_cols; base += (size_t)t * split_stride; colt -= t * split_cols; if (t == 0) sc = scale0; }
        const int col0 = colt + wc * 32 + 8 * fq, bcol0 = u.pn * BM + wc * 32 + 8 * fq;
        const float* bias = this->bias ? this->bias + (size_t)(u.pm >> 5) * bstride : nullptr;
        f32x4 bv[2][2];
#pragma unroll
        for (int bj = 0; bj < 2; ++bj)
#pragma unroll
            for (int n = 0; n < 2; ++n) bv[bj][n] = bias ? *(const f32x4*)(bias + bcol0 + bj * HALF + 4 * n) : (f32x4){0.f, 0.f, 0.f, 0.f};
#pragma unroll
        for (int ai = 0; ai < 2; ++ai)
#pragma unroll
            for (int m = 0; m < 4; ++m) { bf16_t* rowp = base + (size_t)(row0 + ai * HALF + m * 16) * ldc + col0;
                const float rs = rowss ? __builtin_amdgcn_rsqf(rowss[row0 + ai * HALF + m * 16] * (1.0f / 1024.0f) + 1e-6f) : 1.0f;
#pragma unroll
                for (int bj = 0; bj < 2; ++bj) { f32x4 v0 = acc[ai][bj][m][0] * rs + bv[bj][0], v1 = acc[ai][bj][m][1] * rs + bv[bj][1];
                    if (ACT == 1) { f32x2 a = gelu_pk((f32x2){v0[0], v0[1]}), b = gelu_pk((f32x2){v0[2], v0[3]}), c = gelu_pk((f32x2){v1[0], v1[1]}), d = gelu_pk((f32x2){v1[2], v1[3]});
                        v0 = (f32x4){a.x, a.y, b.x, b.y}; v1 = (f32x4){c.x, c.y, d.x, d.y}; }
                    if (ACT == 2) { v0 = __builtin_elementwise_max(v0, (f32x4){0.f, 0.f, 0.f, 0.f}); v1 = __builtin_elementwise_max(v1, (f32x4){0.f, 0.f, 0.f, 0.f}); v0 = v0 * v0; v1 = v1 * v1; }
                    v0 = v0 * sc; v1 = v1 * sc; u32x4 w; w.x = cvt_pk_bf16(v0[0], v0[1]); w.y = cvt_pk_bf16(v0[2], v0[3]); w.z = cvt_pk_bf16(v1[0], v1[1]); w.w = cvt_pk_bf16(v1[2], v1[3]);
                    *(u32x4*)(rowp + bj * HALF) = w; } }
    }
};
template <class Epi, class Sched, bool ALIGN_EPI = false, bool SP2 = false>
__device__ __forceinline__ void gemm_phase(PG8_LAS unsigned char* lds, const Gemm g, const Sched& S, const Epi& E) {
    const int tid = opaque_tid(), wid = __builtin_amdgcn_readfirstlane(tid >> 6), lane = tid & 63, wr = wid >> 2, wc = wid & 3, fr = lane & 15, fq = lane >> 4;
    const int K = g.K, nt = K / BK;
    unsigned voffA[2], voffB[2];
#pragma unroll
    for (int i = 0; i < 2; ++i) { int R, C; stage_rc(tid * 16 + i * 8192, R, C); const int Rb = Epi::PERM ? ((R & ~31) + perm32(R & 31)) : R;
        voffA[i] = (unsigned)(R * K + C) * 2u; voffB[i] = (unsigned)(Rb * K + C) * 2u; }
    const size_t kstep = (size_t)(BK * 2);
    const size_t hstep = (size_t)HALF * K * 2;
    const size_t tstep = 2 * hstep;
    const unsigned ldsw = (unsigned)wid * 1024u;
    const int aoff = lds_byte(wr * 64 + fr, fq * 8), boff = lds_byte(wc * 32 + fr, fq * 8);
#define PG8_SA(b, h) (((b) * 2 + (h)) * HTB)
#define PG8_SB(b, h) ((4 + (b) * 2 + (h)) * HTB)
#define PG8_STAGE(bufoff, gbase, voff) do { _Pragma("unroll") for (int _i = 0; _i < 2; ++_i) \
        __builtin_amdgcn_global_load_lds((const unsigned*)((const char*)(gbase) + (voff)[_i]), (PG8_LAS unsigned*)(lds + (bufoff) + ldsw + _i * 8192), 16, 0, 0); } while (0)
#define PG8_LDA(dst, b, h) do { _Pragma("unroll") for (int m = 0; m < 4; ++m) _Pragma("unroll") for (int k = 0; k < 2; ++k) dst[m][k] = *(const PG8_LAS bf16x8*)(lds + PG8_SA(b, h) + aoff + m * 2048 + k * 1024); } while (0)
#define PG8_LDB(dst, b, h) do { _Pragma("unroll") for (int n = 0; n < 2; ++n) _Pragma("unroll") for (int k = 0; k < 2; ++k) dst[n][k] = *(const PG8_LAS bf16x8*)(lds + PG8_SB(b, h) + boff + n * 2048 + k * 1024); } while (0)
#define PG8_MMA(ai, bj, At, Bt) do { __builtin_amdgcn_s_setprio(1); _Pragma("unroll") for (int m = 0; m < 4; ++m) _Pragma("unroll") for (int n = 0; n < 2; ++n) _Pragma("unroll") for (int k = 0; k < 2; ++k) \
        acc[ai][bj][m][n] = __builtin_amdgcn_mfma_f32_16x16x32_bf16(Bt[n][k], At[m][k], acc[ai][bj][m][n], 0, 0, 0); __builtin_amdgcn_s_setprio(0); } while (0)
#define PG8_WAIT_V(n) asm volatile("s_waitcnt vmcnt(" #n ")" ::: "memory")
#define PG8_WAIT_L(n) asm volatile("s_waitcnt lgkmcnt(" #n ")" ::: "memory")
#define PG8_BAR __builtin_amdgcn_s_barrier()
#define PG8_SCHED __builtin_amdgcn_sched_barrier(0)
    Unit cur, nxt; int ui = 0;
    if (!S.next(0, cur)) return;
    f32x4 acc[2][2][4][2];
#pragma unroll
    for (int a = 0; a < 2; ++a)
#pragma unroll
        for (int b = 0; b < 2; ++b)
#pragma unroll
            for (int m = 0; m < 4; ++m)
#pragma unroll
                for (int n = 0; n < 2; ++n) acc[a][b][m][n] = (f32x4){0.f, 0.f, 0.f, 0.f};
    bf16x8 At[4][2], B0[2][2], B1[2][2];
    const char* cA = (const char*)g.A + (size_t)cur.pm * tstep; const char* cB = (const char*)g.Bt + (size_t)cur.pn * tstep;
    S.a_ready(cur);
    if constexpr (SP2) {
        PG8_STAGE(PG8_SB(0, 0), cB, voffB); PG8_STAGE(PG8_SB(0, 1), cB + hstep, voffB); PG8_STAGE(PG8_SA(0, 0), cA, voffA); PG8_STAGE(PG8_SA(0, 1), cA + hstep, voffA);
        if (wr == 1) PG8_BAR;
        PG8_WAIT_V(2); PG8_BAR;
        PG8_STAGE(PG8_SB(1, 0), cB + kstep, voffB); PG8_STAGE(PG8_SA(1, 0), cA + kstep, voffA); PG8_STAGE(PG8_SB(1, 1), cB + hstep + kstep, voffB);
        PG8_WAIT_V(6); PG8_BAR;
    } else {
        PG8_STAGE(PG8_SB(0, 0), cB, voffB); PG8_STAGE(PG8_SA(0, 0), cA, voffA); PG8_STAGE(PG8_SB(0, 1), cB + hstep, voffB); PG8_STAGE(PG8_SA(0, 1), cA + hstep, voffA);
        if (wr == 1) PG8_BAR;
        PG8_WAIT_V(4); PG8_BAR;
        PG8_STAGE(PG8_SB(1, 0), cB + kstep, voffB); PG8_STAGE(PG8_SA(1, 0), cA + kstep, voffA); PG8_STAGE(PG8_SB(1, 1), cB + hstep + kstep, voffB);
        PG8_WAIT_V(6); PG8_BAR;
    }
    for (;;) {
        const bool has_next = S.next(ui + 1, nxt);
        const char* nA = has_next ? (const char*)g.A + (size_t)nxt.pm * tstep : cA; const char* nB = has_next ? (const char*)g.Bt + (size_t)nxt.pn * tstep : cB;
        for (int t = 0; t < nt; t += 2) {
            const bool last = (t == nt - 2);
            const char* a1 = cA + (size_t)(t + 1) * kstep;
            const char* a2 = last ? nA : cA + (size_t)(t + 2) * kstep; const char* b2 = last ? nB : cB + (size_t)(t + 2) * kstep;
            const char* a3 = a2 + kstep; const char* b3 = b2 + kstep;
            if (last && has_next) S.a_ready(nxt);
            if constexpr (SP2) {
            PG8_LDB(B0, 0, 0); PG8_LDB(B1, 0, 1); PG8_SCHED; PG8_LDA(At, 0, 0); PG8_STAGE(PG8_SA(1, 1), a1 + hstep, voffA);
            PG8_WAIT_V(8); PG8_WAIT_L(0); PG8_BAR; PG8_MMA(0, 0, At, B0); PG8_MMA(0, 1, At, B1); PG8_BAR; PG8_SCHED;
            PG8_LDA(At, 0, 1); PG8_STAGE(PG8_SB(0, 0), b2, voffB); PG8_STAGE(PG8_SB(0, 1), b2 + hstep, voffB); PG8_STAGE(PG8_SA(0, 0), a2, voffA);
            PG8_WAIT_V(8); PG8_WAIT_L(0); PG8_BAR; PG8_MMA(1, 0, At, B0); PG8_MMA(1, 1, At, B1); PG8_BAR; PG8_SCHED;
            PG8_LDB(B0, 1, 0); PG8_LDB(B1, 1, 1); PG8_SCHED; PG8_LDA(At, 1, 0); PG8_STAGE(PG8_SA(0, 1), a2 + hstep, voffA);
            PG8_WAIT_V(8); PG8_WAIT_L(0); PG8_BAR; PG8_MMA(0, 0, At, B0); PG8_MMA(0, 1, At, B1); PG8_BAR; PG8_SCHED;
            PG8_LDA(At, 1, 1); PG8_STAGE(PG8_SB(1, 0), b3, voffB); PG8_STAGE(PG8_SB(1, 1), b3 + hstep, voffB); PG8_STAGE(PG8_SA(1, 0), a3, voffA);
            PG8_WAIT_V(8); PG8_WAIT_L(0); PG8_BAR; PG8_MMA(1, 0, At, B0); PG8_MMA(1, 1, At, B1); PG8_BAR; PG8_SCHED;
            } else {
            PG8_LDB(B0, 0, 0); PG8_SCHED; PG8_LDA(At, 0, 0); PG8_STAGE(PG8_SA(1, 1), a1 + hstep, voffA);
            PG8_WAIT_L(8); PG8_BAR; PG8_WAIT_L(0); PG8_MMA(0, 0, At, B0); PG8_BAR; PG8_SCHED;
            PG8_LDB(B1, 0, 1); PG8_STAGE(PG8_SB(0, 0), b2, voffB);
            PG8_BAR; PG8_WAIT_L(0); PG8_MMA(0, 1, At, B1); PG8_BAR;
            PG8_LDA(At, 0, 1); PG8_STAGE(PG8_SA(0, 0), a2, voffA);
            PG8_BAR; PG8_WAIT_L(0); PG8_MMA(1, 0, At, B0); PG8_BAR; PG8_SCHED;
            PG8_STAGE(PG8_SB(0, 1), b2 + hstep, voffB);
            PG8_WAIT_V(6); PG8_BAR; PG8_MMA(1, 1, At, B1); PG8_BAR;
            PG8_LDB(B0, 1, 0); PG8_SCHED; PG8_LDA(At, 1, 0); PG8_STAGE(PG8_SA(0, 1), a2 + hstep, voffA);
            PG8_WAIT_L(8); PG8_BAR; PG8_WAIT_L(0); PG8_MMA(0, 0, At, B0); PG8_BAR; PG8_SCHED;
            PG8_LDB(B1, 1, 1); PG8_STAGE(PG8_SB(1, 0), b3, voffB);
            PG8_BAR; PG8_WAIT_L(0); PG8_MMA(0, 1, At, B1); PG8_BAR;
            PG8_LDA(At, 1, 1); PG8_STAGE(PG8_SA(1, 0), a3, voffA);
            PG8_BAR; PG8_WAIT_L(0); PG8_MMA(1, 0, At, B0); PG8_BAR; PG8_SCHED;
            PG8_STAGE(PG8_SB(1, 1), b3 + hstep, voffB);
            PG8_WAIT_V(6); PG8_BAR; PG8_MMA(1, 1, At, B1); PG8_BAR;
            }
        }
        if constexpr (ALIGN_EPI) { if (wr == 0) PG8_BAR; }
        if constexpr (!Epi::AFTER_DRAIN) { E(acc, cur, wr, wc, fr, fq); S.done(cur); }
        if (!has_next) break;
#pragma unroll
        for (int a = 0; a < 2; ++a)
#pragma unroll
            for (int b = 0; b < 2; ++b)
#pragma unroll
                for (int m = 0; m < 4; ++m)
#pragma unroll
                    for (int n = 0; n < 2; ++n) acc[a][b][m][n] = (f32x4){0.f, 0.f, 0.f, 0.f};
        cur = nxt; cA = nA; cB = nB; ++ui;
        if constexpr (ALIGN_EPI) { if (wr == 1) PG8_BAR; }
    }
    PG8_WAIT_V(0);
    if constexpr (!ALIGN_EPI) { if (wr == 0) PG8_BAR; }
    PG8_BAR;
    if constexpr (Epi::AFTER_DRAIN) { E.fused(acc, cur, wr, wc, fr, fq, lds, wid, lane); S.done(cur); }
#undef PG8_SA
#undef PG8_SB
#undef PG8_STAGE
#undef PG8_LDA
#undef PG8_LDB
#undef PG8_MMA
#undef PG8_WAIT_V
#undef PG8_WAIT_L
#undef PG8_BAR
#undef PG8_SCHED
}
typedef unsigned u32x2 __attribute__((ext_vector_type(2)));
constexpr float RMS_EPS_F = 1e-6f;
struct EpiResGate {
    static constexpr bool PERM = true, AFTER_DRAIN = false;
    const float* xin; float* xout; const float* gate;
    bf16_t* anext; const float* scale_next; float* rss_next;
    __device__ __forceinline__ void operator()(const f32x4 (&acc)[2][2][4][2], const Unit& u, int wr_, int wc_, int fr_, int fq_) const {
        int tx = threadIdx.x; asm volatile("" : "+v"(tx));
        const int fr = tx & 15, fq = (tx >> 4) & 3, wc = (tx >> 6) & 3, wr = tx >> 8;
        const int b = u.pm >> 5;
        const int col0 = u.pn * BM + wc * 32 + 8 * fq;
        const float* gp = gate + (size_t)b * 6144 + col0;
        f32x4 gv[2][2], sv[2][2];
#pragma unroll
        for (int bj = 0; bj < 2; ++bj)
#pragma unroll
            for (int n = 0; n < 2; ++n) { gv[bj][n] = *(const f32x4*)(gp + bj * HALF + n * 4);
                sv[bj][n] = anext ? *(const f32x4*)(scale_next + (size_t)b * 6144 + col0 + bj * HALF + n * 4) + 1.0f : (f32x4){0.f, 0.f, 0.f, 0.f}; }
#pragma unroll
        for (int ai = 0; ai < 2; ++ai)
#pragma unroll
            for (int m = 0; m < 4; ++m) { int row = u.pm * BM + ai * HALF + wr * 64 + m * 16 + fr; asm volatile("" : "+v"(row));
                const size_t off = (size_t)row * 1024 + col0; float ss = 0.f;
#pragma unroll
                for (int bj = 0; bj < 2; ++bj) { u32x4 w;
#pragma unroll
                    for (int n = 0; n < 2; ++n) { const f32x4 xi = *(const f32x4*)(xin + off + bj * HALF + n * 4);
                        const f32x4 xn = xi + gv[bj][n] * acc[ai][bj][m][n];
                        *(f32x4*)(xout + off + bj * HALF + n * 4) = xn;
                        if (anext) { ss += (xn[0] * xn[0] + xn[1] * xn[1]) + (xn[2] * xn[2] + xn[3] * xn[3]);
                            const f32x4 an = xn * sv[bj][n]; w[2 * n] = cvt_pk_bf16(an[0], an[1]); w[2 * n + 1] = cvt_pk_bf16(an[2], an[3]); } }
                    if (anext) *(u32x4*)(anext + off + bj * HALF) = w; }
                if (anext) { ss += __shfl_xor(ss, 16); ss += __shfl_xor(ss, 32); if (fq == 0) atomicAdd(rss_next + row, ss); }
                asm volatile("" ::: "memory"); }
    }
};
struct EpiQN {
    static constexpr bool PERM = true, AFTER_DRAIN = false;
    bf16_t* Q; const float* gn_nope; PG8_LAS float* P;
    __device__ __forceinline__ void operator()(const f32x4 (&acc)[2][2][4][2], const Unit& u, int wr_, int wc_, int fr_, int fq_) const {
        int tx = threadIdx.x; asm volatile("" : "+v"(tx));
        const int fr = tx & 15, fq = (tx >> 4) & 3, wc = (tx >> 6) & 3, wr = tx >> 8;
        const int b = u.pm >> 5, s0 = (u.pm & 31) * BM;
#pragma unroll
            for (int ai = 0; ai < 2; ++ai)
#pragma unroll
                for (int m = 0; m < 4; ++m)
#pragma unroll
                    for (int bj = 0; bj < 2; ++bj) { float s = 0.f;
#pragma unroll
                        for (int n = 0; n < 2; ++n) { const f32x4 x = acc[ai][bj][m][n]; s += (x[0] * x[0] + x[1] * x[1]) + (x[2] * x[2] + x[3] * x[3]); }
                        s += __shfl_xor(s, 16); s += __shfl_xor(s, 32);
                        if (fq == 0) P[((ai * HALF + wr * 64 + m * 16 + fr) * 2 + bj) * 4 + wc] = s; }
            asm volatile("s_waitcnt lgkmcnt(0)" ::: "memory"); __builtin_amdgcn_s_barrier(); asm volatile("" ::: "memory");
#pragma unroll
            for (int ai = 0; ai < 2; ++ai)
#pragma unroll
                for (int m = 0; m < 4; ++m) { int rl = ai * HALF + wr * 64 + m * 16 + fr; asm volatile("" : "+v"(rl));
#pragma unroll
                    for (int bj = 0; bj < 2; ++bj) { const f32x4 pp = *(const PG8_LAS f32x4*)(P + (rl * 2 + bj) * 4);
                        const float rr = 1.0f / sqrtf(((pp[0] + pp[1]) + (pp[2] + pp[3])) * (1.0f / 128.0f) + RMS_EPS_F);
                        const int head = 2 * u.pn + bj;
                        const unsigned qoff = (unsigned)(((b * 4 + head) * 8192 + s0 + rl) * 192 + wc * 32 + 8 * fq); u32x4 w;
#pragma unroll
                        for (int n = 0; n < 2; ++n) { const f32x4 g = *(const f32x4*)(gn_nope + wc * 32 + 8 * fq + 4 * n);
                            const f32x4 v = acc[ai][bj][m][n] * rr * g; w[2 * n] = cvt_pk_bf16(v[0], v[1]); w[2 * n + 1] = cvt_pk_bf16(v[2], v[3]); }
                        *(u32x4*)(Q + qoff) = w; }
                    asm volatile("" ::: "memory"); }
    }
};
struct EpiQR {
    static constexpr bool PERM = true, AFTER_DRAIN = false;
    bf16_t* Q; const float* gn_rope; const float* cosT; const float* sinT;
    __device__ __forceinline__ void operator()(const f32x4 (&acc)[2][2][4][2], const Unit& u, int wr_, int wc_, int fr_, int fq_) const {
        int tx = threadIdx.x; asm volatile("" : "+v"(tx));
        const int fr = tx & 15, fq = (tx >> 4) & 3, wc = (tx >> 6) & 3, wr = tx >> 8;
        const int b = u.pm >> 5, s0 = (u.pm & 31) * BM;
#pragma unroll
            for (int ai = 0; ai < 2; ++ai)
#pragma unroll
                for (int m = 0; m < 4; ++m) { int rl = ai * HALF + wr * 64 + m * 16 + fr; asm volatile("" : "+v"(rl)); float s = 0.f;
#pragma unroll
                    for (int bj = 0; bj < 2; ++bj)
#pragma unroll
                        for (int n = 0; n < 2; ++n) { const f32x4 x = acc[ai][bj][m][n]; s += (x[0] * x[0] + x[1] * x[1]) + (x[2] * x[2] + x[3] * x[3]); }
                    s += __shfl_xor(s, 16); s += __shfl_xor(s, 32);
                    const float rr = 1.0f / sqrtf(s * (1.0f / 64.0f) + RMS_EPS_F);
                    const size_t t = (size_t)u.pm * BM + rl;
                    bf16_t* qrow = Q + ((size_t)(b * 4 + wc) * 8192 + s0 + rl) * 192 + 128;
                    u32x4 wa, wb;
#pragma unroll
                    for (int n = 0; n < 2; ++n) { const int j0 = 8 * fq + 4 * n;
                        const f32x4 c4 = *(const f32x4*)(cosT + t * 32 + j0), s4 = *(const f32x4*)(sinT + t * 32 + j0);
                        const f32x4 g1 = *(const f32x4*)(gn_rope + j0), g2 = *(const f32x4*)(gn_rope + 32 + j0);
                        const f32x4 y1 = acc[ai][0][m][n] * rr * g1, y2 = acc[ai][1][m][n] * rr * g2;
                        const f32x4 o1 = y1 * c4 - y2 * s4, o2 = y2 * c4 + y1 * s4;
                        wa[2 * n] = cvt_pk_bf16(o1[0], o1[1]); wa[2 * n + 1] = cvt_pk_bf16(o1[2], o1[3]); wb[2 * n] = cvt_pk_bf16(o2[0], o2[1]); wb[2 * n + 1] = cvt_pk_bf16(o2[2], o2[3]); }
                    *(u32x4*)(qrow + 8 * fq) = wa; *(u32x4*)(qrow + 32 + 8 * fq) = wb;
                    asm volatile("" ::: "memory"); }
    }
};
struct EpiKV {
    static constexpr bool PERM = true, AFTER_DRAIN = false;
    bf16_t* Kb; bf16_t* Vb; const float* gn_k; PG8_LAS float* P;
    __device__ __forceinline__ void operator()(const f32x4 (&acc)[2][2][4][2], const Unit& u, int wr_, int wc_, int fr_, int fq_) const {
        int tx = threadIdx.x; asm volatile("" : "+v"(tx));
        const int fr = tx & 15, fq = (tx >> 4) & 3, wc = (tx >> 6) & 3, wr = tx >> 8;
        const int b = u.pm >> 5, s0 = (u.pm & 31) * BM;
#pragma unroll
        for (int ai = 0; ai < 2; ++ai)
#pragma unroll
            for (int m = 0; m < 4; ++m) { float s = 0.f;
#pragma unroll
                for (int n = 0; n < 2; ++n) { const f32x4 x = acc[ai][0][m][n]; s += (x[0] * x[0] + x[1] * x[1]) + (x[2] * x[2] + x[3] * x[3]); }
                s += __shfl_xor(s, 16); s += __shfl_xor(s, 32);
                if (fq == 0) P[(ai * HALF + wr * 64 + m * 16 + fr) * 4 + wc] = s; }
        asm volatile("s_waitcnt lgkmcnt(0)" ::: "memory"); __builtin_amdgcn_s_barrier(); asm volatile("" ::: "memory");
#pragma unroll
        for (int ai = 0; ai < 2; ++ai)
#pragma unroll
            for (int m = 0; m < 4; ++m) { int rl = ai * HALF + wr * 64 + m * 16 + fr; asm volatile("" : "+v"(rl));
                const f32x4 pp = *(const PG8_LAS f32x4*)(P + rl * 4);
                const float rr = 1.0f / sqrtf(((pp[0] + pp[1]) + (pp[2] + pp[3])) * (1.0f / 128.0f) + RMS_EPS_F);
                const size_t tok = (size_t)(b * 4 + u.pn) * 8192 + s0 + rl;
                bf16_t* krow = Kb + tok * 192; bf16_t* vrow = Vb + tok * 128;
                u32x4 w1, w2;
#pragma unroll
                for (int n = 0; n < 2; ++n) { const f32x4 g = *(const f32x4*)(gn_k + wc * 32 + 8 * fq + 4 * n);
                    const f32x4 kx = acc[ai][0][m][n] * rr * g, vx = acc[ai][1][m][n];
                    w1[2 * n] = cvt_pk_bf16(kx[0], kx[1]); w1[2 * n + 1] = cvt_pk_bf16(kx[2], kx[3]); w2[2 * n] = cvt_pk_bf16(vx[0], vx[1]); w2[2 * n + 1] = cvt_pk_bf16(vx[2], vx[3]); }
                *(u32x4*)(krow + wc * 32 + 8 * fq) = w1; *(u32x4*)(vrow + wc * 32 + 8 * fq) = w2;
                asm volatile("" ::: "memory"); }
    }
};
}
namespace att {
using bf16 = __hip_bfloat16;
typedef short bf16x8 __attribute__((ext_vector_type(8)));
typedef short s16x4 __attribute__((ext_vector_type(4)));
typedef float f32x16 __attribute__((ext_vector_type(16)));
typedef float f32x4 __attribute__((ext_vector_type(4)));
typedef unsigned u32x4 __attribute__((ext_vector_type(4)));
constexpr int DQ = 192, DV = 128, LDO = 1024, SEQL = 8192;
constexpr float SCALE = 0.07216878364870322f;
constexpr float THR = 8.f;
constexpr int NW = 8, QBLK = 32, KVBLK = 64, QB = NW * QBLK;
constexpr int SHM_V = KVBLK * DV * 2, SHM_K = KVBLK * DQ * 2;
constexpr int KPITCH = DQ * 2;
constexpr int NSLOT = 3;
constexpr int LDS_WS = NSLOT * (SHM_V + SHM_K), LDS_QP = LDS_WS + NW * 64 * 4, LDS_NEED = LDS_QP + NW * 4096;
#define KSWZ(row, colB) ((row) * 384 + ((colB) ^ (((row) & 7) << 4)))
#define SBAR() __builtin_amdgcn_sched_barrier(0)
__device__ __forceinline__ int v_st(int k, int c) { const int kk = (k & ~0xC) | ((k & 4) << 1) | ((k & 8) >> 1); return ((kk >> 3) * 4 + (c >> 5)) * 512 + ((kk & 7) * 32 + (c & 31)) * 2; }
__device__ __forceinline__ int v_rd_base(int lane) { return ((lane & 3) << 3) | (((lane >> 2) & 3) << 6) | (((lane >> 4) & 1) << 5) | (((lane >> 5) & 1) << 8); }
constexpr int v_rd_off(int d0, int ks, int half) { return d0 * 512 + ks * 4096 + half * 2048; }
__device__ __forceinline__ int crow(int r, int hi) { return (r & 3) + 8 * (r >> 2) + 4 * hi; }
__device__ __forceinline__ unsigned cvtpk(float lo, float hi) { unsigned r; asm volatile("v_cvt_pk_bf16_f32 %0, %1, %2" : "=v"(r) : "v"(lo), "v"(hi)); return r; }
__device__ __forceinline__ bf16x8 load8(const bf16* p) { return *reinterpret_cast<const bf16x8*>(p); }
__device__ __forceinline__ void mask_tile(f32x16& p0, f32x16& p1, int dq) {
    const float NEG = -__builtin_inff();
#pragma unroll
    for (int r = 0; r < 16; ++r) {
        const int c = (r & 3) + 8 * (r >> 2);
        if (dq - c < 0) p0[r] = NEG;
        if (dq - c - 32 < 0) p1[r] = NEG;
    }
}
__device__ __forceinline__ void partialSM(f32x16& p0, f32x16& p1, float& m_reg, float& mn, float& alpha) {
    float pmax = p0[0]; for (int r = 1; r < 16; ++r) pmax = fmaxf(pmax, p0[r]); for (int r = 0; r < 16; ++r) pmax = fmaxf(pmax, p1[r]);
    { auto rr = __builtin_amdgcn_permlane32_swap(__float_as_uint(pmax), __float_as_uint(pmax), false, false);
      pmax = fmaxf(__uint_as_float(rr[0]), __uint_as_float(rr[1])); }
    constexpr float C2 = 1.4426950408889634f * SCALE;
    if (__builtin_expect(__all((pmax - m_reg) * SCALE <= THR), 1)) { mn = m_reg; alpha = 1.f; }
    else { mn = fmaxf(m_reg, pmax); alpha = __builtin_amdgcn_exp2f((m_reg - mn) * C2); m_reg = mn; }
    const float mnL = -mn * C2;
    for (int r = 0; r < 16; ++r) p0[r] = fmaf(p0[r], C2, mnL); for (int r = 0; r < 16; ++r) p1[r] = fmaf(p1[r], C2, mnL);
    for (int r = 0; r < 16; ++r) p0[r] = __builtin_amdgcn_exp2f(p0[r]);
}
__device__ __forceinline__ void finishSM(f32x16& p0, f32x16& p1, float alpha, float& l_reg, bf16x8& pa0, bf16x8& pa1, bf16x8& pa2, bf16x8& pa3) {
    for (int r = 0; r < 16; ++r) p1[r] = __builtin_amdgcn_exp2f(p1[r]);
    float ps = 0; for (int r = 0; r < 16; ++r) ps += p0[r]; for (int r = 0; r < 16; ++r) ps += p1[r];
    { auto rr = __builtin_amdgcn_permlane32_swap(__float_as_uint(ps), __float_as_uint(ps), false, false);
      ps = __uint_as_float(rr[0]) + __uint_as_float(rr[1]); }
    l_reg = l_reg * alpha + ps;
#define PK4(P, B_, OUT) do { unsigned a0 = cvtpk(P[B_+0], P[B_+1]), a1 = cvtpk(P[B_+2], P[B_+3]);                          \
        unsigned b0 = cvtpk(P[B_+4], P[B_+5]), b1 = cvtpk(P[B_+6], P[B_+7]);                                             \
        auto r0 = __builtin_amdgcn_permlane32_swap(a0, b0, false, false); auto r1 = __builtin_amdgcn_permlane32_swap(a1, b1, false, false); \
        u32x4 w = {r0[0], r1[0], r0[1], r1[1]}; OUT = *reinterpret_cast<bf16x8*>(&w); } while (0)
    PK4(p0, 0, pa0); PK4(p0, 8, pa1); PK4(p1, 0, pa2); PK4(p1, 8, pa3);
#undef PK4
}
__device__ __forceinline__ void glds16(const void* gsrc, unsigned lds_dst) { unsigned keep;
    asm volatile("s_mov_b32 %0, m0\n\ts_mov_b32 m0, %2\n\ts_nop 0\n\tglobal_load_lds_dwordx4 %1, off\n\ts_mov_b32 m0, %0" : "=&s"(keep) : "v"(gsrc), "s"(lds_dst) : "memory"); }
__device__ __forceinline__ void qkt(f32x16& p0, f32x16& p1, const char* Kslot, int r32, int hi, const bf16x8* qr, const char* qsp) {
    p0 = f32x16{}; p1 = f32x16{};
    const char* kb[4];
#pragma unroll
    for (int dd = 0; dd < 4; ++dd) kb[dd] = Kslot + KSWZ(r32, (dd * 16 + hi * 8) * 2);
#pragma unroll
    for (int d0 = 0; d0 < 12; ++d0) { const char* a = kb[d0 & 3] + (d0 >> 2) * 128;
        bf16x8 b0 = *reinterpret_cast<const bf16x8*>(a);
        bf16x8 b1 = *reinterpret_cast<const bf16x8*>(a + 32 * KPITCH);
        const bf16x8 qf = d0 < 8 ? qr[d0] : *reinterpret_cast<const bf16x8*>(qsp + (d0 - 8) * 1024);
        p0 = __builtin_amdgcn_mfma_f32_32x32x16_bf16(b0, qf, p0, 0, 0, 0);
        p1 = __builtin_amdgcn_mfma_f32_32x32x16_bf16(b1, qf, p1, 0, 0, 0); }
}
__device__ __forceinline__ void pv_tile(f32x16* o, int vb, bf16x8 pa0, bf16x8 pa1, bf16x8 pa2, bf16x8 pa3) {
#define TRRD(dst, off) asm volatile("ds_read_b64_tr_b16 %0, %1 offset:%2" : "=&v"(dst) : "v"(vb), "i"(off) : "memory")
#define PV_D0(d0) do { s16x4 l0, l1, l2, l3, h0, h1, h2, h3; constexpr int b_ = v_rd_off(d0, 0, 0);     \
        TRRD(l0, b_); TRRD(h0, b_ + 2048); TRRD(l1, b_ + 4096); TRRD(h1, b_ + 6144); TRRD(l2, b_ + 8192); TRRD(h2, b_ + 10240); TRRD(l3, b_ + 12288); TRRD(h3, b_ + 14336); \
        asm volatile("s_waitcnt lgkmcnt(0)" ::: "memory"); SBAR();   \
        o[d0] = __builtin_amdgcn_mfma_f32_32x32x16_bf16(pa0, (bf16x8){l0[0], l0[1], l0[2], l0[3], h0[0], h0[1], h0[2], h0[3]}, o[d0], 0, 0, 0);   \
        o[d0] = __builtin_amdgcn_mfma_f32_32x32x16_bf16(pa1, (bf16x8){l1[0], l1[1], l1[2], l1[3], h1[0], h1[1], h1[2], h1[3]}, o[d0], 0, 0, 0);   \
        o[d0] = __builtin_amdgcn_mfma_f32_32x32x16_bf16(pa2, (bf16x8){l2[0], l2[1], l2[2], l2[3], h2[0], h2[1], h2[2], h2[3]}, o[d0], 0, 0, 0);   \
        o[d0] = __builtin_amdgcn_mfma_f32_32x32x16_bf16(pa3, (bf16x8){l3[0], l3[1], l3[2], l3[3], h3[0], h3[1], h3[2], h3[3]}, o[d0], 0, 0, 0); } while (0)
    PV_D0(0); PV_D0(1); PV_D0(2); PV_D0(3);
#undef PV_D0
#undef TRRD
}
struct BlockRef { const bf16* Q; const bf16* K; const bf16* V; bf16* O; int P0; };
#define WAIT_BAR(N) asm volatile("s_waitcnt vmcnt(" #N ") lgkmcnt(0)\n\ts_barrier" ::: "memory")
__device__ __forceinline__ void attn_block(const BlockRef& cur, char* lds) {
    const int tid = opaque_tid(), wid = __builtin_amdgcn_readfirstlane(tid >> 6), lane = tid & 63, r32 = lane & 31, hi = lane >> 5;
    const int NT = cur.P0 / KVBLK + QB / KVBLK;
    const int qlo = cur.P0 + wid * QBLK, qm = qlo + r32 - 4 * hi;
    char* V_lds = lds; char* K_lds = lds + NSLOT * SHM_V;
    float* ws = (float*)(lds + LDS_WS) + wid * 64; float* li_l = ws, * al_l = ws + 32;
    float m_reg = -1e30f, l_reg = 0; f32x16 o[4] = {};
    const unsigned lds0 = (unsigned)(uintptr_t)lds;
    const int vb0 = (int)lds0 + v_rd_base(lane);
    unsigned kgo[3], vgo[2];
#pragma unroll
    for (int i = 0; i < 3; ++i) { const int ob = (wid * 3 + i) * 1024 + lane * 16, row = ob / 384, rem = ob % 384, g = rem >> 7, cp = (rem & 127) >> 4, c = cp ^ (row & 7);
        kgo[i] = (unsigned)(row * 384 + g * 128 + c * 16); }
#pragma unroll
    for (int i = 0; i < 2; ++i) { const int ob = (wid * 2 + i) * 1024 + lane * 16, st = ob >> 9, rem = ob & 511, kk = (st >> 2) * 8 + (rem >> 6), c = (st & 3) * 32 + ((rem & 63) >> 1);
        const int k = (kk & ~0xC) | ((kk & 4) << 1) | ((kk & 8) >> 1);
        vgo[i] = (unsigned)(k * 256 + c * 2); }
    const char* Kg = (const char*)cur.K; const char* Vg = (const char*)cur.V;
#define DMA_TILE(t, slot) do { const char* kt_ = Kg + (size_t)(t) * (KVBLK * DQ * 2); const char* vt_ = Vg + (size_t)(t) * (KVBLK * DV * 2);                       \
        const unsigned kd_ = lds0 + NSLOT * SHM_V + (slot) * SHM_K + wid * 3072, vd_ = lds0 + (slot) * SHM_V + wid * 2048;                                         \
        glds16(kt_ + kgo[0], (unsigned)__builtin_amdgcn_readfirstlane(kd_)); glds16(kt_ + kgo[1], (unsigned)__builtin_amdgcn_readfirstlane(kd_ + 1024));           \
        glds16(kt_ + kgo[2], (unsigned)__builtin_amdgcn_readfirstlane(kd_ + 2048));                                                                                \
        glds16(vt_ + vgo[0], (unsigned)__builtin_amdgcn_readfirstlane(vd_)); glds16(vt_ + vgo[1], (unsigned)__builtin_amdgcn_readfirstlane(vd_ + 1024)); } while (0)
    DMA_TILE(0, 0); DMA_TILE(1, 1);
    bf16x8 qr[8];
    char* qsp = lds + LDS_QP + wid * 4096 + lane * 16;
#pragma unroll
    for (int d0 = 0; d0 < 8; ++d0) qr[d0] = load8(cur.Q + (size_t)(wid * QBLK + r32) * DQ + d0 * 16 + hi * 8);
#pragma unroll
    for (int d0 = 8; d0 < 12; ++d0) *(bf16x8*)(qsp + (d0 - 8) * 1024) = load8(cur.Q + (size_t)(wid * QBLK + r32) * DQ + d0 * 16 + hi * 8);
    WAIT_BAR(0);
#define RESC(a) do { if (__any((a) < 1.f)) { if (hi == 0) al_l[r32] = (a); asm volatile("s_waitcnt lgkmcnt(0)" ::: "memory");              \
                     for (int d_ = 0; d_ < 4; ++d_) for (int r = 0; r < 16; ++r) o[d_][r] *= al_l[crow(r, hi)]; } } while (0)
#define KBASE(t) ((t) * KVBLK)
#define MASKT(P0_, P1_, t) do { const int kb_ = KBASE(t); if (kb_ + KVBLK - 1 > qlo) mask_tile(P0_, P1_, qm - kb_); } while (0)
    f32x16 p0, p1; float mn, al; bf16x8 pa0, pa1, pa2, pa3;
    int sl = 0, sl2 = 2;
    for (int t = 0; t < NT; ++t) {
        if (t + 2 < NT) DMA_TILE(t + 2, sl2);
        qkt(p0, p1, K_lds + sl * SHM_K, r32, hi, qr, qsp); SBAR();
        MASKT(p0, p1, t); partialSM(p0, p1, m_reg, mn, al);
        RESC(al);
        finishSM(p0, p1, al, l_reg, pa0, pa1, pa2, pa3); SBAR();
        pv_tile(o, vb0 + sl * SHM_V, pa0, pa1, pa2, pa3); SBAR();
        if (t + 2 < NT) WAIT_BAR(5); else WAIT_BAR(0);
        sl2 = sl; sl = (sl == NSLOT - 1) ? 0 : sl + 1;
    }
    if (hi == 0) li_l[r32] = l_reg; asm volatile("s_waitcnt lgkmcnt(0)" ::: "memory");
    float rli[16];
#pragma unroll
    for (int r = 0; r < 16; ++r) rli[r] = __builtin_amdgcn_rcpf(li_l[crow(r, hi)]);
    bf16* Ow = cur.O + (size_t)(wid * QBLK) * LDO;
#pragma unroll
    for (int r = 0; r < 16; ++r) { const int orow = crow(r, hi);
#pragma unroll
        for (int d0 = 0; d0 < 4; ++d0) { const float v = o[d0][r] * rli[r];
            const float vn = __shfl_xor(v, 1);
            if ((r32 & 1) == 0) *(unsigned*)(Ow + (size_t)orow * LDO + d0 * 32 + r32) = cvtpk(v, vn); } }
    WAIT_BAR(0);
#undef RESC
#undef KBASE
#undef MASKT
#undef DMA_TILE
}
#undef WAIT_BAR
struct Item { int bh, qb0, qb1; };
__device__ __forceinline__ Item decode(int L) { Item it; const int xcd = L & 7, k = L >> 3; it.bh = (k >> 4) * 8 + xcd; const int x = k & 15; it.qb0 = x; it.qb1 = 31 - x; return it; }
__device__ __forceinline__ BlockRef mkref(const Item& it, int pass, const bf16* Q, const bf16* K, const bf16* V, bf16* mixed) {
    const int qb = pass ? it.qb1 : it.qb0; BlockRef r;
    r.Q = Q + ((size_t)it.bh * SEQL + (size_t)qb * QB) * DQ; r.K = K + (size_t)it.bh * SEQL * DQ; r.V = V + (size_t)it.bh * SEQL * DV;
    r.O = mixed + ((size_t)(it.bh >> 2) * SEQL + (size_t)qb * QB) * LDO + 512 + (it.bh & 3) * 128; r.P0 = qb * QB;
    return r;
}
__device__ __forceinline__ void attn_phase(char* lds, const bf16* Q, const bf16* K, const bf16* V, bf16* mixed) {
    for (int L = blockIdx.x; L < 256; L += GRID) {
        const Item it = decode(L);
        attn_block(mkref(it, 0, Q, K, V, mixed), lds);
        attn_block(mkref(it, 1, Q, K, V, mixed), lds);
    }
}
#undef KSWZ
#undef SBAR
}
namespace mk {
typedef unsigned short bf16_t;
typedef short bf16x8 __attribute__((ext_vector_type(8)));
typedef float f32x4 __attribute__((ext_vector_type(4)));
typedef float f32x2 __attribute__((ext_vector_type(2)));
typedef float f32x16 __attribute__((ext_vector_type(16)));
typedef unsigned u32x2 __attribute__((ext_vector_type(2)));
typedef unsigned u32x4 __attribute__((ext_vector_type(4)));
constexpr int NB = 4, SEQ = 8192, T = NB * SEQ, DM = 1024, DEPTH = 2, DFF = 4096, NIN = 2048, NMOD = 6 * DM;
constexpr float EPS = 1e-6f;
constexpr size_t MiB = 1u << 20;
constexpr size_t W_IN = 0, W_Q = 4 * MiB, W_KV = W_Q + 384 * 1024, W_O = W_KV + 256 * 1024, W_1 = W_O + 2 * MiB, W_2 = W_1 + 8 * MiB, W_LAYER = 23 * MiB;
static_assert(W_2 + 8 * MiB <= W_LAYER, "weights");
constexpr size_t WS_W = 0, WS_MOD = 46 * MiB, WS_COS = 47 * MiB, WS_SIN = 51 * MiB, WS_HN = 55 * MiB, WS_QN = 119 * MiB, WS_KVN = 135 * MiB,
                 WS_GST = 143 * MiB, WS_GDV = 207 * MiB, WS_R = 208 * MiB, WS_BT = 464 * MiB, WS_RSS = 496 * MiB, WS_BIAS = 497 * MiB, WS_END = 498 * MiB;
constexpr size_t WS_BAR = WS_MOD + 512 * 1024;
constexpr size_t R_PROJ = 0, R_Q = 128 * MiB, R_K = 176 * MiB, R_V = 224 * MiB;
constexpr int MISC_OFF = 157696;
constexpr int LDS_BYTES = MISC_OFF + 64;
constexpr int EPI_OFF = 131072;

__device__ __forceinline__ float bf2f(unsigned short v) { return __uint_as_float((unsigned)v << 16); }
__device__ __forceinline__ unsigned f2bf(float f) { unsigned u = __float_as_uint(f); return (u + 0x7fffu + ((u >> 16) & 1u)) >> 16; }
__device__ __forceinline__ unsigned pk2(float lo, float hi) { return f2bf(lo) | (f2bf(hi) << 16); }
__device__ __forceinline__ float wave_sum(float v) {
#pragma unroll
    for (int o = 1; o < 64; o <<= 1) v += __shfl_xor(v, o);
    return v;
}
__device__ __forceinline__ float half_sum32(float v) {
#pragma unroll
    for (int o = 1; o < 32; o <<= 1) v += __shfl_xor(v, o);
    return v;
}
__device__ __forceinline__ int crow(int r, int hi) { return (r & 3) + 8 * (r >> 2) + 4 * hi; }

__device__ __forceinline__ int src_col(int map, int n) {
    if (map == 1) { if (n < 1536) return n; if (n < 1984) return n + 16; if (n < 2000) return n - 1984 + 1536; return -1; }
    if (map == 2) { if (n < 512) return (n >> 7) * 192 + (n & 127); const int c = n - 512, bj = c >> 7, hd = (c & 127) >> 5, w = c & 31; return hd * 192 + 128 + 32 * bj + w; }
    return n;
}
__device__ __forceinline__ void transpose_item(const float* W, int K, int N, int NP, bf16_t* WT, int map, LAS float* scr, int item, int lane) {
    const int nblk = NP / 32, kb = item / nblk, nb = item % nblk, k0 = 64 * kb, n0 = 32 * nb;
    const int sc = src_col(map, n0 + (lane & 31));
    float tv[32];
#pragma unroll
    for (int i = 0; i < 32; ++i) { const int kk = 2 * i + (lane >> 5); tv[i] = sc >= 0 ? W[(size_t)(k0 + kk) * N + sc] : 0.f; }
#pragma unroll
    for (int i = 0; i < 32; ++i) { const int kk = 2 * i + (lane >> 5); scr[kk * 33 + (lane & 31)] = tv[i]; }
    asm volatile("s_waitcnt lgkmcnt(0)" ::: "memory");
    const int c = lane & 7;
#pragma unroll
    for (int j = 0; j < 4; ++j) { const int n = (lane >> 3) + 8 * j; const LAS float* s = scr + (8 * c) * 33 + n;
        u32x4 o; o.x = pk2(s[0 * 33], s[1 * 33]); o.y = pk2(s[2 * 33], s[3 * 33]); o.z = pk2(s[4 * 33], s[5 * 33]); o.w = pk2(s[6 * 33], s[7 * 33]);
        *(u32x4*)(WT + (size_t)(n0 + n) * K + k0 + 8 * c) = o; }
    asm volatile("s_waitcnt lgkmcnt(0)" ::: "memory");
}
__device__ __forceinline__ void adaln_unit(int u, const float* c, const float* w_ada, const float* b_ada, float* mod, LAS float* lds) {
    const int tid = opaque_tid(), wave = tid >> 6, lane = tid & 63;
    const int l = u / 96, n0 = (u % 96) * 64;
    LAS float* sc = lds; LAS float* red = lds + 4096;
    for (int i = tid; i < 4096; i += 512) { const float v = c[i]; sc[i] = v / (1.0f + __expf(-v)); }
    __syncthreads();
    const float* wp = w_ada + (size_t)l * DM * NMOD + n0 + lane;
    float a0 = 0.f, a1 = 0.f, a2 = 0.f, a3 = 0.f;
#pragma unroll 32
    for (int k = wave * 128; k < wave * 128 + 128; ++k) { const float w = wp[(size_t)k * NMOD]; a0 += sc[k] * w; a1 += sc[1024 + k] * w; a2 += sc[2048 + k] * w; a3 += sc[3072 + k] * w; }
    red[(wave * 4 + 0) * 64 + lane] = a0; red[(wave * 4 + 1) * 64 + lane] = a1; red[(wave * 4 + 2) * 64 + lane] = a2; red[(wave * 4 + 3) * 64 + lane] = a3;
    __syncthreads();
    if (tid < 256) { const int b = tid >> 6; float s = b_ada[(size_t)l * NMOD + n0 + lane];
#pragma unroll
        for (int w = 0; w < 8; ++w) s += red[(w * 4 + b) * 64 + lane];
        mod[((size_t)l * 4 + b) * NMOD + n0 + lane] = s; }
    __syncthreads();
}
__device__ __forceinline__ void prenorm_rows(const float* xin, bf16_t* an, float* rss, const float* modl, int coff) {
    const int tid = opaque_tid(), lane = tid & 63, gw = blockIdx.x * 8 + (tid >> 6), NGW = GRID * 8;
    for (int t = gw; t < T; t += NGW) {
        const f32x4* xr = (const f32x4*)(xin + (size_t)t * DM) + lane; f32x4 v[4]; float ss = 0.f;
#pragma unroll
        for (int j = 0; j < 4; ++j) { v[j] = xr[64 * j]; ss += (v[j][0] * v[j][0] + v[j][1] * v[j][1]) + (v[j][2] * v[j][2] + v[j][3] * v[j][3]); }
        ss = wave_sum(ss); if (lane == 0) rss[t] = ss;
        const float* mb = modl + (size_t)(t >> 13) * NMOD;
#pragma unroll
        for (int j = 0; j < 4; ++j) { const int col = 256 * j + 4 * lane;
            const f32x4 sc = *(const f32x4*)(mb + coff + col);
            const f32x4 h = v[j] * (sc + 1.0f);
            u32x2 w; w.x = pk2(h[0], h[1]); w.y = pk2(h[2], h[3]); *(u32x2*)(an + (size_t)t * DM + col) = w; }
    }
}
__device__ __forceinline__ void bias_rows(const bf16_t* Wt, int N, const float* modl, int soff, float* bias) {
    const int tid = opaque_tid(), lane = tid & 63, gw = blockIdx.x * 8 + (tid >> 6), NGW = GRID * 8;
    for (int n = gw; n < N; n += NGW) {
        const u32x4 w0 = *(const u32x4*)(Wt + (size_t)n * 1024 + 16 * lane), w1 = *(const u32x4*)(Wt + (size_t)n * 1024 + 16 * lane + 8);
        float wf[16];
#pragma unroll
        for (int e2 = 0; e2 < 4; ++e2) { wf[2 * e2] = __uint_as_float(w0[e2] << 16); wf[2 * e2 + 1] = __uint_as_float(w0[e2] & 0xffff0000u);
                                         wf[8 + 2 * e2] = __uint_as_float(w1[e2] << 16); wf[8 + 2 * e2 + 1] = __uint_as_float(w1[e2] & 0xffff0000u); }
#pragma unroll
        for (int b = 0; b < 4; ++b) { const float* sp = modl + (size_t)b * NMOD + soff + 16 * lane; float s = 0.f;
#pragma unroll
            for (int q = 0; q < 4; ++q) { const f32x4 sv = *(const f32x4*)(sp + 4 * q); s += (sv[0] * wf[4 * q] + sv[1] * wf[4 * q + 1]) + (sv[2] * wf[4 * q + 2] + sv[3] * wf[4 * q + 3]); }
            s = wave_sum(s); if (lane == 0) bias[(size_t)b * N + n] = s; }
    }
}
__device__ __forceinline__ void prep_tokens(const bf16_t* __restrict__ proj, bf16_t* __restrict__ qn, bf16_t* __restrict__ kvn, bf16_t* __restrict__ Kb, const float* __restrict__ qa, const float* __restrict__ kva, const float* __restrict__ kr,
                                            const float* __restrict__ cosT, const float* __restrict__ sinT) {
    const int tid = opaque_tid(), lane = tid & 63, gw = blockIdx.x * 8 + (tid >> 6), NGW = GRID * 8;
#pragma unroll 4
    for (int t = gw; t < T; t += NGW) {
        const bf16_t* pr = proj + (size_t)t * NIN;
        { const u32x2 w = *(const u32x2*)(pr + 1536 + 4 * lane);
          const float q0 = __uint_as_float(w.x << 16), q1 = __uint_as_float(w.x & 0xffff0000u), q2 = __uint_as_float(w.y << 16), q3 = __uint_as_float(w.y & 0xffff0000u);
          const float rr = 1.0f / sqrtf(wave_sum((q0 * q0 + q1 * q1) + (q2 * q2 + q3 * q3)) * (1.0f / 256.0f) + EPS);
          const f32x4 g = *(const f32x4*)(qa + 4 * lane);
          u32x2 o; o.x = pk2(q0 * rr * g[0], q1 * rr * g[1]); o.y = pk2(q2 * rr * g[2], q3 * rr * g[3]); *(u32x2*)(qn + (size_t)t * 256 + 4 * lane) = o; }
        { const unsigned w = *(const unsigned*)(pr + 1792 + 2 * lane);
          const float k0 = __uint_as_float(w << 16), k1 = __uint_as_float(w & 0xffff0000u);
          const float rr = 1.0f / sqrtf(wave_sum(k0 * k0 + k1 * k1) * (1.0f / 128.0f) + EPS);
          const f32x2 g = *(const f32x2*)(kva + 2 * lane);
          *(unsigned*)(kvn + (size_t)t * 128 + 2 * lane) = pk2(k0 * rr * g[0], k1 * rr * g[1]); }
        { float y = bf2f(pr[1920 + lane]);
          const float rr = 1.0f / sqrtf(wave_sum(y * y) * (1.0f / 64.0f) + EPS);
          y = y * rr * kr[lane];
          const float pn = __shfl_xor(y, 32); const int j = lane & 31;
          const float c = cosT[(size_t)t * 32 + j], s = sinT[(size_t)t * 32 + j];
          const float o = lane < 32 ? y * c - pn * s : y * c + pn * s;
          const bf16_t ob = (bf16_t)f2bf(o); const int b = t >> 13, sp = t & 8191;
#pragma unroll
          for (int h = 0; h < 4; ++h) Kb[((size_t)(b * 4 + h) * SEQ + sp) * 192 + 128 + lane] = ob; }
    }
}
__device__ __forceinline__ void gla_pass_a(LAS float* ldsf, const bf16_t* proj, const float* wgu, const float* bg, float* Btab, float* Gst, float* Gdv) {
    const int tid = opaque_tid(), lane = tid & 63, r = lane & 31, hh = lane >> 5, wv = tid >> 6, gw = blockIdx.x * 8 + wv, NGW = GRID * 8;
    LAS float* Bw = ldsf + wv * 4096;
    for (int u = gw; u < 16 * 128 * 2; u += NGW) { const int item = u >> 1, dkb = u & 1;
        const int bh = item >> 7, n = item & 127, b = bh >> 2, h = bh & 3; const size_t row0 = (size_t)b * SEQ + (size_t)n * 64;
        const int dk = 32 * dkb + r;
        float bl;
        { float w[16];
#pragma unroll
          for (int q = 0; q < 16; ++q) w[q] = wgu[q * 256 + h * 64 + dk];
          const float bias = bg[h * 64 + dk];
          float loc[32]; float a = 0.f;
#pragma unroll
          for (int t0 = 0; t0 < 32; t0 += 8) { u32x4 g0[8], g1[8];
#pragma unroll
              for (int i = 0; i < 8; ++i) { const bf16_t* ga = proj + (row0 + 32 * hh + t0 + i) * NIN + 1984; g0[i] = *(const u32x4*)ga; g1[i] = *(const u32x4*)(ga + 8); }
#pragma unroll
              for (int i = 0; i < 8; ++i) { float x = bias;
#pragma unroll
                  for (int e2 = 0; e2 < 4; ++e2) { x += __uint_as_float(g0[i][e2] << 16) * w[2 * e2] + __uint_as_float(g0[i][e2] & 0xffff0000u) * w[2 * e2 + 1];
                                                   x += __uint_as_float(g1[i][e2] << 16) * w[8 + 2 * e2] + __uint_as_float(g1[i][e2] & 0xffff0000u) * w[8 + 2 * e2 + 1]; }
                  a += (fminf(x, 0.f) - __logf(1.0f + __expf(-fabsf(x)))) * (1.0f / 16.0f);
                  loc[t0 + i] = a; } }
          const float tot0 = __shfl(a, r);
          const float off = hh ? tot0 : 0.f;
#pragma unroll
          for (int t = 0; t < 32; ++t) { const float v = loc[t] + off; Bw[(32 * hh + t) * 33 + r] = v; Btab[(row0 + 32 * hh + t) * 256 + h * 64 + dk] = v; }
          asm volatile("s_waitcnt lgkmcnt(0)" ::: "memory");
          bl = Bw[63 * 33 + r]; }
        f32x16 acc[4] = {};
#pragma unroll
        for (int ks = 0; ks < 4; ++ks) { bf16x8 bv;
#pragma unroll
            for (int j = 0; j < 8; ++j) { const int t = 16 * ks + 8 * hh + j;
                bv[j] = (short)f2bf(bf2f(proj[(row0 + t) * NIN + 256 + h * 64 + dk]) * __expf(bl - Bw[t * 33 + r])); }
#pragma unroll
            for (int dvb = 0; dvb < 4; ++dvb) { bf16x8 av;
#pragma unroll
                for (int j = 0; j < 8; ++j) { const int t = 16 * ks + 8 * hh + j; av[j] = (short)proj[(row0 + t) * NIN + 512 + h * 128 + 32 * dvb + r]; }
                acc[dvb] = __builtin_amdgcn_mfma_f32_32x32x16_bf16(av, bv, acc[dvb], 0, 0, 0); } }
#pragma unroll
        for (int dvb = 0; dvb < 4; ++dvb) { float* go = Gst + ((size_t)item * 128 + 32 * dvb) * 64 + dk;
#pragma unroll
            for (int i = 0; i < 16; ++i) go[(size_t)crow(i, hh) * 64] = acc[dvb][i]; }
        if (hh == 0) Gdv[(size_t)item * 64 + dk] = __expf(bl);
        asm volatile("s_waitcnt lgkmcnt(0)" ::: "memory");
    }
}
__device__ __forceinline__ void gla_scan(float* Gst, const float* Gdv) {
    const int gt = blockIdx.x * 512 + opaque_tid(), GT = GRID * 512;
    for (int e = gt; e < 16 * 8192; e += GT) { const int bh = e >> 13, idx = e & 8191, dk = idx & 63;
        float* base = Gst + (size_t)bh * 128 * 8192 + idx; const float* dvp = Gdv + (size_t)bh * 128 * 64 + dk;
        float s = 0.f;
        for (int n0 = 0; n0 < 128; n0 += 16) { float u[16], dd[16];
#pragma unroll
            for (int i = 0; i < 16; ++i) { u[i] = base[(size_t)(n0 + i) * 8192]; dd[i] = dvp[(n0 + i) * 64]; }
#pragma unroll
            for (int i = 0; i < 16; ++i) { base[(size_t)(n0 + i) * 8192] = s; s = dd[i] * s + u[i]; } }
    }
}
__device__ __forceinline__ void gla_pass_c(const bf16_t* proj, const float* Btab, const float* Gst, const float* gout, bf16_t* mixed) {
    const int tid = opaque_tid(), lane = tid & 63, r = lane & 31, hh = lane >> 5, gw = blockIdx.x * 8 + (tid >> 6), NGW = GRID * 8;
    for (int u = gw; u < 16 * 128 * 2; u += NGW) { const int item = u >> 1, tb = __builtin_amdgcn_readfirstlane(u & 1);
        const int bh = item >> 7, n = item & 127, b = bh >> 2, h = bh & 3; const size_t row0 = (size_t)b * SEQ + (size_t)n * 64;
        const int tl = 32 * tb + r;
        bf16x8 qe[4];
        { const bf16_t* qp = proj + (row0 + tl) * NIN + h * 64; const float* bp = Btab + (row0 + tl) * 256 + h * 64;
#pragma unroll
          for (int ks = 0; ks < 4; ++ks) { const u32x4 qw = *(const u32x4*)(qp + 16 * ks + 8 * hh); const f32x4 b0 = *(const f32x4*)(bp + 16 * ks + 8 * hh), b1 = *(const f32x4*)(bp + 16 * ks + 8 * hh + 4);
              u32x4 w; w.x = pk2(__uint_as_float(qw[0] << 16) * 0.125f * __expf(b0[0]), __uint_as_float(qw[0] & 0xffff0000u) * 0.125f * __expf(b0[1]));
                       w.y = pk2(__uint_as_float(qw[1] << 16) * 0.125f * __expf(b0[2]), __uint_as_float(qw[1] & 0xffff0000u) * 0.125f * __expf(b0[3]));
                       w.z = pk2(__uint_as_float(qw[2] << 16) * 0.125f * __expf(b1[0]), __uint_as_float(qw[2] & 0xffff0000u) * 0.125f * __expf(b1[1]));
                       w.w = pk2(__uint_as_float(qw[3] << 16) * 0.125f * __expf(b1[2]), __uint_as_float(qw[3] & 0xffff0000u) * 0.125f * __expf(b1[3]));
              qe[ks] = __builtin_bit_cast(bf16x8, w); } }
        f32x16 o[4] = {};
#pragma unroll
        for (int dvb = 0; dvb < 4; ++dvb) { const float* sp = Gst + ((size_t)item * 128 + 32 * dvb + r) * 64;
#pragma unroll
          for (int ks = 0; ks < 4; ++ks) { const f32x4 s0 = *(const f32x4*)(sp + 16 * ks + 8 * hh), s1 = *(const f32x4*)(sp + 16 * ks + 8 * hh + 4);
              u32x4 sw; sw.x = pk2(s0[0], s0[1]); sw.y = pk2(s0[2], s0[3]); sw.z = pk2(s1[0], s1[1]); sw.w = pk2(s1[2], s1[3]);
              o[dvb] = __builtin_amdgcn_mfma_f32_32x32x16_bf16(qe[ks], __builtin_bit_cast(bf16x8, sw), o[dvb], 0, 0, 0); } }
        for (int sb = 0; sb <= tb; ++sb) {
            f32x16 x = {};
            const int sl = 32 * sb + r; const bf16_t* kp = proj + (row0 + sl) * NIN + 256 + h * 64; const float* bp = Btab + (row0 + sl) * 256 + h * 64;
#pragma unroll
            for (int ks = 0; ks < 4; ++ks) { const u32x4 kw = *(const u32x4*)(kp + 16 * ks + 8 * hh); const f32x4 b0 = *(const f32x4*)(bp + 16 * ks + 8 * hh), b1 = *(const f32x4*)(bp + 16 * ks + 8 * hh + 4);
                u32x4 w; w.x = pk2(__uint_as_float(kw[0] << 16) * __expf(-b0[0]), __uint_as_float(kw[0] & 0xffff0000u) * __expf(-b0[1]));
                         w.y = pk2(__uint_as_float(kw[1] << 16) * __expf(-b0[2]), __uint_as_float(kw[1] & 0xffff0000u) * __expf(-b0[3]));
                         w.z = pk2(__uint_as_float(kw[2] << 16) * __expf(-b1[0]), __uint_as_float(kw[2] & 0xffff0000u) * __expf(-b1[1]));
                         w.w = pk2(__uint_as_float(kw[3] << 16) * __expf(-b1[2]), __uint_as_float(kw[3] & 0xffff0000u) * __expf(-b1[3]));
                x = __builtin_amdgcn_mfma_f32_32x32x16_bf16(__builtin_bit_cast(bf16x8, w), qe[ks], x, 0, 0, 0); }
            if (sb == tb) {
#pragma unroll
                for (int i = 0; i < 16; ++i) if (crow(i, hh) > r) x[i] = 0.f; }
#pragma unroll
            for (int s2 = 0; s2 < 2; ++s2) { u32x4 xw; xw.x = pk2(x[8 * s2], x[8 * s2 + 1]); xw.y = pk2(x[8 * s2 + 2], x[8 * s2 + 3]); xw.z = pk2(x[8 * s2 + 4], x[8 * s2 + 5]); xw.w = pk2(x[8 * s2 + 6], x[8 * s2 + 7]);
#pragma unroll
                for (int dvb = 0; dvb < 4; ++dvb) { bf16x8 vb;
#pragma unroll
                    for (int j = 0; j < 8; ++j) { const int sk = 32 * sb + 16 * s2 + 8 * (j >> 2) + 4 * hh + (j & 3); vb[j] = (short)proj[(row0 + sk) * NIN + 512 + h * 128 + 32 * dvb + r]; }
                    o[dvb] = __builtin_amdgcn_mfma_f32_32x32x16_bf16(__builtin_bit_cast(bf16x8, xw), vb, o[dvb], 0, 0, 0); } } }
        float gn[4];
#pragma unroll
        for (int dvb = 0; dvb < 4; ++dvb) gn[dvb] = gout[32 * dvb + r];
#pragma unroll
        for (int i = 0; i < 16; ++i) { const int t = 32 * tb + crow(i, hh);
            const float tot = half_sum32((o[0][i] * o[0][i] + o[1][i] * o[1][i]) + (o[2][i] * o[2][i] + o[3][i] * o[3][i]));
            const float rr = __builtin_amdgcn_rsqf(tot * (1.0f / 128.0f) + EPS);
#pragma unroll
            for (int dvb = 0; dvb < 4; ++dvb) { const float g = bf2f(proj[(row0 + t) * NIN + 1024 + h * 128 + 32 * dvb + r]);
                const float val = o[dvb][i] * rr * gn[dvb] * (g * __builtin_amdgcn_rcpf(1.0f + __expf(-g)));
                mixed[(row0 + t) * DM + h * 128 + 32 * dvb + r] = (bf16_t)f2bf(val); } }
    }
}
}
#define XB_TMO      128
#define XB_XCNT(j)  (256  + 64 * (j))
#define XB_XSUB(j)  (1280 + 64 * (j))
#define XB_XGEN(j)  (2304 + 64 * (j))
#define XB_TOP      3328
#define XB_TOPGEN   3392
#define XCD_BAR_WORDS 3456
#define XB_SPIN_CAP (1u << 18)

__device__ __forceinline__ unsigned xb_ld(unsigned* p)              { return __hip_atomic_load(p, __ATOMIC_RELAXED, __HIP_MEMORY_SCOPE_AGENT); }
__device__ __forceinline__ unsigned xb_add(unsigned* p, unsigned v) { return __hip_atomic_fetch_add(p, v, __ATOMIC_RELAXED, __HIP_MEMORY_SCOPE_AGENT); }
__device__ __forceinline__ unsigned xb_xcc_id() { return (unsigned)__builtin_amdgcn_s_getreg((3 << 11) | 20) & 0xFu; }
#define XB_SPIN(cond, bar) do { unsigned _sp = 0; while (cond) { __builtin_amdgcn_s_sleep(1); \
    if ((++_sp & 255u) == 0u) { if (xb_ld(&(bar)[XB_TMO])) break; if (_sp > XB_SPIN_CAP) { atomicAdd(&(bar)[XB_TMO], 1u); break; } } } } while (0)

struct XcdBarrier {
    unsigned* bar; unsigned x;
    volatile LAS unsigned* st;
};

__device__ __forceinline__ XcdBarrier xcd_barrier_post(unsigned* bar, volatile LAS unsigned* st) {
    XcdBarrier b; b.bar = bar; b.x = xb_xcc_id(); b.st = st;
    if (threadIdx.x == 0) (void)xb_add(&bar[XB_XCNT(b.x)], 1u);
    return b;
}
__device__ __forceinline__ void xcd_barrier_complete(unsigned* bar, unsigned x, unsigned& nloc, unsigned& nx) {
    const unsigned G = gridDim.x * gridDim.y * gridDim.z;
    unsigned sum, cnt, mine, sp = 0u;
    for (;;) {
        sum = 0u; cnt = 0u; mine = 0u;
#pragma unroll
        for (unsigned j = 0; j < 16; ++j) { const unsigned c = xb_ld(&bar[XB_XCNT(j)]); sum += c; cnt += (c > 0u) ? 1u : 0u; mine = (j == x) ? c : mine; }
        if (sum == G) break;
        __builtin_amdgcn_s_sleep(1);
        if ((++sp & 255u) == 0u) { if (xb_ld(&bar[XB_TMO])) break; if (sp > XB_SPIN_CAP) { atomicAdd(&bar[XB_TMO], 1u); break; } }
    }
    nloc = mine > 0u ? mine : 1u; nx = cnt > 0u ? cnt : 1u;
}

__device__ __forceinline__ void xcd_barrier(const XcdBarrier& b) {
    asm volatile("s_waitcnt vmcnt(0)" ::: "memory");
    __syncthreads();
    if (threadIdx.x == 0) {
        unsigned* bar = b.bar; unsigned bx = b.x; asm volatile("" : "+s"(bx));
        __builtin_amdgcn_s_waitcnt(0);
        unsigned nloc = b.st[0], nx = b.st[1];
        if (nloc == 0u) { xcd_barrier_complete(bar, bx, nloc, nx); b.st[0] = nloc; b.st[1] = nx; }
        const unsigned old = xb_add(&bar[XB_XSUB(bx)], 1u);
        const unsigned gen = old / nloc;
        if (old + 1u == (gen + 1u) * nloc) {
            __builtin_amdgcn_fence(__ATOMIC_RELEASE, "agent");
            asm volatile("s_waitcnt vmcnt(0)" ::: "memory");
            const unsigned og = xb_add(&bar[XB_TOP], 1u);
            const unsigned tg = og / nx;
            if (og + 1u == (tg + 1u) * nx) xb_add(&bar[XB_TOPGEN], 1u);
            else XB_SPIN(xb_ld(&bar[XB_TOPGEN]) == tg, bar);
            __builtin_amdgcn_fence(__ATOMIC_ACQUIRE, "agent");
            xb_add(&bar[XB_XGEN(bx)], 1u);
            asm volatile("s_waitcnt vmcnt(0)" ::: "memory");
        } else {
            XB_SPIN(xb_ld(&bar[XB_XGEN(bx)]) == gen, bar);
            __builtin_amdgcn_fence(__ATOMIC_ACQUIRE, "agent");
            asm volatile("s_waitcnt vmcnt(0)" ::: "memory");
        }
    }
    __syncthreads();
}
#ifndef PHM
#define PHM 0xffff
#endif
#ifndef REP
#define REP 0
#endif
#ifndef USE_XB
#define USE_XB 1
#endif
#if USE_XB
#define GSYNC() xcd_barrier(xbar)
#else
#define GSYNC() grid.sync()
#endif
#if REP
#define REPEAT(k) _Pragma("unroll 1") for (int rep_ = 0, nrep_ = opaque_int((((REP) >> (k)) & 1) + 1); rep_ < nrep_; ++rep_)
#else
#define REPEAT(k)
#endif
struct Args { const float* in[20]; float* out; unsigned char* ws; float inv_freq[32]; };
__global__ void __launch_bounds__(512, 2) mega_fwd(Args a) {
    using namespace mk;
    extern __shared__ __attribute__((aligned(16))) unsigned char lds[];
    cg::grid_group grid = cg::this_grid();
    const int tid = opaque_tid(), lane = tid & 63, wave = __builtin_amdgcn_readfirstlane(tid >> 6);
    constexpr int G = GRID;
    PG8_LAS unsigned char* ldsl = (PG8_LAS unsigned char*)lds;
    LAS float* ldsf = (LAS float*)lds;
    unsigned char* ws = a.ws;
    const float* x_in = a.in[0]; const float* c_in = a.in[1]; const int* pos = (const int*)a.in[2];
    const float* w_ada = a.in[3]; const float* b_ada = a.in[4];
    float* mod = (float*)(ws + WS_MOD); float* cosT = (float*)(ws + WS_COS); float* sinT = (float*)(ws + WS_SIN);
    bf16_t* HN = (bf16_t*)(ws + WS_HN); bf16_t* QN = (bf16_t*)(ws + WS_QN); bf16_t* KVN = (bf16_t*)(ws + WS_KVN);
    float* GST = (float*)(ws + WS_GST); float* GDV = (float*)(ws + WS_GDV); float* BT = (float*)(ws + WS_BT);
    bf16_t* PROJ = (bf16_t*)(ws + WS_R + R_PROJ); bf16_t* QB_ = (bf16_t*)(ws + WS_R + R_Q); bf16_t* KB_ = (bf16_t*)(ws + WS_R + R_K); bf16_t* VB_ = (bf16_t*)(ws + WS_R + R_V);
    bf16_t* HB = (bf16_t*)(ws + WS_R);
    float* xout = a.out;
    float* RSS = (float*)(ws + WS_RSS); float* BIAS = (float*)(ws + WS_BIAS); bf16_t* AN1 = (bf16_t*)(ws + WS_GST);
#if USE_XB
    volatile LAS unsigned* MISC = (volatile LAS unsigned*)(ldsl + MISC_OFF);
    if (tid < 16) MISC[tid] = 0u;
    __syncthreads();
    const XcdBarrier xbar = xcd_barrier_post((unsigned*)(ws + WS_BAR), MISC);
#endif

#if (PHM >> 0) & 1
    for (int u = blockIdx.x; u < 192; u += G) adaln_unit(u, c_in, w_ada, b_ada, mod, ldsf);
    __syncthreads();
    { const int gt = blockIdx.x * 512 + tid, GT = G * 512;
      for (int e = gt; e < T * 32; e += GT) { const int t = e >> 5, j = e & 31;
          const float ang = (float)pos[t] * a.inv_freq[j];
          const double turns = (double)ang * 0.15915494309189535; const float fr = (float)(turns - rint(turns)) * 6.283185307179586f;
          cosT[e] = cosf(fr); sinT[e] = sinf(fr); } }
    { float* rz = (float*)(ws + WS_RSS) + T; const int gt = blockIdx.x * 512 + tid, GT = G * 512; for (int e = gt; e < 3 * T; e += GT) rz[e] = 0.f; }
    { LAS float* scr = (LAS float*)(ldsl + wave * 16384);
      const int gw = blockIdx.x * 8 + wave, NGW = G * 8;
      constexpr int I_IN = 16 * 64, I_Q = 4 * 24, I_KV = 2 * 32, I_O = 16 * 32, I_1 = 16 * 128, I_2 = 64 * 32, I_L = I_IN + I_Q + I_KV + I_O + I_1 + I_2;
      for (int it = gw; it < DEPTH * I_L; it += NGW) { const int l = it / I_L; int r = it % I_L; unsigned char* wl = ws + WS_W + (size_t)l * W_LAYER;
          if (r < I_IN) { transpose_item(a.in[5] + (size_t)l * 1024 * 2000, 1024, 2000, 2048, (bf16_t*)(wl + W_IN), 1, scr, r, lane); continue; } r -= I_IN;
          if (r < I_Q) { transpose_item(a.in[10] + (size_t)l * 256 * 768, 256, 768, 768, (bf16_t*)(wl + W_Q), 2, scr, r, lane); continue; } r -= I_Q;
          if (r < I_KV) { transpose_item(a.in[12] + (size_t)l * 128 * 1024, 128, 1024, 1024, (bf16_t*)(wl + W_KV), 0, scr, r, lane); continue; } r -= I_KV;
          if (r < I_O) { transpose_item(a.in[17] + (size_t)l * 1024 * 1024, 1024, 1024, 1024, (bf16_t*)(wl + W_O), 0, scr, r, lane); continue; } r -= I_O;
          if (r < I_1) { transpose_item(a.in[18] + (size_t)l * 1024 * 4096, 1024, 4096, 4096, (bf16_t*)(wl + W_1), 0, scr, r, lane); continue; } r -= I_1;
          transpose_item(a.in[19] + (size_t)l * 4096 * 1024, 4096, 1024, 1024, (bf16_t*)(wl + W_2), 0, scr, r, lane); } }
#endif
    grid.sync();
    prenorm_rows(x_in, HN, RSS, mod, 1024);
    for (int l = 0; l < DEPTH; ++l) { unsigned char* wl = ws + WS_W + (size_t)l * W_LAYER; const float* modl = mod + (size_t)l * 4 * NMOD;
        bias_rows((const bf16_t*)(wl + W_IN), NIN, modl, 0, BIAS + (size_t)l * 4 * NIN);
        bias_rows((const bf16_t*)(wl + W_1), DFF, modl, 3072, BIAS + 2 * 4 * NIN + (size_t)l * 4 * DFF); }
    GSYNC();

#pragma unroll 1
    for (int l = 0; l < DEPTH; ++l) {
        const float* modl = mod + (size_t)l * 4 * NMOD;
        unsigned char* wl = ws + WS_W + (size_t)l * W_LAYER;
        const float* xin = l == 0 ? x_in : xout;
#if (PHM >> 2) & 1
        REPEAT(2) { pg8::Gemm g{HN, (const bf16_t*)(wl + W_IN), T, NIN, DM}; pg8::StaticOrder S; S.init(T, NIN, G, (int)blockIdx.x);
          pg8::EpiBf16<0> E{PROJ, NIN, BIAS + (size_t)l * 4 * NIN, 0, 0, 1.f, RSS + (size_t)(2 * l) * T, NIN};
          pg8::gemm_phase<pg8::EpiBf16<0>, pg8::StaticOrder, true, true>(ldsl, g, S, E); }
#endif
        GSYNC();
#if (PHM >> 3) & 1
        REPEAT(3) prep_tokens(PROJ, QN, KVN, KB_, a.in[9] + l * 256, a.in[11] + l * 128, a.in[16] + l * 64, cosT, sinT);
#endif
#if (PHM >> 4) & 1
        REPEAT(4) gla_pass_a(ldsf, PROJ, a.in[6] + (size_t)l * 16 * 256, a.in[7] + l * 256, BT, GST, GDV);
#endif
        GSYNC();
#if (PHM >> 5) & 1
        REPEAT(5) { int kq = 256; asm volatile("" : "+s"(kq));
          pg8::Gemm g{QN, (const bf16_t*)(wl + W_Q), T, 512, kq}; pg8::StaticOrder S; S.init(T, 512, G, (int)blockIdx.x);
          pg8::EpiQN E{QB_, a.in[13] + l * 128, (PG8_LAS float*)(ldsl + EPI_OFF)};
          pg8::gemm_phase<pg8::EpiQN, pg8::StaticOrder, true, true>(ldsl, g, S, E); }
#endif
#if (PHM >> 13) & 1
        REPEAT(5) { int kq = 256; asm volatile("" : "+s"(kq));
          pg8::Gemm g{QN, (const bf16_t*)(wl + W_Q) + 512 * 256, T, 256, kq}; pg8::StaticOrder S; S.init(T, 256, G, (int)blockIdx.x);
          pg8::EpiQR E{QB_, a.in[15] + l * 64, cosT, sinT};
          pg8::gemm_phase<pg8::EpiQR, pg8::StaticOrder, true, true>(ldsl, g, S, E); }
#endif
#if (PHM >> 6) & 1
        REPEAT(5) { int kk = 128; asm volatile("" : "+s"(kk));
          pg8::Gemm g{KVN, (const bf16_t*)(wl + W_KV), T, 1024, kk}; pg8::StaticOrder S; S.init(T, 1024, G, (int)blockIdx.x);
          pg8::EpiKV E{KB_, VB_, a.in[14] + l * 128, (PG8_LAS float*)(ldsl + EPI_OFF)};
          pg8::gemm_phase<pg8::EpiKV, pg8::StaticOrder, true, true>(ldsl, g, S, E); }
#endif
#if (PHM >> 7) & 1
        gla_scan(GST, GDV);
#endif
        GSYNC();
#if (PHM >> 8) & 1
        REPEAT(8) att::attn_phase((char*)lds, (const att::bf16*)QB_, (const att::bf16*)KB_, (const att::bf16*)VB_, (att::bf16*)HN);
#endif
        __syncthreads();
#if (PHM >> 9) & 1
        REPEAT(9) gla_pass_c(PROJ, BT, GST, a.in[8] + l * 128, HN);
#endif
        GSYNC();
#if (PHM >> 10) & 1
        { pg8::Gemm g{HN, (const bf16_t*)(wl + W_O), T, DM, DM}; pg8::StaticOrder S; S.init(T, DM, G, (int)blockIdx.x);
          pg8::EpiResGate E{xin, xout, modl + 2048, AN1, modl + 4096, RSS + (size_t)(2 * l + 1) * T};
          pg8::gemm_phase<pg8::EpiResGate, pg8::StaticOrder, true, true>(ldsl, g, S, E); }
#endif
        GSYNC();
#if (PHM >> 11) & 1
        REPEAT(11) { pg8::Gemm g{AN1, (const bf16_t*)(wl + W_1), T, DFF, DM}; pg8::StaticOrder S; S.init(T, DFF, G, (int)blockIdx.x);
          pg8::EpiBf16<2> E{HB, DFF, BIAS + 2 * 4 * NIN + (size_t)l * 4 * DFF, 0, 0, 1.f, RSS + (size_t)(2 * l + 1) * T, DFF};
          pg8::gemm_phase<pg8::EpiBf16<2>, pg8::StaticOrder, true, true>(ldsl, g, S, E); }
#endif
        GSYNC();
#if (PHM >> 12) & 1
        { pg8::Gemm g{HB, (const bf16_t*)(wl + W_2), T, DM, DFF}; pg8::StaticOrder S; S.init(T, DM, G, (int)blockIdx.x);
          const bool more = l + 1 < DEPTH;
          pg8::EpiResGate E{xout, xout, modl + 5120, more ? HN : nullptr, mod + (size_t)(l + 1) * 4 * NMOD + 1024, RSS + (size_t)(2 * l + 2) * T};
          pg8::gemm_phase<pg8::EpiResGate, pg8::StaticOrder, true, true>(ldsl, g, S, E); }
#endif
        if (l + 1 < DEPTH) GSYNC();
    }
}

extern "C" void kernel_launch(void* const* d_in, const int* in_sizes, int n_in, void* d_out, int out_size, void* d_ws, size_t ws_size, hipStream_t stream) {
    static int grid = 0;
    if (grid == 0) {
        if (n_in != 20 || out_size != mk::T * mk::DM || ws_size < mk::WS_END) { fprintf(stderr, "kernel_launch: unexpected shapes (n_in %d out %d ws %zu)\n", n_in, out_size, ws_size); grid = -1; return; }
        int dev = 0, cus = 0, per = 0;
        (void)hipGetDevice(&dev); (void)hipDeviceGetAttribute(&cus, hipDeviceAttributeMultiprocessorCount, dev);
        (void)hipFuncSetAttribute((const void*)mega_fwd, hipFuncAttributeMaxDynamicSharedMemorySize, mk::LDS_BYTES);
        if (hipOccupancyMaxActiveBlocksPerMultiprocessor(&per, (const void*)mega_fwd, 512, mk::LDS_BYTES) != hipSuccess || per < 1) per = 1;
        (void)hipGetLastError();
        if (cus * per < GRID) fprintf(stderr, "kernel_launch: device holds %d co-resident workgroups, kernel built for %d\n", cus * per, GRID);
        grid = GRID;
    }
    if (grid < 0) return;
    (void)hipMemsetAsync((unsigned char*)d_ws + mk::WS_BAR, 0, XCD_BAR_WORDS * sizeof(unsigned), stream);
    Args a{};
    for (int i = 0; i < 20; ++i) a.in[i] = (const float*)d_in[i];
    a.out = (float*)d_out; a.ws = (unsigned char*)d_ws;
    for (int j = 0; j < 32; ++j) a.inv_freq[j] = powf(10000.0f, -(float)(2 * j) / 64.0f);
    void* args[] = {&a};
    hipError_t e = hipLaunchCooperativeKernel((const void*)mega_fwd, dim3(grid), dim3(512), args, mk::LDS_BYTES, stream);
    if (e != hipSuccess) fprintf(stderr, "kernel_launch: cooperative launch failed: %s (grid %d)\n", hipGetErrorString(e), grid);
}
```

```cpp
#include <hip/hip_runtime.h>
#include <hip/hip_bf16.h>
#include <hip/hip_cooperative_groups.h>
#include <cstdio>
#include <cstdint>
#include <cmath>
namespace cg = cooperative_groups;
#define LAS __attribute__((address_space(3)))
__device__ __forceinline__ int opaque_tid() { int t = threadIdx.x; asm volatile("" : "+v"(t)); return t; }
__device__ __forceinline__ int opaque_int(int v) { asm volatile("" : "+s"(v)); return v; }
constexpr int GRID = 256;
namespace pg8 {
#define PG8_LAS __attribute__((address_space(3)))
typedef unsigned short bf16_t;
typedef short bf16x8 __attribute__((ext_vector_type(8)));
typedef float f32x4 __attribute__((ext_vector_type(4)));
typedef unsigned u32x4 __attribute__((ext_vector_type(4)));
constexpr int BM = 256, BK = 64, HALF = 128, HTB = HALF * BK * 2  , STAGE_BYTES = 8 * HTB, NXCD = 8, WGM = 8;

__host__ __device__ __forceinline__ int lds_byte(int r, int c) { const int st = (r >> 4) * 2 + (c >> 5), rr = r & 15, cc = c & 31, ob = rr * 64 + cc * 2; return st * 1024 + (ob ^ (((ob >> 9) & 1) << 5)); }
__host__ __device__ __forceinline__ void stage_rc(int b, int& R, int& C) { const int st = b / 1024, sb = b % 1024, swz = sb ^ (((sb >> 9) & 1) << 5); R = (st >> 1) * 16 + swz / 64; C = (st & 1) * 32 + (swz % 64) / 2; }
__host__ __device__ __forceinline__ int perm32(int rho) { const int n = rho >> 4, i = rho & 15; return 8 * (i >> 2) + 4 * n + (i & 3); }

struct Unit { int pm, pn; };
struct Gemm { const bf16_t* A; const bf16_t* Bt; int M, N, K; };

struct StaticOrder {
    int nM, nN, nwg, G, c;
    __host__ __device__ void init(int M, int N, int G_, int c_) { nM = M / BM; nN = N / BM; nwg = nM * nN; G = G_; c = c_; }
    __host__ __device__ bool next(int i, Unit& u) const {
        const long L = (long)i * G + c; if (L >= nwg) return false;
        int wgid = (int)L; { const int q = nwg / NXCD, r = nwg % NXCD, xcd = wgid % NXCD, off = wgid / NXCD; wgid = (xcd < r ? xcd * (q + 1) : r * (q + 1) + (xcd - r) * q) + off; }
        const int nig = WGM * nN, gid = wgid / nig, fm = gid * WGM, gsz = (nM - fm) < WGM ? (nM - fm) : WGM;
        u.pm = fm + ((wgid % nig) % gsz); u.pn = (wgid % nig) / gsz; return true;
    }
    __device__ __forceinline__ void a_ready(const Unit&) const {}
    __device__ __forceinline__ void done(const Unit&) const {}
};

__device__ __forceinline__ unsigned cvt_pk_bf16(float lo, float hi) { unsigned r; asm volatile("v_cvt_pk_bf16_f32 %0, %1, %2" : "=v"(r) : "v"(lo), "v"(hi)); return r; }
typedef float f32x2 __attribute__((ext_vector_type(2)));
__device__ __forceinline__ f32x2 gelu_pk(f32x2 v) {
    const f32x2 av = __builtin_elementwise_abs(v), d = av * 0.2316418882f + 1.0f;
    f32x2 t; t.x = __builtin_amdgcn_rcpf(d.x); t.y = __builtin_amdgcn_rcpf(d.y);
    f32x2 q = t * 0.5307027145f + (-0.7265760135f); q = q * t + 0.7107068705f; q = q * t + (-0.142248368f); q = q * t + 0.127414796f; q = q * t;
    const f32x2 s = (v * v) * (-0.72134752044f);
    f32x2 e; e.x = __builtin_amdgcn_exp2f(s.x); e.y = __builtin_amdgcn_exp2f(s.y);
    const f32x2 m = v * (q * e), r = v - m;
    f32x2 o; o.x = v.x < 0.f ? m.x : r.x; o.y = v.y < 0.f ? m.y : r.y; return o;
}

template <int ACT  > struct EpiBf16 {
    static constexpr bool PERM = true, AFTER_DRAIN = false; static_assert(ACT == 0 || ACT == 1 || ACT == 2, "EpiBf16: ACT is 0 (none), 1 (gelu_pk) or 2 (relu squared)");
    bf16_t* O; int ldc; const float* bias; int split_cols; size_t split_stride; float scale0; const float* rowss = nullptr; int bstride = 0;
    __device__ __forceinline__ void operator()(const f32x4 (&acc)[2][2][4][2], const Unit& u, int wr, int wc, int fr, int fq) const {
        const int row0 = u.pm * BM + wr * 64 + fr; int colt = u.pn * BM; bf16_t* base = O;
        float sc = 1.f; if (split_cols) { const int t = colt / split_cols; base += (size_t)t * split_stride; colt -= t * split_cols; if (t == 0) sc = scale0; }
        const int col0 = colt + wc * 32 + 8 * fq, bcol0 = u.pn * BM + wc * 32 + 8 * fq;
        const float* bias = this->bias ? this->bias + (size_t)(u.pm >> 5) * bstride : nullptr;
        f32x4 bv[2][2];
#pragma unroll
        for (int bj = 0; bj < 2; ++bj)
#pragma unroll
            for (int n = 0; n < 2; ++n) bv[bj][n] = bias ? *(const f32x4*)(bias + bcol0 + bj * HALF + 4 * n) : (f32x4){0.f, 0.f, 0.f, 0.f};
#pragma unroll
        for (int ai = 0; ai < 2; ++ai)
#pragma unroll
            for (int m = 0; m < 4; ++m) { bf16_t* rowp = base + (size_t)(row0 + ai * HALF + m * 16) * ldc + col0;
                const float rs = rowss ? __builtin_amdgcn_rsqf(rowss[row0 + ai * HALF + m * 16] * (1.0f / 1024.0f) + 1e-6f) : 1.0f;
#pragma unroll
                for (int bj = 0; bj < 2; ++bj) { f32x4 v0 = acc[ai][bj][m][0] * rs + bv[bj][0], v1 = acc[ai][bj][m][1] * rs + bv[bj][1];
                    if (ACT == 1) { f32x2 a = gelu_pk((f32x2){v0[0], v0[1]}), b = gelu_pk((f32x2){v0[2], v0[3]}), c = gelu_pk((f32x2){v1[0], v1[1]}), d = gelu_pk((f32x2){v1[2], v1[3]});
                        v0 = (f32x4){a.x, a.y, b.x, b.y}; v1 = (f32x4){c.x, c.y, d.x, d.y}; }
                    if (ACT == 2) { v0 = __builtin_elementwise_max(v0, (f32x4){0.f, 0.f, 0.f, 0.f}); v1 = __builtin_elementwise_max(v1, (f32x4){0.f, 0.f, 0.f, 0.f}); v0 = v0 * v0; v1 = v1 * v1; }
                    v0 = v0 * sc; v1 = v1 * sc; u32x4 w; w.x = cvt_pk_bf16(v0[0], v0[1]); w.y = cvt_pk_bf16(v0[2], v0[3]); w.z = cvt_pk_bf16(v1[0], v1[1]); w.w = cvt_pk_bf16(v1[2], v1[3]);
                    *(u32x4*)(rowp + bj * HALF) = w; } }
    }
};
template <class Epi, class Sched, bool ALIGN_EPI = false, bool SP2 = false>
__device__ __forceinline__ void gemm_phase(PG8_LAS unsigned char* lds, const Gemm g, const Sched& S, const Epi& E) {
    const int tid = opaque_tid(), wid = __builtin_amdgcn_readfirstlane(tid >> 6), lane = tid & 63, wr = wid >> 2, wc = wid & 3, fr = lane & 15, fq = lane >> 4;
    const int K = g.K, nt = K / BK;
    unsigned voffA[2], voffB[2];
#pragma unroll
    for (int i = 0; i < 2; ++i) { int R, C; stage_rc(tid * 16 + i * 8192, R, C); const int Rb = Epi::PERM ? ((R & ~31) + perm32(R & 31)) : R;
        voffA[i] = (unsigned)(R * K + C) * 2u; voffB[i] = (unsigned)(Rb * K + C) * 2u; }
    const size_t kstep = (size_t)(BK * 2);
    const size_t hstep = (size_t)HALF * K * 2;
    const size_t tstep = 2 * hstep;
    const unsigned ldsw = (unsigned)wid * 1024u;
    const int aoff = lds_byte(wr * 64 + fr, fq * 8), boff = lds_byte(wc * 32 + fr, fq * 8);
#define PG8_SA(b, h) (((b) * 2 + (h)) * HTB)
#define PG8_SB(b, h) ((4 + (b) * 2 + (h)) * HTB)
#define PG8_STAGE(bufoff, gbase, voff) do { _Pragma("unroll") for (int _i = 0; _i < 2; ++_i) \
        __builtin_amdgcn_global_load_lds((const unsigned*)((const char*)(gbase) + (voff)[_i]), (PG8_LAS unsigned*)(lds + (bufoff) + ldsw + _i * 8192), 16, 0, 0); } while (0)
#define PG8_LDA(dst, b, h) do { _Pragma("unroll") for (int m = 0; m < 4; ++m) _Pragma("unroll") for (int k = 0; k < 2; ++k) dst[m][k] = *(const PG8_LAS bf16x8*)(lds + PG8_SA(b, h) + aoff + m * 2048 + k * 1024); } while (0)
#define PG8_LDB(dst, b, h) do { _Pragma("unroll") for (int n = 0; n < 2; ++n) _Pragma("unroll") for (int k = 0; k < 2; ++k) dst[n][k] = *(const PG8_LAS bf16x8*)(lds + PG8_SB(b, h) + boff + n * 2048 + k * 1024); } while (0)
#define PG8_MMA(ai, bj, At, Bt) do { __builtin_amdgcn_s_setprio(1); _Pragma("unroll") for (int m = 0; m < 4; ++m) _Pragma("unroll") for (int n = 0; n < 2; ++n) _Pragma("unroll") for (int k = 0; k < 2; ++k) \
        acc[ai][bj][m][n] = __builtin_amdgcn_mfma_f32_16x16x32_bf16(Bt[n][k], At[m][k], acc[ai][bj][m][n], 0, 0, 0); __builtin_amdgcn_s_setprio(0); } while (0)
#define PG8_WAIT_V(n) asm volatile("s_waitcnt vmcnt(" #n ")" ::: "memory")
#define PG8_WAIT_L(n) asm volatile("s_waitcnt lgkmcnt(" #n ")" ::: "memory")
#define PG8_BAR __builtin_amdgcn_s_barrier()
#define PG8_SCHED __builtin_amdgcn_sched_barrier(0)
    Unit cur, nxt; int ui = 0;
    if (!S.next(0, cur)) return;
    f32x4 acc[2][2][4][2];
#pragma unroll
    for (int a = 0; a < 2; ++a)
#pragma unroll
        for (int b = 0; b < 2; ++b)
#pragma unroll
            for (int m = 0; m < 4; ++m)
#pragma unroll
                for (int n = 0; n < 2; ++n) acc[a][b][m][n] = (f32x4){0.f, 0.f, 0.f, 0.f};
    bf16x8 At[4][2], B0[2][2], B1[2][2];
    const char* cA = (const char*)g.A + (size_t)cur.pm * tstep; const char* cB = (const char*)g.Bt + (size_t)cur.pn * tstep;
    S.a_ready(cur);
    if constexpr (SP2) {
        PG8_STAGE(PG8_SB(0, 0), cB, voffB); PG8_STAGE(PG8_SB(0, 1), cB + hstep, voffB); PG8_STAGE(PG8_SA(0, 0), cA, voffA); PG8_STAGE(PG8_SA(0, 1), cA + hstep, voffA);
        if (wr == 1) PG8_BAR;
        PG8_WAIT_V(2); PG8_BAR;
        PG8_STAGE(PG8_SB(1, 0), cB + kstep, voffB); PG8_STAGE(PG8_SA(1, 0), cA + kstep, voffA); PG8_STAGE(PG8_SB(1, 1), cB + hstep + kstep, voffB);
        PG8_WAIT_V(6); PG8_BAR;
    } else {
        PG8_STAGE(PG8_SB(0, 0), cB, voffB); PG8_STAGE(PG8_SA(0, 0), cA, voffA); PG8_STAGE(PG8_SB(0, 1), cB + hstep, voffB); PG8_STAGE(PG8_SA(0, 1), cA + hstep, voffA);
        if (wr == 1) PG8_BAR;
        PG8_WAIT_V(4); PG8_BAR;
        PG8_STAGE(PG8_SB(1, 0), cB + kstep, voffB); PG8_STAGE(PG8_SA(1, 0), cA + kstep, voffA); PG8_STAGE(PG8_SB(1, 1), cB + hstep + kstep, voffB);
        PG8_WAIT_V(6); PG8_BAR;
    }
    for (;;) {
        const bool has_next = S.next(ui + 1, nxt);
        const char* nA = has_next ? (const char*)g.A + (size_t)nxt.pm * tstep : cA; const char* nB = has_next ? (const char*)g.Bt + (size_t)nxt.pn * tstep : cB;
        for (int t = 0; t < nt; t += 2) {
            const bool last = (t == nt - 2);
            const char* a1 = cA + (size_t)(t + 1) * kstep;
            const char* a2 = last ? nA : cA + (size_t)(t + 2) * kstep; const char* b2 = last ? nB : cB + (size_t)(t + 2) * kstep;
            const char* a3 = a2 + kstep; const char* b3 = b2 + kstep;
            if (last && has_next) S.a_ready(nxt);
            if constexpr (SP2) {
            PG8_LDB(B0, 0, 0); PG8_LDB(B1, 0, 1); PG8_SCHED; PG8_LDA(At, 0, 0); PG8_STAGE(PG8_SA(1, 1), a1 + hstep, voffA);
            PG8_WAIT_V(8); PG8_WAIT_L(0); PG8_BAR; PG8_MMA(0, 0, At, B0); PG8_MMA(0, 1, At, B1); PG8_BAR; PG8_SCHED;
            PG8_LDA(At, 0, 1); PG8_STAGE(PG8_SB(0, 0), b2, voffB); PG8_STAGE(PG8_SB(0, 1), b2 + hstep, voffB); PG8_STAGE(PG8_SA(0, 0), a2, voffA);
            PG8_WAIT_V(8); PG8_WAIT_L(0); PG8_BAR; PG8_MMA(1, 0, At, B0); PG8_MMA(1, 1, At, B1); PG8_BAR; PG8_SCHED;
            PG8_LDB(B0, 1, 0); PG8_LDB(B1, 1, 1); PG8_SCHED; PG8_LDA(At, 1, 0); PG8_STAGE(PG8_SA(0, 1), a2 + hstep, voffA);
            PG8_WAIT_V(8); PG8_WAIT_L(0); PG8_BAR; PG8_MMA(0, 0, At, B0); PG8_MMA(0, 1, At, B1); PG8_BAR; PG8_SCHED;
            PG8_LDA(At, 1, 1); PG8_STAGE(PG8_SB(1, 0), b3, voffB); PG8_STAGE(PG8_SB(1, 1), b3 + hstep, voffB); PG8_STAGE(PG8_SA(1, 0), a3, voffA);
            PG8_WAIT_V(8); PG8_WAIT_L(0); PG8_BAR; PG8_MMA(1, 0, At, B0); PG8_MMA(1, 1, At, B1); PG8_BAR; PG8_SCHED;
            } else {
            PG8_LDB(B0, 0, 0); PG8_SCHED; PG8_LDA(At, 0, 0); PG8_STAGE(PG8_SA(1, 1), a1 + hstep, voffA);
            PG8_WAIT_L(8); PG8_BAR; PG8_WAIT_L(0); PG8_MMA(0, 0, At, B0); PG8_BAR; PG8_SCHED;
            PG8_LDB(B1, 0, 1); PG8_STAGE(PG8_SB(0, 0), b2, voffB);
            PG8_BAR; PG8_WAIT_L(0); PG8_MMA(0, 1, At, B1); PG8_BAR;
            PG8_LDA(At, 0, 1); PG8_STAGE(PG8_SA(0, 0), a2, voffA);
            PG8_BAR; PG8_WAIT_L(0); PG8_MMA(1, 0, At, B0); PG8_BAR; PG8_SCHED;
            PG8_STAGE(PG8_SB(0, 1), b2 + hstep, voffB);
            PG8_WAIT_V(6); PG8_BAR; PG8_MMA(1, 1, At, B1); PG8_BAR;
            PG8_LDB(B0, 1, 0); PG8_SCHED; PG8_LDA(At, 1, 0); PG8_STAGE(PG8_SA(0, 1), a2 + hstep, voffA);
            PG8_WAIT_L(8); PG8_BAR; PG8_WAIT_L(0); PG8_MMA(0, 0, At, B0); PG8_BAR; PG8_SCHED;
            PG8_LDB(B1, 1, 1); PG8_STAGE(PG8_SB(1, 0), b3, voffB);
            PG8_BAR; PG8_WAIT_L(0); PG8_MMA(0, 1, At, B1); PG8_BAR;
            PG8_LDA(At, 1, 1); PG8_STAGE(PG8_SA(1, 0), a3, voffA);
            PG8_BAR; PG8_WAIT_L(0); PG8_MMA(1, 0, At, B0); PG8_BAR; PG8_SCHED;
            PG8_STAGE(PG8_SB(1, 1), b3 + hstep, voffB);
            PG8_WAIT_V(6); PG8_BAR; PG8_MMA(1, 1, At, B1); PG8_BAR;
            }
        }
        if constexpr (ALIGN_EPI) { if (wr == 0) PG8_BAR; }
        if constexpr (!Epi::AFTER_DRAIN) { E(acc, cur, wr, wc, fr, fq); S.done(cur); }
        if (!has_next) break;
#pragma unroll
        for (int a = 0; a < 2; ++a)
#pragma unroll
            for (int b = 0; b < 2; ++b)
#pragma unroll
                for (int m = 0; m < 4; ++m)
#pragma unroll
                    for (int n = 0; n < 2; ++n) acc[a][b][m][n] = (f32x4){0.f, 0.f, 0.f, 0.f};
        cur = nxt; cA = nA; cB = nB; ++ui;
        if constexpr (ALIGN_EPI) { if (wr == 1) PG8_BAR; }
    }
    PG8_WAIT_V(0);
    if constexpr (!ALIGN_EPI) { if (wr == 0) PG8_BAR; }
    PG8_BAR;
    if constexpr (Epi::AFTER_DRAIN) { E.fused(acc, cur, wr, wc, fr, fq, lds, wid, lane); S.done(cur); }
#undef PG8_SA
#undef PG8_SB
#undef PG8_STAGE
#undef PG8_LDA
#undef PG8_LDB
#undef PG8_MMA
#undef PG8_WAIT_V
#undef PG8_WAIT_L
#undef PG8_BAR
#undef PG8_SCHED
}
typedef unsigned u32x2 __attribute__((ext_vector_type(2)));
constexpr float RMS_EPS_F = 1e-6f;
struct EpiResGate {
    static constexpr bool PERM = true, AFTER_DRAIN = false;
    const float* xin; float* xout; const float* gate;
    bf16_t* anext; const float* scale_next; float* rss_next;
    __device__ __forceinline__ void operator()(const f32x4 (&acc)[2][2][4][2], const Unit& u, int wr_, int wc_, int fr_, int fq_) const {
        int tx = threadIdx.x; asm volatile("" : "+v"(tx));
        const int fr = tx & 15, fq = (tx >> 4) & 3, wc = (tx >> 6) & 3, wr = tx >> 8;
        const int b = u.pm >> 5;
        const int col0 = u.pn * BM + wc * 32 + 8 * fq;
        const float* gp = gate + (size_t)b * 6144 + col0;
        f32x4 gv[2][2], sv[2][2];
#pragma unroll
        for (int bj = 0; bj < 2; ++bj)
#pragma unroll
            for (int n = 0; n < 2; ++n) { gv[bj][n] = *(const f32x4*)(gp + bj * HALF + n * 4);
                sv[bj][n] = anext ? *(const f32x4*)(scale_next + (size_t)b * 6144 + col0 + bj * HALF + n * 4) + 1.0f : (f32x4){0.f, 0.f, 0.f, 0.f}; }
#pragma unroll
        for (int ai = 0; ai < 2; ++ai)
#pragma unroll
            for (int m = 0; m < 4; ++m) { int row = u.pm * BM + ai * HALF + wr * 64 + m * 16 + fr; asm volatile("" : "+v"(row));
                const size_t off = (size_t)row * 1024 + col0; float ss = 0.f;
#pragma unroll
                for (int bj = 0; bj < 2; ++bj) { u32x4 w;
#pragma unroll
                    for (int n = 0; n < 2; ++n) { const f32x4 xi = *(const f32x4*)(xin + off + bj * HALF + n * 4);
                        const f32x4 xn = xi + gv[bj][n] * acc[ai][bj][m][n];
                        *(f32x4*)(xout + off + bj * HALF + n * 4) = xn;
                        if (anext) { ss += (xn[0] * xn[0] + xn[1] * xn[1]) + (xn[2] * xn[2] + xn[3] * xn[3]);
                            const f32x4 an = xn * sv[bj][n]; w[2 * n] = cvt_pk_bf16(an[0], an[1]); w[2 * n + 1] = cvt_pk_bf16(an[2], an[3]); } }
                    if (anext) *(u32x4*)(anext + off + bj * HALF) = w; }
                if (anext) { ss += __shfl_xor(ss, 16); ss += __shfl_xor(ss, 32); if (fq == 0) atomicAdd(rss_next + row, ss); }
                asm volatile("" ::: "memory"); }
    }
};
struct EpiQN {
    static constexpr bool PERM = true, AFTER_DRAIN = false;
    bf16_t* Q; const float* gn_nope; PG8_LAS float* P;
    __device__ __forceinline__ void operator()(const f32x4 (&acc)[2][2][4][2], const Unit& u, int wr_, int wc_, int fr_, int fq_) const {
        int tx = threadIdx.x; asm volatile("" : "+v"(tx));
        const int fr = tx & 15, fq = (tx >> 4) & 3, wc = (tx >> 6) & 3, wr = tx >> 8;
        const int b = u.pm >> 5, s0 = (u.pm & 31) * BM;
#pragma unroll
            for (int ai = 0; ai < 2; ++ai)
#pragma unroll
                for (int m = 0; m < 4; ++m)
#pragma unroll
                    for (int bj = 0; bj < 2; ++bj) { float s = 0.f;
#pragma unroll
                        for (int n = 0; n < 2; ++n) { const f32x4 x = acc[ai][bj][m][n]; s += (x[0] * x[0] + x[1] * x[1]) + (x[2] * x[2] + x[3] * x[3]); }
                        s += __shfl_xor(s, 16); s += __shfl_xor(s, 32);
                        if (fq == 0) P[((ai * HALF + wr * 64 + m * 16 + fr) * 2 + bj) * 4 + wc] = s; }
            asm volatile("s_waitcnt lgkmcnt(0)" ::: "memory"); __builtin_amdgcn_s_barrier(); asm volatile("" ::: "memory");
#pragma unroll
            for (int ai = 0; ai < 2; ++ai)
#pragma unroll
                for (int m = 0; m < 4; ++m) { int rl = ai * HALF + wr * 64 + m * 16 + fr; asm volatile("" : "+v"(rl));
#pragma unroll
                    for (int bj = 0; bj < 2; ++bj) { const f32x4 pp = *(const PG8_LAS f32x4*)(P + (rl * 2 + bj) * 4);
                        const float rr = 1.0f / sqrtf(((pp[0] + pp[1]) + (pp[2] + pp[3])) * (1.0f / 128.0f) + RMS_EPS_F);
                        const int head = 2 * u.pn + bj;
                        const unsigned qoff = (unsigned)(((b * 4 + head) * 8192 + s0 + rl) * 192 + wc * 32 + 8 * fq); u32x4 w;
#pragma unroll
                        for (int n = 0; n < 2; ++n) { const f32x4 g = *(const f32x4*)(gn_nope + wc * 32 + 8 * fq + 4 * n);
                            const f32x4 v = acc[ai][bj][m][n] * rr * g; w[2 * n] = cvt_pk_bf16(v[0], v[1]); w[2 * n + 1] = cvt_pk_bf16(v[2], v[3]); }
                        *(u32x4*)(Q + qoff) = w; }
                    asm volatile("" ::: "memory"); }
    }
};
struct EpiQR {
    static constexpr bool PERM = true, AFTER_DRAIN = false;
    bf16_t* Q; const float* gn_rope; const float* cosT; const float* sinT;
    __device__ __forceinline__ void operator()(const f32x4 (&acc)[2][2][4][2], const Unit& u, int wr_, int wc_, int fr_, int fq_) const {
        int tx = threadIdx.x; asm volatile("" : "+v"(tx));
        const int fr = tx & 15, fq = (tx >> 4) & 3, wc = (tx >> 6) & 3, wr = tx >> 8;
        const int b = u.pm >> 5, s0 = (u.pm & 31) * BM;
#pragma unroll
            for (int ai = 0; ai < 2; ++ai)
#pragma unroll
                for (int m = 0; m < 4; ++m) { int rl = ai * HALF + wr * 64 + m * 16 + fr; asm volatile("" : "+v"(rl)); float s = 0.f;
#pragma unroll
                    for (int bj = 0; bj < 2; ++bj)
#pragma unroll
                        for (int n = 0; n < 2; ++n) { const f32x4 x = acc[ai][bj][m][n]; s += (x[0] * x[0] + x[1] * x[1]) + (x[2] * x[2] + x[3] * x[3]); }
                    s += __shfl_xor(s, 16); s += __shfl_xor(s, 32);
                    const float rr = 1.0f / sqrtf(s * (1.0f / 64.0f) + RMS_EPS_F);
                    const size_t t = (size_t)u.pm * BM + rl;
                    bf16_t* qrow = Q + ((size_t)(b * 4 + wc) * 8192 + s0 + rl) * 192 + 128;
                    u32x4 wa, wb;
#pragma unroll
                    for (int n = 0; n < 2; ++n) { const int j0 = 8 * fq + 4 * n;
                        const f32x4 c4 = *(const f32x4*)(cosT + t * 32 + j0), s4 = *(const f32x4*)(sinT + t * 32 + j0);
                        const f32x4 g1 = *(const f32x4*)(gn_rope + j0), g2 = *(const f32x4*)(gn_rope + 32 + j0);
                        const f32x4 y1 = acc[ai][0][m][n] * rr * g1, y2 = acc[ai][1][m][n] * rr * g2;
                        const f32x4 o1 = y1 * c4 - y2 * s4, o2 = y2 * c4 + y1 * s4;
                        wa[2 * n] = cvt_pk_bf16(o1[0], o1[1]); wa[2 * n + 1] = cvt_pk_bf16(o1[2], o1[3]); wb[2 * n] = cvt_pk_bf16(o2[0], o2[1]); wb[2 * n + 1] = cvt_pk_bf16(o2[2], o2[3]); }
                    *(u32x4*)(qrow + 8 * fq) = wa; *(u32x4*)(qrow + 32 + 8 * fq) = wb;
                    asm volatile("" ::: "memory"); }
    }
};
struct EpiKV {
    static constexpr bool PERM = true, AFTER_DRAIN = false;
    bf16_t* Kb; bf16_t* Vb; const float* gn_k; PG8_LAS float* P;
    __device__ __forceinline__ void operator()(const f32x4 (&acc)[2][2][4][2], const Unit& u, int wr_, int wc_, int fr_, int fq_) const {
        int tx = threadIdx.x; asm volatile("" : "+v"(tx));
        const int fr = tx & 15, fq = (tx >> 4) & 3, wc = (tx >> 6) & 3, wr = tx >> 8;
        const int b = u.pm >> 5, s0 = (u.pm & 31) * BM;
#pragma unroll
        for (int ai = 0; ai < 2; ++ai)
#pragma unroll
            for (int m = 0; m < 4; ++m) { float s = 0.f;
#pragma unroll
                for (int n = 0; n < 2; ++n) { const f32x4 x = acc[ai][0][m][n]; s += (x[0] * x[0] + x[1] * x[1]) + (x[2] * x[2] + x[3] * x[3]); }
                s += __shfl_xor(s, 16); s += __shfl_xor(s, 32);
                if (fq == 0) P[(ai * HALF + wr * 64 + m * 16 + fr) * 4 + wc] = s; }
        asm volatile("s_waitcnt lgkmcnt(0)" ::: "memory"); __builtin_amdgcn_s_barrier(); asm volatile("" ::: "memory");
#pragma unroll
        for (int ai = 0; ai < 2; ++ai)
#pragma unroll
            for (int m = 0; m < 4; ++m) { int rl = ai * HALF + wr * 64 + m * 16 + fr; asm volatile("" : "+v"(rl));
                const f32x4 pp = *(const PG8_LAS f32x4*)(P + rl * 4);
                const float rr = 1.0f / sqrtf(((pp[0] + pp[1]) + (pp[2] + pp[3])) * (1.0f / 128.0f) + RMS_EPS_F);
                const size_t tok = (size_t)(b * 4 + u.pn) * 8192 + s0 + rl;
                bf16_t* krow = Kb + tok * 192; bf16_t* vrow = Vb + tok * 128;
                u32x4 w1, w2;
#pragma unroll
                for (int n = 0; n < 2; ++n) { const f32x4 g = *(const f32x4*)(gn_k + wc * 32 + 8 * fq + 4 * n);
                    const f32x4 kx = acc[ai][0][m][n] * rr * g, vx = acc[ai][1][m][n];
                    w1[2 * n] = cvt_pk_bf16(kx[0], kx[1]); w1[2 * n + 1] = cvt_pk_bf16(kx[2], kx[3]); w2[2 * n] = cvt_pk_bf16(vx[0], vx[1]); w2[2 * n + 1] = cvt_pk_bf16(vx[2], vx[3]); }
                *(u32x4*)(krow + wc * 32 + 8 * fq) = w1; *(u32x4*)(vrow + wc * 32 + 8 * fq) = w2;
                asm volatile("" ::: "memory"); }
    }
};
}
namespace att {
using bf16 = __hip_bfloat16;
typedef short bf16x8 __attribute__((ext_vector_type(8)));
typedef short s16x4 __attribute__((ext_vector_type(4)));
typedef float f32x16 __attribute__((ext_vector_type(16)));
typedef float f32x4 __attribute__((ext_vector_type(4)));
typedef unsigned u32x4 __attribute__((ext_vector_type(4)));
constexpr int DQ = 192, DV = 128, LDO = 1024, SEQL = 8192;
constexpr float SCALE = 0.07216878364870322f;
constexpr float THR = 8.f;
constexpr int NW = 8, QBLK = 32, KVBLK = 64, QB = NW * QBLK;
constexpr int SHM_V = KVBLK * DV * 2, SHM_K = KVBLK * DQ * 2;
constexpr int KPITCH = DQ * 2;
constexpr int NSLOT = 3;
constexpr int LDS_WS = NSLOT * (SHM_V + SHM_K), LDS_QP = LDS_WS + NW * 64 * 4, LDS_NEED = LDS_QP + NW * 4096;
#define KS3(row) ((((row) >> 1) & 3) | ((((row) >> 4) & 1) << 2))
#define KSWZ(row, colB) ((row) * 384 + ((colB) ^ (KS3(row) << 4)))
#define SBAR() __builtin_amdgcn_sched_barrier(0)
__device__ __forceinline__ int v_st(int k, int c) { const int kk = (k & ~0xC) | ((k & 4) << 1) | ((k & 8) >> 1); return ((kk >> 3) * 4 + (c >> 5)) * 512 + ((kk & 7) * 32 + (c & 31)) * 2; }
__device__ __forceinline__ int v_rd_base(int lane) { return ((lane & 3) << 3) | (((lane >> 2) & 3) << 6) | (((lane >> 4) & 1) << 5) | (((lane >> 5) & 1) << 8); }
constexpr int v_rd_off(int d0, int ks, int half) { return d0 * 512 + ks * 4096 + half * 2048; }
__device__ __forceinline__ int crow(int r, int hi) { return (r & 3) + 8 * (r >> 2) + 4 * hi; }
__device__ __forceinline__ unsigned cvtpk(float lo, float hi) { unsigned r; asm volatile("v_cvt_pk_bf16_f32 %0, %1, %2" : "=v"(r) : "v"(lo), "v"(hi)); return r; }
__device__ __forceinline__ bf16x8 load8(const bf16* p) { return *reinterpret_cast<const bf16x8*>(p); }
__device__ __forceinline__ void mask_tile(f32x16& p0, f32x16& p1, int dq) {
    const float NEG = -__builtin_inff();
#pragma unroll
    for (int r = 0; r < 16; ++r) {
        const int c = (r & 3) + 8 * (r >> 2);
        if (dq - c < 0) p0[r] = NEG;
        if (dq - c - 32 < 0) p1[r] = NEG;
    }
}
__device__ __forceinline__ void partialSM(f32x16& p0, f32x16& p1, float& m_reg, float& mn, float& alpha) {
    float pmax = p0[0]; for (int r = 1; r < 16; ++r) pmax = fmaxf(pmax, p0[r]); for (int r = 0; r < 16; ++r) pmax = fmaxf(pmax, p1[r]);
    { auto rr = __builtin_amdgcn_permlane32_swap(__float_as_uint(pmax), __float_as_uint(pmax), false, false);
      pmax = fmaxf(__uint_as_float(rr[0]), __uint_as_float(rr[1])); }
    constexpr float C2 = 1.4426950408889634f * SCALE;
    if (__builtin_expect(__all((pmax - m_reg) * SCALE <= THR), 1)) { mn = m_reg; alpha = 1.f; }
    else { mn = fmaxf(m_reg, pmax); alpha = __builtin_amdgcn_exp2f((m_reg - mn) * C2); m_reg = mn; }
    const float mnL = -mn * C2;
    for (int r = 0; r < 16; ++r) p0[r] = fmaf(p0[r], C2, mnL); for (int r = 0; r < 16; ++r) p1[r] = fmaf(p1[r], C2, mnL);
    for (int r = 0; r < 16; ++r) p0[r] = __builtin_amdgcn_exp2f(p0[r]);
}
__device__ __forceinline__ void finishSM(f32x16& p0, f32x16& p1, float alpha, float& l_reg, bf16x8& pa0, bf16x8& pa1, bf16x8& pa2, bf16x8& pa3) {
    for (int r = 0; r < 16; ++r) p1[r] = __builtin_amdgcn_exp2f(p1[r]);
    float ps = 0; for (int r = 0; r < 16; ++r) ps += p0[r]; for (int r = 0; r < 16; ++r) ps += p1[r];
    { auto rr = __builtin_amdgcn_permlane32_swap(__float_as_uint(ps), __float_as_uint(ps), false, false);
      ps = __uint_as_float(rr[0]) + __uint_as_float(rr[1]); }
    l_reg = l_reg * alpha + ps;
#define PK4(P, B_, OUT) do { unsigned a0 = cvtpk(P[B_+0], P[B_+1]), a1 = cvtpk(P[B_+2], P[B_+3]);                          \
        unsigned b0 = cvtpk(P[B_+4], P[B_+5]), b1 = cvtpk(P[B_+6], P[B_+7]);                                             \
        auto r0 = __builtin_amdgcn_permlane32_swap(a0, b0, false, false); auto r1 = __builtin_amdgcn_permlane32_swap(a1, b1, false, false); \
        u32x4 w = {r0[0], r1[0], r0[1], r1[1]}; OUT = *reinterpret_cast<bf16x8*>(&w); } while (0)
    PK4(p0, 0, pa0); PK4(p0, 8, pa1); PK4(p1, 0, pa2); PK4(p1, 8, pa3);
#undef PK4
}
__device__ __forceinline__ void glds16(const void* gsrc, unsigned lds_dst) { unsigned keep;
    asm volatile("s_mov_b32 %0, m0\n\ts_mov_b32 m0, %2\n\ts_nop 0\n\tglobal_load_lds_dwordx4 %1, off\n\ts_mov_b32 m0, %0" : "=&s"(keep) : "v"(gsrc), "s"(lds_dst) : "memory"); }
__device__ __forceinline__ void qkt(f32x16& p0, f32x16& p1, const char* Kslot, int r32, int hi, const bf16x8* qr, const char* qsp) {
    p0 = f32x16{}; p1 = f32x16{};
    const char* kb[4];
#pragma unroll
    for (int dd = 0; dd < 4; ++dd) kb[dd] = Kslot + KSWZ(r32, (dd * 16 + hi * 8) * 2);
#pragma unroll
    for (int d0 = 0; d0 < 12; ++d0) { const char* a = kb[d0 & 3] + (d0 >> 2) * 128;
        bf16x8 b0 = *reinterpret_cast<const bf16x8*>(a);
        bf16x8 b1 = *reinterpret_cast<const bf16x8*>(a + 32 * KPITCH);
        const bf16x8 qf = d0 < 8 ? qr[d0] : *reinterpret_cast<const bf16x8*>(qsp + (d0 - 8) * 1024);
        p0 = __builtin_amdgcn_mfma_f32_32x32x16_bf16(b0, qf, p0, 0, 0, 0);
        p1 = __builtin_amdgcn_mfma_f32_32x32x16_bf16(b1, qf, p1, 0, 0, 0); }
}
__device__ __forceinline__ void pv_tile(f32x16* o, int vb, bf16x8 pa0, bf16x8 pa1, bf16x8 pa2, bf16x8 pa3) {
#define TRRD(dst, off) asm volatile("ds_read_b64_tr_b16 %0, %1 offset:%2" : "=&v"(dst) : "v"(vb), "i"(off) : "memory")
#define PV_D0(d0) do { s16x4 l0, l1, l2, l3, h0, h1, h2, h3; constexpr int b_ = v_rd_off(d0, 0, 0);     \
        TRRD(l0, b_); TRRD(h0, b_ + 2048); TRRD(l1, b_ + 4096); TRRD(h1, b_ + 6144); TRRD(l2, b_ + 8192); TRRD(h2, b_ + 10240); TRRD(l3, b_ + 12288); TRRD(h3, b_ + 14336); \
        asm volatile("s_waitcnt lgkmcnt(0)" ::: "memory"); SBAR();   \
        o[d0] = __builtin_amdgcn_mfma_f32_32x32x16_bf16(pa0, (bf16x8){l0[0], l0[1], l0[2], l0[3], h0[0], h0[1], h0[2], h0[3]}, o[d0], 0, 0, 0);   \
        o[d0] = __builtin_amdgcn_mfma_f32_32x32x16_bf16(pa1, (bf16x8){l1[0], l1[1], l1[2], l1[3], h1[0], h1[1], h1[2], h1[3]}, o[d0], 0, 0, 0);   \
        o[d0] = __builtin_amdgcn_mfma_f32_32x32x16_bf16(pa2, (bf16x8){l2[0], l2[1], l2[2], l2[3], h2[0], h2[1], h2[2], h2[3]}, o[d0], 0, 0, 0);   \
        o[d0] = __builtin_amdgcn_mfma_f32_32x32x16_bf16(pa3, (bf16x8){l3[0], l3[1], l3[2], l3[3], h3[0], h3[1], h3[2], h3[3]}, o[d0], 0, 0, 0); } while (0)
    PV_D0(0); PV_D0(1); PV_D0(2); PV_D0(3);
#undef PV_D0
#undef TRRD
}
struct BlockRef { const bf16* Q; const bf16* K; const bf16* V; bf16* O; int P0; };
#define WAIT_BAR(N) asm volatile("s_waitcnt vmcnt(" #N ") lgkmcnt(0)\n\ts_barrier" ::: "memory")
__device__ __forceinline__ void attn_block(const BlockRef& cur, char* lds) {
    const int tid = opaque_tid(), wid = __builtin_amdgcn_readfirstlane(tid >> 6), lane = tid & 63, r32 = lane & 31, hi = lane >> 5;
    const int NT = cur.P0 / KVBLK + QB / KVBLK;
    const int qlo = cur.P0 + wid * QBLK, qm = qlo + r32 - 4 * hi;
    char* V_lds = lds; char* K_lds = lds + NSLOT * SHM_V;
    float* ws = (float*)(lds + LDS_WS) + wid * 64; float* li_l = ws, * al_l = ws + 32;
    float m_reg = -1e30f, l_reg = 0; f32x16 o[4] = {};
    const unsigned lds0 = (unsigned)(uintptr_t)lds;
    const int vb0 = (int)lds0 + v_rd_base(lane);
    unsigned kgo[3], vgo[2];
#pragma unroll
    for (int i = 0; i < 3; ++i) { const int ob = (wid * 3 + i) * 1024 + lane * 16, row = ob / 384, rem = ob % 384, g = rem >> 7, cp = (rem & 127) >> 4, c = cp ^ KS3(row);
        kgo[i] = (unsigned)(row * 384 + g * 128 + c * 16); }
#pragma unroll
    for (int i = 0; i < 2; ++i) { const int ob = (wid * 2 + i) * 1024 + lane * 16, st = ob >> 9, rem = ob & 511, kk = (st >> 2) * 8 + (rem >> 6), c = (st & 3) * 32 + ((rem & 63) >> 1);
        const int k = (kk & ~0xC) | ((kk & 4) << 1) | ((kk & 8) >> 1);
        vgo[i] = (unsigned)(k * 256 + c * 2); }
    const char* Kg = (const char*)cur.K; const char* Vg = (const char*)cur.V;
#define DMA_TILE(t, slot) do { const char* kt_ = Kg + (size_t)(t) * (KVBLK * DQ * 2); const char* vt_ = Vg + (size_t)(t) * (KVBLK * DV * 2);                       \
        const unsigned kd_ = lds0 + NSLOT * SHM_V + (slot) * SHM_K + wid * 3072, vd_ = lds0 + (slot) * SHM_V + wid * 2048;                                         \
        glds16(kt_ + kgo[0], (unsigned)__builtin_amdgcn_readfirstlane(kd_)); glds16(kt_ + kgo[1], (unsigned)__builtin_amdgcn_readfirstlane(kd_ + 1024));           \
        glds16(kt_ + kgo[2], (unsigned)__builtin_amdgcn_readfirstlane(kd_ + 2048));                                                                                \
        glds16(vt_ + vgo[0], (unsigned)__builtin_amdgcn_readfirstlane(vd_)); glds16(vt_ + vgo[1], (unsigned)__builtin_amdgcn_readfirstlane(vd_ + 1024)); } while (0)
    DMA_TILE(0, 0); DMA_TILE(1, 1);
    bf16x8 qr[8];
    char* qsp = lds + LDS_QP + wid * 4096 + lane * 16;
#pragma unroll
    for (int d0 = 0; d0 < 8; ++d0) qr[d0] = load8(cur.Q + (size_t)(wid * QBLK + r32) * DQ + d0 * 16 + hi * 8);
#pragma unroll
    for (int d0 = 8; d0 < 12; ++d0) *(bf16x8*)(qsp + (d0 - 8) * 1024) = load8(cur.Q + (size_t)(wid * QBLK + r32) * DQ + d0 * 16 + hi * 8);
    WAIT_BAR(0);
#define RESC(a) do { if (__any((a) < 1.f)) { if (hi == 0) al_l[r32] = (a); asm volatile("s_waitcnt lgkmcnt(0)" ::: "memory");              \
                     for (int d_ = 0; d_ < 4; ++d_) for (int r = 0; r < 16; ++r) o[d_][r] *= al_l[crow(r, hi)]; } } while (0)
#define KBASE(t) ((t) * KVBLK)
#define MASKT(P0_, P1_, t) do { const int kb_ = KBASE(t); if (kb_ + KVBLK - 1 > qlo) mask_tile(P0_, P1_, qm - kb_); } while (0)
    f32x16 p0, p1; float mn, al; bf16x8 pa0, pa1, pa2, pa3;
    int sl = 0, sl2 = 2;
    for (int t = 0; t < NT; ++t) {
        if (t + 2 < NT) DMA_TILE(t + 2, sl2);
        qkt(p0, p1, K_lds + sl * SHM_K, r32, hi, qr, qsp); SBAR();
        MASKT(p0, p1, t); partialSM(p0, p1, m_reg, mn, al);
        RESC(al);
        finishSM(p0, p1, al, l_reg, pa0, pa1, pa2, pa3); SBAR();
        pv_tile(o, vb0 + sl * SHM_V, pa0, pa1, pa2, pa3); SBAR();
        if (t + 2 < NT) WAIT_BAR(5); else WAIT_BAR(0);
        sl2 = sl; sl = (sl == NSLOT - 1) ? 0 : sl + 1;
    }
    if (hi == 0) li_l[r32] = l_reg; asm volatile("s_waitcnt lgkmcnt(0)" ::: "memory");
    float rli[16];
#pragma unroll
    for (int r = 0; r < 16; ++r) rli[r] = __builtin_amdgcn_rcpf(li_l[crow(r, hi)]);
    bf16* Ow = cur.O + (size_t)(wid * QBLK) * LDO;
#pragma unroll
    for (int r = 0; r < 16; ++r) { const int orow = crow(r, hi);
#pragma unroll
        for (int d0 = 0; d0 < 4; ++d0) { const float v = o[d0][r] * rli[r];
            const float vn = __shfl_xor(v, 1);
            if ((r32 & 1) == 0) *(unsigned*)(Ow + (size_t)orow * LDO + d0 * 32 + r32) = cvtpk(v, vn); } }
    WAIT_BAR(0);
#undef RESC
#undef KBASE
#undef MASKT
#undef DMA_TILE
}
#undef WAIT_BAR
struct Item { int bh, qb0, qb1; };
__device__ __forceinline__ Item decode(int L) { Item it; const int xcd = L & 7, k = L >> 3; it.bh = (k >> 4) * 8 + xcd; const int x = k & 15; it.qb0 = x; it.qb1 = 31 - x; return it; }
__device__ __forceinline__ BlockRef mkref(const Item& it, int pass, const bf16* Q, const bf16* K, const bf16* V, bf16* mixed) {
    const int qb = pass ? it.qb1 : it.qb0; BlockRef r;
    r.Q = Q + ((size_t)it.bh * SEQL + (size_t)qb * QB) * DQ; r.K = K + (size_t)it.bh * SEQL * DQ; r.V = V + (size_t)it.bh * SEQL * DV;
    r.O = mixed + ((size_t)(it.bh >> 2) * SEQL + (size_t)qb * QB) * LDO + 512 + (it.bh & 3) * 128; r.P0 = qb * QB;
    return r;
}
__device__ __forceinline__ void attn_phase(char* lds, const bf16* Q, const bf16* K, const bf16* V, bf16* mixed) {
    for (int L = blockIdx.x; L < 256; L += GRID) {
        const Item it = decode(L);
        attn_block(mkref(it, 0, Q, K, V, mixed), lds);
        attn_block(mkref(it, 1, Q, K, V, mixed), lds);
    }
}
#undef KSWZ
#undef KS3
#undef SBAR
}
namespace mk {
typedef unsigned short bf16_t;
typedef short bf16x8 __attribute__((ext_vector_type(8)));
typedef float f32x4 __attribute__((ext_vector_type(4)));
typedef float f32x2 __attribute__((ext_vector_type(2)));
typedef float f32x16 __attribute__((ext_vector_type(16)));
typedef unsigned u32x2 __attribute__((ext_vector_type(2)));
typedef unsigned u32x4 __attribute__((ext_vector_type(4)));
constexpr int NB = 4, SEQ = 8192, T = NB * SEQ, DM = 1024, DEPTH = 2, DFF = 4096, NIN = 2048, NMOD = 6 * DM;
constexpr float EPS = 1e-6f;
constexpr size_t MiB = 1u << 20;
constexpr size_t W_IN = 0, W_Q = 4 * MiB, W_KV = W_Q + 384 * 1024, W_O = W_KV + 256 * 1024, W_1 = W_O + 2 * MiB, W_2 = W_1 + 8 * MiB, W_LAYER = 23 * MiB;
static_assert(W_2 + 8 * MiB <= W_LAYER, "weights");
constexpr size_t WS_W = 0, WS_MOD = 46 * MiB, WS_COS = 47 * MiB, WS_SIN = 51 * MiB, WS_HN = 55 * MiB, WS_QN = 119 * MiB, WS_KVN = 135 * MiB,
                 WS_GST = 143 * MiB, WS_GDV = 207 * MiB, WS_R = 208 * MiB, WS_BT = 464 * MiB, WS_RSS = 496 * MiB, WS_BIAS = 497 * MiB, WS_END = 498 * MiB;
constexpr size_t WS_BAR = WS_MOD + 512 * 1024;
constexpr size_t R_PROJ = 0, R_Q = 128 * MiB, R_K = 176 * MiB, R_V = 224 * MiB;
constexpr int MISC_OFF = 157696;
constexpr int LDS_BYTES = MISC_OFF + 64;
constexpr int EPI_OFF = 131072;

__device__ __forceinline__ float bf2f(unsigned short v) { return __uint_as_float((unsigned)v << 16); }
typedef __bf16 hwbf16x2 __attribute__((ext_vector_type(2)));
__device__ __forceinline__ unsigned pk2(float lo, float hi) { const f32x2 v = {lo, hi}; return __builtin_bit_cast(unsigned, __builtin_convertvector(v, hwbf16x2)); }
__device__ __forceinline__ unsigned f2bf(float f) { return pk2(f, 0.f) & 0xffffu; }
__device__ __forceinline__ float wave_sum(float v) {
#pragma unroll
    for (int o = 1; o < 64; o <<= 1) v += __shfl_xor(v, o);
    return v;
}
__device__ __forceinline__ float half_sum32(float v) {
#pragma unroll
    for (int o = 1; o < 32; o <<= 1) v += __shfl_xor(v, o);
    return v;
}
__device__ __forceinline__ int crow(int r, int hi) { return (r & 3) + 8 * (r >> 2) + 4 * hi; }

__device__ __forceinline__ int src_col(int map, int n) {
    if (map == 1) { if (n < 1536) return n; if (n < 1984) return n + 16; if (n < 2000) return n - 1984 + 1536; return -1; }
    if (map == 2) { if (n < 512) return (n >> 7) * 192 + (n & 127); const int c = n - 512, bj = c >> 7, hd = (c & 127) >> 5, w = c & 31; return hd * 192 + 128 + 32 * bj + w; }
    return n;
}
__device__ __forceinline__ void transpose_item(const float* W, int K, int N, int NP, bf16_t* WT, int map, LAS float* scr, int item, int lane) {
    const int nblk = NP / 32, kb = item / nblk, nb = item % nblk, k0 = 64 * kb, n0 = 32 * nb;
    const int sc = src_col(map, n0 + (lane & 31));
    float tv[32];
#pragma unroll
    for (int i = 0; i < 32; ++i) { const int kk = 2 * i + (lane >> 5); tv[i] = sc >= 0 ? W[(size_t)(k0 + kk) * N + sc] : 0.f; }
#pragma unroll
    for (int i = 0; i < 32; ++i) { const int kk = 2 * i + (lane >> 5); scr[kk * 33 + (lane & 31)] = tv[i]; }
    asm volatile("s_waitcnt lgkmcnt(0)" ::: "memory");
    const int c = lane & 7;
#pragma unroll
    for (int j = 0; j < 4; ++j) { const int n = (lane >> 3) + 8 * j; const LAS float* s = scr + (8 * c) * 33 + n;
        u32x4 o; o.x = pk2(s[0 * 33], s[1 * 33]); o.y = pk2(s[2 * 33], s[3 * 33]); o.z = pk2(s[4 * 33], s[5 * 33]); o.w = pk2(s[6 * 33], s[7 * 33]);
        *(u32x4*)(WT + (size_t)(n0 + n) * K + k0 + 8 * c) = o; }
    asm volatile("s_waitcnt lgkmcnt(0)" ::: "memory");
}
__device__ __forceinline__ void adaln_unit(int u, const float* c, const float* w_ada, const float* b_ada, float* mod, LAS float* lds) {
    const int tid = opaque_tid(), wave = tid >> 6, lane = tid & 63;
    const int l = u / 96, n0 = (u % 96) * 64;
    LAS float* sc = lds; LAS float* red = lds + 4096;
    for (int i = tid; i < 4096; i += 512) { const float v = c[i]; sc[i] = v / (1.0f + __expf(-v)); }
    __syncthreads();
    const float* wp = w_ada + (size_t)l * DM * NMOD + n0 + lane;
    float a0 = 0.f, a1 = 0.f, a2 = 0.f, a3 = 0.f;
#pragma unroll 32
    for (int k = wave * 128; k < wave * 128 + 128; ++k) { const float w = wp[(size_t)k * NMOD]; a0 += sc[k] * w; a1 += sc[1024 + k] * w; a2 += sc[2048 + k] * w; a3 += sc[3072 + k] * w; }
    red[(wave * 4 + 0) * 64 + lane] = a0; red[(wave * 4 + 1) * 64 + lane] = a1; red[(wave * 4 + 2) * 64 + lane] = a2; red[(wave * 4 + 3) * 64 + lane] = a3;
    __syncthreads();
    if (tid < 256) { const int b = tid >> 6; float s = b_ada[(size_t)l * NMOD + n0 + lane];
#pragma unroll
        for (int w = 0; w < 8; ++w) s += red[(w * 4 + b) * 64 + lane];
        mod[((size_t)l * 4 + b) * NMOD + n0 + lane] = s; }
    __syncthreads();
}
__device__ __forceinline__ void prenorm_rows(const float* __restrict__ xin, bf16_t* __restrict__ an, float* __restrict__ rss, const float* __restrict__ modl, int coff) {
    const int tid = opaque_tid(), lane = tid & 63, gw = blockIdx.x * 8 + (tid >> 6), NGW = GRID * 8;
#pragma unroll 4
    for (int t = gw; t < T; t += NGW) {
        const f32x4* xr = (const f32x4*)(xin + (size_t)t * DM) + lane; f32x4 v[4]; float ss = 0.f;
#pragma unroll
        for (int j = 0; j < 4; ++j) { v[j] = xr[64 * j]; ss += (v[j][0] * v[j][0] + v[j][1] * v[j][1]) + (v[j][2] * v[j][2] + v[j][3] * v[j][3]); }
        ss = wave_sum(ss); if (lane == 0) rss[t] = ss;
        const float* mb = modl + (size_t)(t >> 13) * NMOD;
#pragma unroll
        for (int j = 0; j < 4; ++j) { const int col = 256 * j + 4 * lane;
            const f32x4 sc = *(const f32x4*)(mb + coff + col);
            const f32x4 h = v[j] * (sc + 1.0f);
            u32x2 w; w.x = pk2(h[0], h[1]); w.y = pk2(h[2], h[3]); *(u32x2*)(an + (size_t)t * DM + col) = w; }
    }
}
__device__ __forceinline__ void bias_rows(const bf16_t* __restrict__ Wt, int N, const float* __restrict__ modl, int soff, float* __restrict__ bias) {
    const int tid = opaque_tid(), lane = tid & 63, gw = blockIdx.x * 8 + (tid >> 6), NGW = GRID * 8;
#pragma unroll 2
    for (int n = gw; n < N; n += NGW) {
        const u32x4 w0 = *(const u32x4*)(Wt + (size_t)n * 1024 + 16 * lane), w1 = *(const u32x4*)(Wt + (size_t)n * 1024 + 16 * lane + 8);
        float wf[16];
#pragma unroll
        for (int e2 = 0; e2 < 4; ++e2) { wf[2 * e2] = __uint_as_float(w0[e2] << 16); wf[2 * e2 + 1] = __uint_as_float(w0[e2] & 0xffff0000u);
                                         wf[8 + 2 * e2] = __uint_as_float(w1[e2] << 16); wf[8 + 2 * e2 + 1] = __uint_as_float(w1[e2] & 0xffff0000u); }
#pragma unroll
        for (int b = 0; b < 4; ++b) { const float* sp = modl + (size_t)b * NMOD + soff + 16 * lane; float s = 0.f;
#pragma unroll
            for (int q = 0; q < 4; ++q) { const f32x4 sv = *(const f32x4*)(sp + 4 * q); s += (sv[0] * wf[4 * q] + sv[1] * wf[4 * q + 1]) + (sv[2] * wf[4 * q + 2] + sv[3] * wf[4 * q + 3]); }
            s = wave_sum(s); if (lane == 0) bias[(size_t)b * N + n] = s; }
    }
}
__device__ __forceinline__ void prep_tokens(const bf16_t* __restrict__ proj, bf16_t* __restrict__ qn, bf16_t* __restrict__ kvn, bf16_t* __restrict__ Kb, const float* __restrict__ qa, const float* __restrict__ kva, const float* __restrict__ kr,
                                            const float* __restrict__ cosT, const float* __restrict__ sinT) {
    const int tid = opaque_tid(), lane = tid & 63, gw = blockIdx.x * 8 + (tid >> 6), NGW = GRID * 8;
#pragma unroll 4
    for (int t = gw; t < T; t += NGW) {
        const bf16_t* pr = proj + (size_t)t * NIN;
        { const u32x2 w = *(const u32x2*)(pr + 1536 + 4 * lane);
          const float q0 = __uint_as_float(w.x << 16), q1 = __uint_as_float(w.x & 0xffff0000u), q2 = __uint_as_float(w.y << 16), q3 = __uint_as_float(w.y & 0xffff0000u);
          const float rr = 1.0f / sqrtf(wave_sum((q0 * q0 + q1 * q1) + (q2 * q2 + q3 * q3)) * (1.0f / 256.0f) + EPS);
          const f32x4 g = *(const f32x4*)(qa + 4 * lane);
          u32x2 o; o.x = pk2(q0 * rr * g[0], q1 * rr * g[1]); o.y = pk2(q2 * rr * g[2], q3 * rr * g[3]); *(u32x2*)(qn + (size_t)t * 256 + 4 * lane) = o; }
        { const unsigned w = *(const unsigned*)(pr + 1792 + 2 * lane);
          const float k0 = __uint_as_float(w << 16), k1 = __uint_as_float(w & 0xffff0000u);
          const float rr = 1.0f / sqrtf(wave_sum(k0 * k0 + k1 * k1) * (1.0f / 128.0f) + EPS);
          const f32x2 g = *(const f32x2*)(kva + 2 * lane);
          *(unsigned*)(kvn + (size_t)t * 128 + 2 * lane) = pk2(k0 * rr * g[0], k1 * rr * g[1]); }
        { float y = bf2f(pr[1920 + lane]);
          const float rr = 1.0f / sqrtf(wave_sum(y * y) * (1.0f / 64.0f) + EPS);
          y = y * rr * kr[lane];
          const float pn = __shfl_xor(y, 32); const int j = lane & 31;
          const float c = cosT[(size_t)t * 32 + j], s = sinT[(size_t)t * 32 + j];
          const float o = lane < 32 ? y * c - pn * s : y * c + pn * s;
          const bf16_t ob = (bf16_t)f2bf(o); const int b = t >> 13, sp = t & 8191;
#pragma unroll
          for (int h = 0; h < 4; ++h) Kb[((size_t)(b * 4 + h) * SEQ + sp) * 192 + 128 + lane] = ob; }
    }
}
__device__ __forceinline__ void gla_pass_a(LAS float* ldsf, const bf16_t* proj, const float* wgu, const float* bg, float* Btab, float* Gst, float* Gdv) {
    const int tid = opaque_tid(), lane = tid & 63, r = lane & 31, hh = lane >> 5, wv = tid >> 6, gw = blockIdx.x * 8 + wv, NGW = GRID * 8;
    LAS float* Bw = ldsf + wv * 4096;
    for (int u = gw; u < 16 * 128 * 2; u += NGW) { const int item = u >> 1, dkb = u & 1;
        const int bh = item >> 7, n = item & 127, b = bh >> 2, h = bh & 3; const size_t row0 = (size_t)b * SEQ + (size_t)n * 64;
        const int dk = 32 * dkb + r;
        float bl;
        { float w[16];
#pragma unroll
          for (int q = 0; q < 16; ++q) w[q] = wgu[q * 256 + h * 64 + dk];
          const float bias = bg[h * 64 + dk];
          float loc[32]; float a = 0.f;
#pragma unroll
          for (int t0 = 0; t0 < 32; t0 += 8) { u32x4 g0[8], g1[8];
#pragma unroll
              for (int i = 0; i < 8; ++i) { const bf16_t* ga = proj + (row0 + 32 * hh + t0 + i) * NIN + 1984; g0[i] = *(const u32x4*)ga; g1[i] = *(const u32x4*)(ga + 8); }
#pragma unroll
              for (int i = 0; i < 8; ++i) { float x = bias;
#pragma unroll
                  for (int e2 = 0; e2 < 4; ++e2) { x += __uint_as_float(g0[i][e2] << 16) * w[2 * e2] + __uint_as_float(g0[i][e2] & 0xffff0000u) * w[2 * e2 + 1];
                                                   x += __uint_as_float(g1[i][e2] << 16) * w[8 + 2 * e2] + __uint_as_float(g1[i][e2] & 0xffff0000u) * w[8 + 2 * e2 + 1]; }
                  a += (fminf(x, 0.f) - __logf(1.0f + __expf(-fabsf(x)))) * (1.0f / 16.0f);
                  loc[t0 + i] = a; } }
          const float tot0 = __shfl(a, r);
          const float off = hh ? tot0 : 0.f;
#pragma unroll
          for (int t = 0; t < 32; ++t) { const float v = loc[t] + off; Bw[(32 * hh + t) * 33 + r] = v; Btab[(row0 + 32 * hh + t) * 256 + h * 64 + dk] = v; }
          asm volatile("s_waitcnt lgkmcnt(0)" ::: "memory");
          bl = Bw[63 * 33 + r]; }
        f32x16 acc[4] = {};
#pragma unroll
        for (int ks = 0; ks < 4; ++ks) { bf16x8 bv;
#pragma unroll
            for (int j = 0; j < 8; ++j) { const int t = 16 * ks + 8 * hh + j;
                bv[j] = (short)f2bf(bf2f(proj[(row0 + t) * NIN + 256 + h * 64 + dk]) * __expf(bl - Bw[t * 33 + r])); }
#pragma unroll
            for (int dvb = 0; dvb < 4; ++dvb) { bf16x8 av;
#pragma unroll
                for (int j = 0; j < 8; ++j) { const int t = 16 * ks + 8 * hh + j; av[j] = (short)proj[(row0 + t) * NIN + 512 + h * 128 + 32 * dvb + r]; }
                acc[dvb] = __builtin_amdgcn_mfma_f32_32x32x16_bf16(av, bv, acc[dvb], 0, 0, 0); } }
#pragma unroll
        for (int dvb = 0; dvb < 4; ++dvb) { float* go = Gst + ((size_t)item * 128 + 32 * dvb) * 64 + dk;
#pragma unroll
            for (int i = 0; i < 16; ++i) go[(size_t)crow(i, hh) * 64] = acc[dvb][i]; }
        if (hh == 0) Gdv[(size_t)item * 64 + dk] = __expf(bl);
        asm volatile("s_waitcnt lgkmcnt(0)" ::: "memory");
    }
}
__device__ __forceinline__ void gla_scan(float* Gst, const float* Gdv) {
    const int gt = blockIdx.x * 512 + opaque_tid(), GT = GRID * 512;
    for (int e = gt; e < 16 * 8192; e += GT) { const int bh = e >> 13, idx = e & 8191, dk = idx & 63;
        float* base = Gst + (size_t)bh * 128 * 8192 + idx; const float* dvp = Gdv + (size_t)bh * 128 * 64 + dk;
        float s = 0.f;
        for (int n0 = 0; n0 < 128; n0 += 16) { float u[16], dd[16];
#pragma unroll
            for (int i = 0; i < 16; ++i) { u[i] = base[(size_t)(n0 + i) * 8192]; dd[i] = dvp[(n0 + i) * 64]; }
#pragma unroll
            for (int i = 0; i < 16; ++i) { base[(size_t)(n0 + i) * 8192] = s; s = dd[i] * s + u[i]; } }
    }
}
__device__ __forceinline__ void gla_pass_c(const bf16_t* proj, const float* Btab, const float* Gst, const float* gout, bf16_t* mixed) {
    const int tid = opaque_tid(), lane = tid & 63, r = lane & 31, hh = lane >> 5, gw = blockIdx.x * 8 + (tid >> 6), NGW = GRID * 8;
    for (int u = gw; u < 16 * 128 * 2; u += NGW) { const int item = u >> 1, tb = __builtin_amdgcn_readfirstlane((u ^ (u >> 11) ^ (u >> 3)) & 1);
        const int bh = item >> 7, n = item & 127, b = bh >> 2, h = bh & 3; const size_t row0 = (size_t)b * SEQ + (size_t)n * 64;
        const int tl = 32 * tb + r;
        bf16x8 qe[4];
        { const bf16_t* qp = proj + (row0 + tl) * NIN + h * 64; const float* bp = Btab + (row0 + tl) * 256 + h * 64;
#pragma unroll
          for (int ks = 0; ks < 4; ++ks) { const u32x4 qw = *(const u32x4*)(qp + 16 * ks + 8 * hh); const f32x4 b0 = *(const f32x4*)(bp + 16 * ks + 8 * hh), b1 = *(const f32x4*)(bp + 16 * ks + 8 * hh + 4);
              u32x4 w; w.x = pk2(__uint_as_float(qw[0] << 16) * 0.125f * __expf(b0[0]), __uint_as_float(qw[0] & 0xffff0000u) * 0.125f * __expf(b0[1]));
                       w.y = pk2(__uint_as_float(qw[1] << 16) * 0.125f * __expf(b0[2]), __uint_as_float(qw[1] & 0xffff0000u) * 0.125f * __expf(b0[3]));
                       w.z = pk2(__uint_as_float(qw[2] << 16) * 0.125f * __expf(b1[0]), __uint_as_float(qw[2] & 0xffff0000u) * 0.125f * __expf(b1[1]));
                       w.w = pk2(__uint_as_float(qw[3] << 16) * 0.125f * __expf(b1[2]), __uint_as_float(qw[3] & 0xffff0000u) * 0.125f * __expf(b1[3]));
              qe[ks] = __builtin_bit_cast(bf16x8, w); } }
        f32x16 o[4] = {};
#pragma unroll
        for (int dvb = 0; dvb < 4; ++dvb) { const float* sp = Gst + ((size_t)item * 128 + 32 * dvb + r) * 64;
#pragma unroll
          for (int ks = 0; ks < 4; ++ks) { const f32x4 s0 = *(const f32x4*)(sp + 16 * ks + 8 * hh), s1 = *(const f32x4*)(sp + 16 * ks + 8 * hh + 4);
              u32x4 sw; sw.x = pk2(s0[0], s0[1]); sw.y = pk2(s0[2], s0[3]); sw.z = pk2(s1[0], s1[1]); sw.w = pk2(s1[2], s1[3]);
              o[dvb] = __builtin_amdgcn_mfma_f32_32x32x16_bf16(qe[ks], __builtin_bit_cast(bf16x8, sw), o[dvb], 0, 0, 0); } }
        for (int sb = 0; sb <= tb; ++sb) {
            f32x16 x = {};
            const int sl = 32 * sb + r; const bf16_t* kp = proj + (row0 + sl) * NIN + 256 + h * 64; const float* bp = Btab + (row0 + sl) * 256 + h * 64;
#pragma unroll
            for (int ks = 0; ks < 4; ++ks) { const u32x4 kw = *(const u32x4*)(kp + 16 * ks + 8 * hh); const f32x4 b0 = *(const f32x4*)(bp + 16 * ks + 8 * hh), b1 = *(const f32x4*)(bp + 16 * ks + 8 * hh + 4);
                u32x4 w; w.x = pk2(__uint_as_float(kw[0] << 16) * __expf(-b0[0]), __uint_as_float(kw[0] & 0xffff0000u) * __expf(-b0[1]));
                         w.y = pk2(__uint_as_float(kw[1] << 16) * __expf(-b0[2]), __uint_as_float(kw[1] & 0xffff0000u) * __expf(-b0[3]));
                         w.z = pk2(__uint_as_float(kw[2] << 16) * __expf(-b1[0]), __uint_as_float(kw[2] & 0xffff0000u) * __expf(-b1[1]));
                         w.w = pk2(__uint_as_float(kw[3] << 16) * __expf(-b1[2]), __uint_as_float(kw[3] & 0xffff0000u) * __expf(-b1[3]));
                x = __builtin_amdgcn_mfma_f32_32x32x16_bf16(__builtin_bit_cast(bf16x8, w), qe[ks], x, 0, 0, 0); }
            if (sb == tb) {
#pragma unroll
                for (int i = 0; i < 16; ++i) if (crow(i, hh) > r) x[i] = 0.f; }
#pragma unroll
            for (int s2 = 0; s2 < 2; ++s2) { u32x4 xw; xw.x = pk2(x[8 * s2], x[8 * s2 + 1]); xw.y = pk2(x[8 * s2 + 2], x[8 * s2 + 3]); xw.z = pk2(x[8 * s2 + 4], x[8 * s2 + 5]); xw.w = pk2(x[8 * s2 + 6], x[8 * s2 + 7]);
#pragma unroll
                for (int dvb = 0; dvb < 4; ++dvb) { bf16x8 vb;
#pragma unroll
                    for (int j = 0; j < 8; ++j) { const int sk = 32 * sb + 16 * s2 + 8 * (j >> 2) + 4 * hh + (j & 3); vb[j] = (short)proj[(row0 + sk) * NIN + 512 + h * 128 + 32 * dvb + r]; }
                    o[dvb] = __builtin_amdgcn_mfma_f32_32x32x16_bf16(__builtin_bit_cast(bf16x8, xw), vb, o[dvb], 0, 0, 0); } } }
        float gn[4];
#pragma unroll
        for (int dvb = 0; dvb < 4; ++dvb) gn[dvb] = gout[32 * dvb + r];
#pragma unroll
        for (int i = 0; i < 16; ++i) { const int t = 32 * tb + crow(i, hh);
            const float tot = half_sum32((o[0][i] * o[0][i] + o[1][i] * o[1][i]) + (o[2][i] * o[2][i] + o[3][i] * o[3][i]));
            const float rr = __builtin_amdgcn_rsqf(tot * (1.0f / 128.0f) + EPS);
#pragma unroll
            for (int dvb = 0; dvb < 4; ++dvb) { const float g = bf2f(proj[(row0 + t) * NIN + 1024 + h * 128 + 32 * dvb + r]);
                const float val = o[dvb][i] * rr * gn[dvb] * (g * __builtin_amdgcn_rcpf(1.0f + __expf(-g)));
                mixed[(row0 + t) * DM + h * 128 + 32 * dvb + r] = (bf16_t)f2bf(val); } }
    }
}
}
#define XB_TMO      128
#define XB_XCNT(j)  (256  + 64 * (j))
#define XB_XSUB(j)  (1280 + 64 * (j))
#define XB_XGEN(j)  (2304 + 64 * (j))
#define XB_TOP      3328
#define XB_TOPGEN   3392
#define XCD_BAR_WORDS 3456
#define XB_SPIN_CAP (1u << 18)

__device__ __forceinline__ unsigned xb_ld(unsigned* p)              { return __hip_atomic_load(p, __ATOMIC_RELAXED, __HIP_MEMORY_SCOPE_AGENT); }
__device__ __forceinline__ unsigned xb_add(unsigned* p, unsigned v) { return __hip_atomic_fetch_add(p, v, __ATOMIC_RELAXED, __HIP_MEMORY_SCOPE_AGENT); }
__device__ __forceinline__ unsigned xb_xcc_id() { return (unsigned)__builtin_amdgcn_s_getreg((3 << 11) | 20) & 0xFu; }
#define XB_SPIN(cond, bar) do { unsigned _sp = 0; while (cond) { __builtin_amdgcn_s_sleep(1); \
    if ((++_sp & 255u) == 0u) { if (xb_ld(&(bar)[XB_TMO])) break; if (_sp > XB_SPIN_CAP) { atomicAdd(&(bar)[XB_TMO], 1u); break; } } } } while (0)

struct XcdBarrier {
    unsigned* bar; unsigned x;
    volatile LAS unsigned* st;
};

__device__ __forceinline__ XcdBarrier xcd_barrier_post(unsigned* bar, volatile LAS unsigned* st) {
    XcdBarrier b; b.bar = bar; b.x = xb_xcc_id(); b.st = st;
    if (threadIdx.x == 0) (void)xb_add(&bar[XB_XCNT(b.x)], 1u);
    return b;
}
__device__ __forceinline__ void xcd_barrier_complete(unsigned* bar, unsigned x, unsigned& nloc, unsigned& nx) {
    const unsigned G = gridDim.x * gridDim.y * gridDim.z;
    unsigned sum, cnt, mine, sp = 0u;
    for (;;) {
        sum = 0u; cnt = 0u; mine = 0u;
#pragma unroll
        for (unsigned j = 0; j < 16; ++j) { const unsigned c = xb_ld(&bar[XB_XCNT(j)]); sum += c; cnt += (c > 0u) ? 1u : 0u; mine = (j == x) ? c : mine; }
        if (sum == G) break;
        __builtin_amdgcn_s_sleep(1);
        if ((++sp & 255u) == 0u) { if (xb_ld(&bar[XB_TMO])) break; if (sp > XB_SPIN_CAP) { atomicAdd(&bar[XB_TMO], 1u); break; } }
    }
    nloc = mine > 0u ? mine : 1u; nx = cnt > 0u ? cnt : 1u;
}

__device__ __forceinline__ void xcd_barrier(const XcdBarrier& b) {
    asm volatile("s_waitcnt vmcnt(0)" ::: "memory");
    __syncthreads();
    if (threadIdx.x == 0) {
        unsigned* bar = b.bar; unsigned bx = b.x; asm volatile("" : "+s"(bx));
        __builtin_amdgcn_s_waitcnt(0);
        unsigned nloc = b.st[0], nx = b.st[1];
        if (nloc == 0u) { xcd_barrier_complete(bar, bx, nloc, nx); b.st[0] = nloc; b.st[1] = nx; }
        const unsigned old = xb_add(&bar[XB_XSUB(bx)], 1u);
        const unsigned gen = old / nloc;
        if (old + 1u == (gen + 1u) * nloc) {
            __builtin_amdgcn_fence(__ATOMIC_RELEASE, "agent");
            asm volatile("s_waitcnt vmcnt(0)" ::: "memory");
            const unsigned og = xb_add(&bar[XB_TOP], 1u);
            const unsigned tg = og / nx;
            if (og + 1u == (tg + 1u) * nx) xb_add(&bar[XB_TOPGEN], 1u);
            else XB_SPIN(xb_ld(&bar[XB_TOPGEN]) == tg, bar);
            __builtin_amdgcn_fence(__ATOMIC_ACQUIRE, "agent");
            xb_add(&bar[XB_XGEN(bx)], 1u);
            asm volatile("s_waitcnt vmcnt(0)" ::: "memory");
        } else {
            XB_SPIN(xb_ld(&bar[XB_XGEN(bx)]) == gen, bar);
            __builtin_amdgcn_fence(__ATOMIC_ACQUIRE, "agent");
            asm volatile("s_waitcnt vmcnt(0)" ::: "memory");
        }
    }
    __syncthreads();
}
#ifndef PHM
#define PHM 0xffff
#endif
#ifndef REP
#define REP 0
#endif
#ifndef USE_XB
#define USE_XB 1
#endif
#if USE_XB
#define GSYNC() xcd_barrier(xbar)
#else
#define GSYNC() grid.sync()
#endif
#if REP
#define REPEAT(k) _Pragma("unroll 1") for (int rep_ = 0, nrep_ = opaque_int((((REP) >> (k)) & 1) + 1); rep_ < nrep_; ++rep_)
#else
#define REPEAT(k)
#endif
struct Args { const float* in[20]; float* out; unsigned char* ws; float inv_freq[32]; };
__global__ void __launch_bounds__(512, 2) mega_fwd(Args a) {
    using namespace mk;
    extern __shared__ __attribute__((aligned(16))) unsigned char lds[];
    cg::grid_group grid = cg::this_grid();
    const int tid = opaque_tid(), lane = tid & 63, wave = __builtin_amdgcn_readfirstlane(tid >> 6);
    constexpr int G = GRID;
    PG8_LAS unsigned char* ldsl = (PG8_LAS unsigned char*)lds;
    LAS float* ldsf = (LAS float*)lds;
    unsigned char* ws = a.ws;
    const float* x_in = a.in[0]; const float* c_in = a.in[1]; const int* pos = (const int*)a.in[2];
    const float* w_ada = a.in[3]; const float* b_ada = a.in[4];
    float* mod = (float*)(ws + WS_MOD); float* cosT = (float*)(ws + WS_COS); float* sinT = (float*)(ws + WS_SIN);
    bf16_t* HN = (bf16_t*)(ws + WS_HN); bf16_t* QN = (bf16_t*)(ws + WS_QN); bf16_t* KVN = (bf16_t*)(ws + WS_KVN);
    float* GST = (float*)(ws + WS_GST); float* GDV = (float*)(ws + WS_GDV); float* BT = (float*)(ws + WS_BT);
    bf16_t* PROJ = (bf16_t*)(ws + WS_R + R_PROJ); bf16_t* QB_ = (bf16_t*)(ws + WS_R + R_Q); bf16_t* KB_ = (bf16_t*)(ws + WS_R + R_K); bf16_t* VB_ = (bf16_t*)(ws + WS_R + R_V);
    bf16_t* HB = (bf16_t*)(ws + WS_R);
    float* xout = a.out;
    float* RSS = (float*)(ws + WS_RSS); float* BIAS = (float*)(ws + WS_BIAS); bf16_t* AN1 = (bf16_t*)(ws + WS_GST);
#if USE_XB
    volatile LAS unsigned* MISC = (volatile LAS unsigned*)(ldsl + MISC_OFF);
    if (tid < 16) MISC[tid] = 0u;
    __syncthreads();
    const XcdBarrier xbar = xcd_barrier_post((unsigned*)(ws + WS_BAR), MISC);
#endif

    REPEAT(0) {
#if (PHM >> 0) & 1
    for (int u = blockIdx.x; u < 192; u += G) adaln_unit(u, c_in, w_ada, b_ada, mod, ldsf);
    __syncthreads();
    { const int gt = blockIdx.x * 512 + tid, GT = G * 512;
      for (int e = gt; e < T * 32; e += GT) { const int t = e >> 5, j = e & 31;
          const float ang = (float)pos[t] * a.inv_freq[j];
          const double turns = (double)ang * 0.15915494309189535; const float fr = (float)(turns - rint(turns)) * 6.283185307179586f;
          cosT[e] = cosf(fr); sinT[e] = sinf(fr); } }
    { float* rz = (float*)(ws + WS_RSS) + T; const int gt = blockIdx.x * 512 + tid, GT = G * 512; for (int e = gt; e < 3 * T; e += GT) rz[e] = 0.f; }
    { LAS float* scr = (LAS float*)(ldsl + wave * 16384);
      const int gw = blockIdx.x * 8 + wave, NGW = G * 8;
      constexpr int I_IN = 16 * 64, I_Q = 4 * 24, I_KV = 2 * 32, I_O = 16 * 32, I_1 = 16 * 128, I_2 = 64 * 32, I_L = I_IN + I_Q + I_KV + I_O + I_1 + I_2;
      for (int it = gw; it < DEPTH * I_L; it += NGW) { const int l = it / I_L; int r = it % I_L; unsigned char* wl = ws + WS_W + (size_t)l * W_LAYER;
          if (r < I_IN) { transpose_item(a.in[5] + (size_t)l * 1024 * 2000, 1024, 2000, 2048, (bf16_t*)(wl + W_IN), 1, scr, r, lane); continue; } r -= I_IN;
          if (r < I_Q) { transpose_item(a.in[10] + (size_t)l * 256 * 768, 256, 768, 768, (bf16_t*)(wl + W_Q), 2, scr, r, lane); continue; } r -= I_Q;
          if (r < I_KV) { transpose_item(a.in[12] + (size_t)l * 128 * 1024, 128, 1024, 1024, (bf16_t*)(wl + W_KV), 0, scr, r, lane); continue; } r -= I_KV;
          if (r < I_O) { transpose_item(a.in[17] + (size_t)l * 1024 * 1024, 1024, 1024, 1024, (bf16_t*)(wl + W_O), 0, scr, r, lane); continue; } r -= I_O;
          if (r < I_1) { transpose_item(a.in[18] + (size_t)l * 1024 * 4096, 1024, 4096, 4096, (bf16_t*)(wl + W_1), 0, scr, r, lane); continue; } r -= I_1;
          transpose_item(a.in[19] + (size_t)l * 4096 * 1024, 4096, 1024, 1024, (bf16_t*)(wl + W_2), 0, scr, r, lane); } }
#endif
    grid.sync();
    prenorm_rows(x_in, HN, RSS, mod, 1024);
    for (int l = 0; l < DEPTH; ++l) { unsigned char* wl = ws + WS_W + (size_t)l * W_LAYER; const float* modl = mod + (size_t)l * 4 * NMOD;
        bias_rows((const bf16_t*)(wl + W_IN), NIN, modl, 0, BIAS + (size_t)l * 4 * NIN);
        bias_rows((const bf16_t*)(wl + W_1), DFF, modl, 3072, BIAS + 2 * 4 * NIN + (size_t)l * 4 * DFF); }
    GSYNC();

    }
#pragma unroll 1
    for (int l = 0; l < DEPTH; ++l) {
        const float* modl = mod + (size_t)l * 4 * NMOD;
        unsigned char* wl = ws + WS_W + (size_t)l * W_LAYER;
        const float* xin = l == 0 ? x_in : xout;
#if (PHM >> 2) & 1
        REPEAT(2) { pg8::Gemm g{HN, (const bf16_t*)(wl + W_IN), T, NIN, DM}; pg8::StaticOrder S; S.init(T, NIN, G, (int)blockIdx.x);
          pg8::EpiBf16<0> E{PROJ, NIN, BIAS + (size_t)l * 4 * NIN, 0, 0, 1.f, RSS + (size_t)(2 * l) * T, NIN};
          pg8::gemm_phase<pg8::EpiBf16<0>, pg8::StaticOrder, true, true>(ldsl, g, S, E); }
#endif
        GSYNC();
#if (PHM >> 3) & 1
        REPEAT(3) prep_tokens(PROJ, QN, KVN, KB_, a.in[9] + l * 256, a.in[11] + l * 128, a.in[16] + l * 64, cosT, sinT);
#endif
#if (PHM >> 4) & 1
        REPEAT(4) gla_pass_a(ldsf, PROJ, a.in[6] + (size_t)l * 16 * 256, a.in[7] + l * 256, BT, GST, GDV);
#endif
        GSYNC();
#if (PHM >> 5) & 1
        REPEAT(5) { int kq = 256; asm volatile("" : "+s"(kq));
          pg8::Gemm g{QN, (const bf16_t*)(wl + W_Q), T, 512, kq}; pg8::StaticOrder S; S.init(T, 512, G, (int)blockIdx.x);
          pg8::EpiQN E{QB_, a.in[13] + l * 128, (PG8_LAS float*)(ldsl + EPI_OFF)};
          pg8::gemm_phase<pg8::EpiQN, pg8::StaticOrder, true, true>(ldsl, g, S, E); }
#endif
#if (PHM >> 13) & 1
        REPEAT(5) { int kq = 256; asm volatile("" : "+s"(kq));
          pg8::Gemm g{QN, (const bf16_t*)(wl + W_Q) + 512 * 256, T, 256, kq}; pg8::StaticOrder S; S.init(T, 256, G, (int)blockIdx.x);
          pg8::EpiQR E{QB_, a.in[15] + l * 64, cosT, sinT};
          pg8::gemm_phase<pg8::EpiQR, pg8::StaticOrder, true, true>(ldsl, g, S, E); }
#endif
#if (PHM >> 6) & 1
        REPEAT(5) { int kk = 128; asm volatile("" : "+s"(kk));
          pg8::Gemm g{KVN, (const bf16_t*)(wl + W_KV), T, 1024, kk}; pg8::StaticOrder S; S.init(T, 1024, G, (int)blockIdx.x);
          pg8::EpiKV E{KB_, VB_, a.in[14] + l * 128, (PG8_LAS float*)(ldsl + EPI_OFF)};
          pg8::gemm_phase<pg8::EpiKV, pg8::StaticOrder, true, true>(ldsl, g, S, E); }
#endif
#if (PHM >> 7) & 1
        gla_scan(GST, GDV);
#endif
        GSYNC();
#if (PHM >> 8) & 1
        REPEAT(8) att::attn_phase((char*)lds, (const att::bf16*)QB_, (const att::bf16*)KB_, (const att::bf16*)VB_, (att::bf16*)HN);
#endif
        __syncthreads();
#if (PHM >> 9) & 1
        REPEAT(9) gla_pass_c(PROJ, BT, GST, a.in[8] + l * 128, HN);
#endif
        GSYNC();
#if (PHM >> 10) & 1
        { pg8::Gemm g{HN, (const bf16_t*)(wl + W_O), T, DM, DM}; pg8::StaticOrder S; S.init(T, DM, G, (int)blockIdx.x);
          pg8::EpiResGate E{xin, xout, modl + 2048, AN1, modl + 4096, RSS + (size_t)(2 * l + 1) * T};
          pg8::gemm_phase<pg8::EpiResGate, pg8::StaticOrder, true, true>(ldsl, g, S, E); }
#endif
        GSYNC();
#if (PHM >> 11) & 1
        REPEAT(11) { pg8::Gemm g{AN1, (const bf16_t*)(wl + W_1), T, DFF, DM}; pg8::StaticOrder S; S.init(T, DFF, G, (int)blockIdx.x);
          pg8::EpiBf16<2> E{HB, DFF, BIAS + 2 * 4 * NIN + (size_t)l * 4 * DFF, 0, 0, 1.f, RSS + (size_t)(2 * l + 1) * T, DFF};
          pg8::gemm_phase<pg8::EpiBf16<2>, pg8::StaticOrder, true, true>(ldsl, g, S, E); }
#endif
        GSYNC();
#if (PHM >> 12) & 1
        { pg8::Gemm g{HB, (const bf16_t*)(wl + W_2), T, DM, DFF}; pg8::StaticOrder S; S.init(T, DM, G, (int)blockIdx.x);
          const bool more = l + 1 < DEPTH;
          pg8::EpiResGate E{xout, xout, modl + 5120, more ? HN : nullptr, mod + (size_t)(l + 1) * 4 * NMOD + 1024, RSS + (size_t)(2 * l + 2) * T};
          pg8::gemm_phase<pg8::EpiResGate, pg8::StaticOrder, true, true>(ldsl, g, S, E); }
#endif
        if (l + 1 < DEPTH) GSYNC();
    }
}

extern "C" void kernel_launch(void* const* d_in, const int* in_sizes, int n_in, void* d_out, int out_size, void* d_ws, size_t ws_size, hipStream_t stream) {
    static int grid = 0;
    if (grid == 0) {
        if (n_in != 20 || out_size != mk::T * mk::DM || ws_size < mk::WS_END) { fprintf(stderr, "kernel_launch: unexpected shapes (n_in %d out %d ws %zu)\n", n_in, out_size, ws_size); grid = -1; return; }
        int dev = 0, cus = 0, per = 0;
        (void)hipGetDevice(&dev); (void)hipDeviceGetAttribute(&cus, hipDeviceAttributeMultiprocessorCount, dev);
        (void)hipFuncSetAttribute((const void*)mega_fwd, hipFuncAttributeMaxDynamicSharedMemorySize, mk::LDS_BYTES);
        if (hipOccupancyMaxActiveBlocksPerMultiprocessor(&per, (const void*)mega_fwd, 512, mk::LDS_BYTES) != hipSuccess || per < 1) per = 1;
        (void)hipGetLastError();
        if (cus * per < GRID) fprintf(stderr, "kernel_launch: device holds %d co-resident workgroups, kernel built for %d\n", cus * per, GRID);
        grid = GRID;
    }
    if (grid < 0) return;
    (void)hipMemsetAsync((unsigned char*)d_ws + mk::WS_BAR, 0, XCD_BAR_WORDS * sizeof(unsigned), stream);
    Args a{};
    for (int i = 0; i < 20; ++i) a.in[i] = (const float*)d_in[i];
    a.out = (float*)d_out; a.ws = (unsigned char*)d_ws;
    for (int j = 0; j < 32; ++j) a.inv_freq[j] = powf(10000.0f, -(float)(2 * j) / 64.0f);
    void* args[] = {&a};
    hipError_t e = hipLaunchCooperativeKernel((const void*)mega_fwd, dim3(grid), dim3(512), args, mk::LDS_BYTES, stream);
    if (e != hipSuccess) fprintf(stderr, "kernel_launch: cooperative launch failed: %s (grid %d)\n", hipGetErrorString(e), grid);
}
```

```cpp
#include <hip/hip_runtime.h>
#include <hip/hip_bf16.h>
#include <hip/hip_cooperative_groups.h>
#include <cstdio>
#include <cstdint>
#include <cmath>
namespace cg = cooperative_groups;
#define LAS __attribute__((address_space(3)))
__device__ __forceinline__ int opaque_tid() { int t = threadIdx.x; asm volatile("" : "+v"(t)); return t; }
__device__ __forceinline__ int opaque_int(int v) { asm volatile("" : "+s"(v)); return v; }
constexpr int GRID = 256;
namespace pg8 {
#define PG8_LAS __attribute__((address_space(3)))
typedef unsigned short bf16_t;
typedef short bf16x8 __attribute__((ext_vector_type(8)));
typedef float f32x4 __attribute__((ext_vector_type(4)));
typedef unsigned u32x4 __attribute__((ext_vector_type(4)));
constexpr int BM = 256, BK = 64, HALF = 128, HTB = HALF * BK * 2  , STAGE_BYTES = 8 * HTB, NXCD = 8, WGM = 8;

__host__ __device__ __forceinline__ int lds_byte(int r, int c) { const int st = (r >> 4) * 2 + (c >> 5), rr = r & 15, cc = c & 31, ob = rr * 64 + cc * 2; return st * 1024 + (ob ^ (((ob >> 9) & 1) << 5)); }
__host__ __device__ __forceinline__ void stage_rc(int b, int& R, int& C) { const int st = b / 1024, sb = b % 1024, swz = sb ^ (((sb >> 9) & 1) << 5); R = (st >> 1) * 16 + swz / 64; C = (st & 1) * 32 + (swz % 64) / 2; }
__host__ __device__ __forceinline__ int perm32(int rho) { const int n = rho >> 4, i = rho & 15; return 8 * (i >> 2) + 4 * n + (i & 3); }

struct Unit { int pm, pn; };
struct Gemm { const bf16_t* A; const bf16_t* Bt; int M, N, K; };

struct StaticOrder {
    int nM, nN, nwg, G, c;
    __host__ __device__ void init(int M, int N, int G_, int c_) { nM = M / BM; nN = N / BM; nwg = nM * nN; G = G_; c = c_; }
    __host__ __device__ bool next(int i, Unit& u) const {
        const long L = (long)i * G + c; if (L >= nwg) return false;
        int wgid = (int)L; { const int q = nwg / NXCD, r = nwg % NXCD, xcd = wgid % NXCD, off = wgid / NXCD; wgid = (xcd < r ? xcd * (q + 1) : r * (q + 1) + (xcd - r) * q) + off; }
        const int nig = WGM * nN, gid = wgid / nig, fm = gid * WGM, gsz = (nM - fm) < WGM ? (nM - fm) : WGM;
        u.pm = fm + ((wgid % nig) % gsz); u.pn = (wgid % nig) / gsz; return true;
    }
    __device__ __forceinline__ void a_ready(const Unit&) const {}
    __device__ __forceinline__ void done(const Unit&) const {}
};

__device__ __forceinline__ unsigned cvt_pk_bf16(float lo, float hi) { unsigned r; asm volatile("v_cvt_pk_bf16_f32 %0, %1, %2" : "=v"(r) : "v"(lo), "v"(hi)); return r; }
typedef float f32x2 __attribute__((ext_vector_type(2)));
__device__ __forceinline__ f32x2 gelu_pk(f32x2 v) {
    const f32x2 av = __builtin_elementwise_abs(v), d = av * 0.2316418882f + 1.0f;
    f32x2 t; t.x = __builtin_amdgcn_rcpf(d.x); t.y = __builtin_amdgcn_rcpf(d.y);
    f32x2 q = t * 0.5307027145f + (-0.7265760135f); q = q * t + 0.7107068705f; q = q * t + (-0.142248368f); q = q * t + 0.127414796f; q = q * t;
    const f32x2 s = (v * v) * (-0.72134752044f);
    f32x2 e; e.x = __builtin_amdgcn_exp2f(s.x); e.y = __builtin_amdgcn_exp2f(s.y);
    const f32x2 m = v * (q * e), r = v - m;
    f32x2 o; o.x = v.x < 0.f ? m.x : r.x; o.y = v.y < 0.f ? m.y : r.y; return o;
}

template <int ACT  > struct EpiBf16 {
    static constexpr bool PERM = true, AFTER_DRAIN = false; static_assert(ACT == 0 || ACT == 1 || ACT == 2, "EpiBf16: ACT is 0 (none), 1 (gelu_pk) or 2 (relu squared)");
    bf16_t* O; int ldc; const float* bias; int split_cols; size_t split_stride; float scale0; const float* rowss = nullptr; int bstride = 0;
    __device__ __forceinline__ void operator()(const f32x4 (&acc)[2][2][4][2], const Unit& u, int wr, int wc, int fr, int fq) const {
        const int row0 = u.pm * BM + wr * 64 + fr; int colt = u.pn * BM; bf16_t* base = O;
        float sc = 1.f; if (split_cols) { const int t = colt / split_cols; base += (size_t)t * split_stride; colt -= t * split_cols; if (t == 0) sc = scale0; }
        const int col0 = colt + wc * 32 + 8 * fq, bcol0 = u.pn * BM + wc * 32 + 8 * fq;
        const float* bias = this->bias ? this->bias + (size_t)(u.pm >> 5) * bstride : nullptr;
        f32x4 bv[2][2];
#pragma unroll
        for (int bj = 0; bj < 2; ++bj)
#pragma unroll
            for (int n = 0; n < 2; ++n) bv[bj][n] = bias ? *(const f32x4*)(bias + bcol0 + bj * HALF + 4 * n) : (f32x4){0.f, 0.f, 0.f, 0.f};
#pragma unroll
        for (int ai = 0; ai < 2; ++ai)
#pragma unroll
            for (int m = 0; m < 4; ++m) { bf16_t* rowp = base + (size_t)(row0 + ai * HALF + m * 16) * ldc + col0;
                const float rs = rowss ? __builtin_amdgcn_rsqf(rowss[row0 + ai * HALF + m * 16] * (1.0f / 1024.0f) + 1e-6f) : 1.0f;
#pragma unroll
                for (int bj = 0; bj < 2; ++bj) { f32x4 v0 = acc[ai][bj][m][0] * rs + bv[bj][0], v1 = acc[ai][bj][m][1] * rs + bv[bj][1];
                    if (ACT == 1) { f32x2 a = gelu_pk((f32x2){v0[0], v0[1]}), b = gelu_pk((f32x2){v0[2], v0[3]}), c = gelu_pk((f32x2){v1[0], v1[1]}), d = gelu_pk((f32x2){v1[2], v1[3]});
                        v0 = (f32x4){a.x, a.y, b.x, b.y}; v1 = (f32x4){c.x, c.y, d.x, d.y}; }
                    if (ACT == 2) { v0 = __builtin_elementwise_max(v0, (f32x4){0.f, 0.f, 0.f, 0.f}); v1 = __builtin_elementwise_max(v1, (f32x4){0.f, 0.f, 0.f, 0.f}); v0 = v0 * v0; v1 = v1 * v1; }
                    v0 = v0 * sc; v1 = v1 * sc; u32x4 w; w.x = cvt_pk_bf16(v0[0], v0[1]); w.y = cvt_pk_bf16(v0[2], v0[3]); w.z = cvt_pk_bf16(v1[0], v1[1]); w.w = cvt_pk_bf16(v1[2], v1[3]);
                    *(u32x4*)(rowp + bj * HALF) = w; } }
    }
};
template <class Epi, class Sched, bool ALIGN_EPI = false, bool SP2 = false>
__device__ __forceinline__ void gemm_phase(PG8_LAS unsigned char* lds, const Gemm g, const Sched& S, const Epi& E) {
    const int tid = opaque_tid(), wid = __builtin_amdgcn_readfirstlane(tid >> 6), lane = tid & 63, wr = wid >> 2, wc = wid & 3, fr = lane & 15, fq = lane >> 4;
    const int K = g.K, nt = K / BK;
    unsigned voffA[2], voffB[2];
#pragma unroll
    for (int i = 0; i < 2; ++i) { int R, C; stage_rc(tid * 16 + i * 8192, R, C); const int Rb = Epi::PERM ? ((R & ~31) + perm32(R & 31)) : R;
        voffA[i] = (unsigned)(R * K + C) * 2u; voffB[i] = (unsigned)(Rb * K + C) * 2u; }
    const size_t kstep = (size_t)(BK * 2);
    const size_t hstep = (size_t)HALF * K * 2;
    const size_t tstep = 2 * hstep;
    const unsigned ldsw = (unsigned)wid * 1024u;
    const int aoff = lds_byte(wr * 64 + fr, fq * 8), boff = lds_byte(wc * 32 + fr, fq * 8);
#define PG8_SA(b, h) (((b) * 2 + (h)) * HTB)
#define PG8_SB(b, h) ((4 + (b) * 2 + (h)) * HTB)
#define PG8_STAGE(bufoff, gbase, voff) do { _Pragma("unroll") for (int _i = 0; _i < 2; ++_i) \
        __builtin_amdgcn_global_load_lds((const unsigned*)((const char*)(gbase) + (voff)[_i]), (PG8_LAS unsigned*)(lds + (bufoff) + ldsw + _i * 8192), 16, 0, 0); } while (0)
#define PG8_LDA(dst, b, h) do { _Pragma("unroll") for (int m = 0; m < 4; ++m) _Pragma("unroll") for (int k = 0; k < 2; ++k) dst[m][k] = *(const PG8_LAS bf16x8*)(lds + PG8_SA(b, h) + aoff + m * 2048 + k * 1024); } while (0)
#define PG8_LDB(dst, b, h) do { _Pragma("unroll") for (int n = 0; n < 2; ++n) _Pragma("unroll") for (int k = 0; k < 2; ++k) dst[n][k] = *(const PG8_LAS bf16x8*)(lds + PG8_SB(b, h) + boff + n * 2048 + k * 1024); } while (0)
#define PG8_MMA(ai, bj, At, Bt) do { __builtin_amdgcn_s_setprio(1); _Pragma("unroll") for (int m = 0; m < 4; ++m) _Pragma("unroll") for (int n = 0; n < 2; ++n) _Pragma("unroll") for (int k = 0; k < 2; ++k) \
        acc[ai][bj][m][n] = __builtin_amdgcn_mfma_f32_16x16x32_bf16(Bt[n][k], At[m][k], acc[ai][bj][m][n], 0, 0, 0); __builtin_amdgcn_s_setprio(0); } while (0)
#define PG8_WAIT_V(n) asm volatile("s_waitcnt vmcnt(" #n ")" ::: "memory")
#define PG8_WAIT_L(n) asm volatile("s_waitcnt lgkmcnt(" #n ")" ::: "memory")
#define PG8_BAR __builtin_amdgcn_s_barrier()
#define PG8_SCHED __builtin_amdgcn_sched_barrier(0)
    Unit cur, nxt; int ui = 0;
    if (!S.next(0, cur)) return;
    f32x4 acc[2][2][4][2];
#pragma unroll
    for (int a = 0; a < 2; ++a)
#pragma unroll
        for (int b = 0; b < 2; ++b)
#pragma unroll
            for (int m = 0; m < 4; ++m)
#pragma unroll
                for (int n = 0; n < 2; ++n) acc[a][b][m][n] = (f32x4){0.f, 0.f, 0.f, 0.f};
    bf16x8 At[4][2], B0[2][2], B1[2][2];
    const char* cA = (const char*)g.A + (size_t)cur.pm * tstep; const char* cB = (const char*)g.Bt + (size_t)cur.pn * tstep;
    S.a_ready(cur);
    if constexpr (SP2) {
        PG8_STAGE(PG8_SB(0, 0), cB, voffB); PG8_STAGE(PG8_SB(0, 1), cB + hstep, voffB); PG8_STAGE(PG8_SA(0, 0), cA, voffA); PG8_STAGE(PG8_SA(0, 1), cA + hstep, voffA);
        if (wr == 1) PG8_BAR;
        PG8_WAIT_V(2); PG8_BAR;
        PG8_STAGE(PG8_SB(1, 0), cB + kstep, voffB); PG8_STAGE(PG8_SA(1, 0), cA + kstep, voffA); PG8_STAGE(PG8_SB(1, 1), cB + hstep + kstep, voffB);
        PG8_WAIT_V(6); PG8_BAR;
    } else {
        PG8_STAGE(PG8_SB(0, 0), cB, voffB); PG8_STAGE(PG8_SA(0, 0), cA, voffA); PG8_STAGE(PG8_SB(0, 1), cB + hstep, voffB); PG8_STAGE(PG8_SA(0, 1), cA + hstep, voffA);
        if (wr == 1) PG8_BAR;
        PG8_WAIT_V(4); PG8_BAR;
        PG8_STAGE(PG8_SB(1, 0), cB + kstep, voffB); PG8_STAGE(PG8_SA(1, 0), cA + kstep, voffA); PG8_STAGE(PG8_SB(1, 1), cB + hstep + kstep, voffB);
        PG8_WAIT_V(6); PG8_BAR;
    }
    for (;;) {
        const bool has_next = S.next(ui + 1, nxt);
        const char* nA = has_next ? (const char*)g.A + (size_t)nxt.pm * tstep : cA; const char* nB = has_next ? (const char*)g.Bt + (size_t)nxt.pn * tstep : cB;
        for (int t = 0; t < nt; t += 2) {
            const bool last = (t == nt - 2);
            const char* a1 = cA + (size_t)(t + 1) * kstep;
            const char* a2 = last ? nA : cA + (size_t)(t + 2) * kstep; const char* b2 = last ? nB : cB + (size_t)(t + 2) * kstep;
            const char* a3 = a2 + kstep; const char* b3 = b2 + kstep;
            if (last && has_next) S.a_ready(nxt);
            if constexpr (SP2) {
            PG8_LDB(B0, 0, 0); PG8_LDB(B1, 0, 1); PG8_SCHED; PG8_LDA(At, 0, 0); PG8_STAGE(PG8_SA(1, 1), a1 + hstep, voffA);
            PG8_WAIT_V(8); PG8_WAIT_L(0); PG8_BAR; PG8_MMA(0, 0, At, B0); PG8_MMA(0, 1, At, B1); PG8_BAR; PG8_SCHED;
            PG8_LDA(At, 0, 1); PG8_STAGE(PG8_SB(0, 0), b2, voffB); PG8_STAGE(PG8_SB(0, 1), b2 + hstep, voffB); PG8_STAGE(PG8_SA(0, 0), a2, voffA);
            PG8_WAIT_V(8); PG8_WAIT_L(0); PG8_BAR; PG8_MMA(1, 0, At, B0); PG8_MMA(1, 1, At, B1); PG8_BAR; PG8_SCHED;
            PG8_LDB(B0, 1, 0); PG8_LDB(B1, 1, 1); PG8_SCHED; PG8_LDA(At, 1, 0); PG8_STAGE(PG8_SA(0, 1), a2 + hstep, voffA);
            PG8_WAIT_V(8); PG8_WAIT_L(0); PG8_BAR; PG8_MMA(0, 0, At, B0); PG8_MMA(0, 1, At, B1); PG8_BAR; PG8_SCHED;
            PG8_LDA(At, 1, 1); PG8_STAGE(PG8_SB(1, 0), b3, voffB); PG8_STAGE(PG8_SB(1, 1), b3 + hstep, voffB); PG8_STAGE(PG8_SA(1, 0), a3, voffA);
            PG8_WAIT_V(8); PG8_WAIT_L(0); PG8_BAR; PG8_MMA(1, 0, At, B0); PG8_MMA(1, 1, At, B1); PG8_BAR; PG8_SCHED;
            } else {
            PG8_LDB(B0, 0, 0); PG8_SCHED; PG8_LDA(At, 0, 0); PG8_STAGE(PG8_SA(1, 1), a1 + hstep, voffA);
            PG8_WAIT_L(8); PG8_BAR; PG8_WAIT_L(0); PG8_MMA(0, 0, At, B0); PG8_BAR; PG8_SCHED;
            PG8_LDB(B1, 0, 1); PG8_STAGE(PG8_SB(0, 0), b2, voffB);
            PG8_BAR; PG8_WAIT_L(0); PG8_MMA(0, 1, At, B1); PG8_BAR;
            PG8_LDA(At, 0, 1); PG8_STAGE(PG8_SA(0, 0), a2, voffA);
            PG8_BAR; PG8_WAIT_L(0); PG8_MMA(1, 0, At, B0); PG8_BAR; PG8_SCHED;
            PG8_STAGE(PG8_SB(0, 1), b2 + hstep, voffB);
            PG8_WAIT_V(6); PG8_BAR; PG8_MMA(1, 1, At, B1); PG8_BAR;
            PG8_LDB(B0, 1, 0); PG8_SCHED; PG8_LDA(At, 1, 0); PG8_STAGE(PG8_SA(0, 1), a2 + hstep, voffA);
            PG8_WAIT_L(8); PG8_BAR; PG8_WAIT_L(0); PG8_MMA(0, 0, At, B0); PG8_BAR; PG8_SCHED;
            PG8_LDB(B1, 1, 1); PG8_STAGE(PG8_SB(1, 0), b3, voffB);
            PG8_BAR; PG8_WAIT_L(0); PG8_MMA(0, 1, At, B1); PG8_BAR;
            PG8_LDA(At, 1, 1); PG8_STAGE(PG8_SA(1, 0), a3, voffA);
            PG8_BAR; PG8_WAIT_L(0); PG8_MMA(1, 0, At, B0); PG8_BAR; PG8_SCHED;
            PG8_STAGE(PG8_SB(1, 1), b3 + hstep, voffB);
            PG8_WAIT_V(6); PG8_BAR; PG8_MMA(1, 1, At, B1); PG8_BAR;
            }
        }
        if constexpr (ALIGN_EPI) { if (wr == 0) PG8_BAR; }
        if constexpr (!Epi::AFTER_DRAIN) { E(acc, cur, wr, wc, fr, fq); S.done(cur); }
        if (!has_next) break;
#pragma unroll
        for (int a = 0; a < 2; ++a)
#pragma unroll
            for (int b = 0; b < 2; ++b)
#pragma unroll
                for (int m = 0; m < 4; ++m)
#pragma unroll
                    for (int n = 0; n < 2; ++n) acc[a][b][m][n] = (f32x4){0.f, 0.f, 0.f, 0.f};
        cur = nxt; cA = nA; cB = nB; ++ui;
        if constexpr (ALIGN_EPI) { if (wr == 1) PG8_BAR; }
    }
    PG8_WAIT_V(0);
    if constexpr (!ALIGN_EPI) { if (wr == 0) PG8_BAR; }
    PG8_BAR;
    if constexpr (Epi::AFTER_DRAIN) { E.fused(acc, cur, wr, wc, fr, fq, lds, wid, lane); S.done(cur); }
#undef PG8_SA
#undef PG8_SB
#undef PG8_STAGE
#undef PG8_LDA
#undef PG8_LDB
#undef PG8_MMA
#undef PG8_WAIT_V
#undef PG8_WAIT_L
#undef PG8_BAR
#undef PG8_SCHED
}
typedef unsigned u32x2 __attribute__((ext_vector_type(2)));
constexpr float RMS_EPS_F = 1e-6f;
struct EpiResGate {
    static constexpr bool PERM = true, AFTER_DRAIN = false;
    const float* xin; float* xout; const float* gate;
    bf16_t* anext; const float* scale_next; float* rss_next;
    __device__ __forceinline__ void operator()(const f32x4 (&acc)[2][2][4][2], const Unit& u, int wr_, int wc_, int fr_, int fq_) const {
        int tx = threadIdx.x; asm volatile("" : "+v"(tx));
        const int fr = tx & 15, fq = (tx >> 4) & 3, wc = (tx >> 6) & 3, wr = tx >> 8;
        const int b = u.pm >> 5;
        const int col0 = u.pn * BM + wc * 32 + 8 * fq;
        const float* gp = gate + (size_t)b * 6144 + col0;
        f32x4 gv[2][2], sv[2][2];
#pragma unroll
        for (int bj = 0; bj < 2; ++bj)
#pragma unroll
            for (int n = 0; n < 2; ++n) { gv[bj][n] = *(const f32x4*)(gp + bj * HALF + n * 4);
                sv[bj][n] = anext ? *(const f32x4*)(scale_next + (size_t)b * 6144 + col0 + bj * HALF + n * 4) + 1.0f : (f32x4){0.f, 0.f, 0.f, 0.f}; }
#pragma unroll
        for (int ai = 0; ai < 2; ++ai)
#pragma unroll
            for (int m = 0; m < 4; ++m) { int row = u.pm * BM + ai * HALF + wr * 64 + m * 16 + fr; asm volatile("" : "+v"(row));
                const size_t off = (size_t)row * 1024 + col0; float ss = 0.f;
#pragma unroll
                for (int bj = 0; bj < 2; ++bj) { u32x4 w;
#pragma unroll
                    for (int n = 0; n < 2; ++n) { const f32x4 xi = *(const f32x4*)(xin + off + bj * HALF + n * 4);
                        const f32x4 xn = xi + gv[bj][n] * acc[ai][bj][m][n];
                        *(f32x4*)(xout + off + bj * HALF + n * 4) = xn;
                        if (anext) { ss += (xn[0] * xn[0] + xn[1] * xn[1]) + (xn[2] * xn[2] + xn[3] * xn[3]);
                            const f32x4 an = xn * sv[bj][n]; w[2 * n] = cvt_pk_bf16(an[0], an[1]); w[2 * n + 1] = cvt_pk_bf16(an[2], an[3]); } }
                    if (anext) *(u32x4*)(anext + off + bj * HALF) = w; }
                if (anext) { ss += __shfl_xor(ss, 16); ss += __shfl_xor(ss, 32); if (fq == 0) atomicAdd(rss_next + row, ss); }
                asm volatile("" ::: "memory"); }
    }
};
struct EpiQN {
    static constexpr bool PERM = true, AFTER_DRAIN = false;
    bf16_t* Q; const float* gn_nope; PG8_LAS float* P;
    __device__ __forceinline__ void operator()(const f32x4 (&acc)[2][2][4][2], const Unit& u, int wr_, int wc_, int fr_, int fq_) const {
        int tx = threadIdx.x; asm volatile("" : "+v"(tx));
        const int fr = tx & 15, fq = (tx >> 4) & 3, wc = (tx >> 6) & 3, wr = tx >> 8;
        const int b = u.pm >> 5, s0 = (u.pm & 31) * BM;
#pragma unroll
            for (int ai = 0; ai < 2; ++ai)
#pragma unroll
                for (int m = 0; m < 4; ++m)
#pragma unroll
                    for (int bj = 0; bj < 2; ++bj) { float s = 0.f;
#pragma unroll
                        for (int n = 0; n < 2; ++n) { const f32x4 x = acc[ai][bj][m][n]; s += (x[0] * x[0] + x[1] * x[1]) + (x[2] * x[2] + x[3] * x[3]); }
                        s += __shfl_xor(s, 16); s += __shfl_xor(s, 32);
                        if (fq == 0) P[((ai * HALF + wr * 64 + m * 16 + fr) * 2 + bj) * 4 + wc] = s; }
            asm volatile("s_waitcnt lgkmcnt(0)" ::: "memory"); __builtin_amdgcn_s_barrier(); asm volatile("" ::: "memory");
#pragma unroll
            for (int ai = 0; ai < 2; ++ai)
#pragma unroll
                for (int m = 0; m < 4; ++m) { int rl = ai * HALF + wr * 64 + m * 16 + fr; asm volatile("" : "+v"(rl));
#pragma unroll
                    for (int bj = 0; bj < 2; ++bj) { const f32x4 pp = *(const PG8_LAS f32x4*)(P + (rl * 2 + bj) * 4);
                        const float rr = 1.0f / sqrtf(((pp[0] + pp[1]) + (pp[2] + pp[3])) * (1.0f / 128.0f) + RMS_EPS_F);
                        const int head = 2 * u.pn + bj;
                        const unsigned qoff = (unsigned)(((b * 4 + head) * 8192 + s0 + rl) * 192 + wc * 32 + 8 * fq); u32x4 w;
#pragma unroll
                        for (int n = 0; n < 2; ++n) { const f32x4 g = *(const f32x4*)(gn_nope + wc * 32 + 8 * fq + 4 * n);
                            const f32x4 v = acc[ai][bj][m][n] * rr * g; w[2 * n] = cvt_pk_bf16(v[0], v[1]); w[2 * n + 1] = cvt_pk_bf16(v[2], v[3]); }
                        *(u32x4*)(Q + qoff) = w; }
                    asm volatile("" ::: "memory"); }
    }
};
struct EpiQR {
    static constexpr bool PERM = true, AFTER_DRAIN = false;
    bf16_t* Q; const float* gn_rope; const float* cosT; const float* sinT;
    __device__ __forceinline__ void operator()(const f32x4 (&acc)[2][2][4][2], const Unit& u, int wr_, int wc_, int fr_, int fq_) const {
        int tx = threadIdx.x; asm volatile("" : "+v"(tx));
        const int fr = tx & 15, fq = (tx >> 4) & 3, wc = (tx >> 6) & 3, wr = tx >> 8;
        const int b = u.pm >> 5, s0 = (u.pm & 31) * BM;
#pragma unroll
            for (int ai = 0; ai < 2; ++ai)
#pragma unroll
                for (int m = 0; m < 4; ++m) { int rl = ai * HALF + wr * 64 + m * 16 + fr; asm volatile("" : "+v"(rl)); float s = 0.f;
#pragma unroll
                    for (int bj = 0; bj < 2; ++bj)
#pragma unroll
                        for (int n = 0; n < 2; ++n) { const f32x4 x = acc[ai][bj][m][n]; s += (x[0] * x[0] + x[1] * x[1]) + (x[2] * x[2] + x[3] * x[3]); }
                    s += __shfl_xor(s, 16); s += __shfl_xor(s, 32);
                    const float rr = 1.0f / sqrtf(s * (1.0f / 64.0f) + RMS_EPS_F);
                    const size_t t = (size_t)u.pm * BM + rl;
                    bf16_t* qrow = Q + ((size_t)(b * 4 + wc) * 8192 + s0 + rl) * 192 + 128;
                    u32x4 wa, wb;
#pragma unroll
                    for (int n = 0; n < 2; ++n) { const int j0 = 8 * fq + 4 * n;
                        const f32x4 c4 = *(const f32x4*)(cosT + t * 32 + j0), s4 = *(const f32x4*)(sinT + t * 32 + j0);
                        const f32x4 g1 = *(const f32x4*)(gn_rope + j0), g2 = *(const f32x4*)(gn_rope + 32 + j0);
                        const f32x4 y1 = acc[ai][0][m][n] * rr * g1, y2 = acc[ai][1][m][n] * rr * g2;
                        const f32x4 o1 = y1 * c4 - y2 * s4, o2 = y2 * c4 + y1 * s4;
                        wa[2 * n] = cvt_pk_bf16(o1[0], o1[1]); wa[2 * n + 1] = cvt_pk_bf16(o1[2], o1[3]); wb[2 * n] = cvt_pk_bf16(o2[0], o2[1]); wb[2 * n + 1] = cvt_pk_bf16(o2[2], o2[3]); }
                    *(u32x4*)(qrow + 8 * fq) = wa; *(u32x4*)(qrow + 32 + 8 * fq) = wb;
                    asm volatile("" ::: "memory"); }
    }
};
struct EpiKV {
    static constexpr bool PERM = true, AFTER_DRAIN = false;
    bf16_t* Kb; bf16_t* Vb; const float* gn_k; PG8_LAS float* P;
    __device__ __forceinline__ void operator()(const f32x4 (&acc)[2][2][4][2], const Unit& u, int wr_, int wc_, int fr_, int fq_) const {
        int tx = threadIdx.x; asm volatile("" : "+v"(tx));
        const int fr = tx & 15, fq = (tx >> 4) & 3, wc = (tx >> 6) & 3, wr = tx >> 8;
        const int b = u.pm >> 5, s0 = (u.pm & 31) * BM;
#pragma unroll
        for (int ai = 0; ai < 2; ++ai)
#pragma unroll
            for (int m = 0; m < 4; ++m) { float s = 0.f;
#pragma unroll
                for (int n = 0; n < 2; ++n) { const f32x4 x = acc[ai][0][m][n]; s += (x[0] * x[0] + x[1] * x[1]) + (x[2] * x[2] + x[3] * x[3]); }
                s += __shfl_xor(s, 16); s += __shfl_xor(s, 32);
                if (fq == 0) P[(ai * HALF + wr * 64 + m * 16 + fr) * 4 + wc] = s; }
        asm volatile("s_waitcnt lgkmcnt(0)" ::: "memory"); __builtin_amdgcn_s_barrier(); asm volatile("" ::: "memory");
#pragma unroll
        for (int ai = 0; ai < 2; ++ai)
#pragma unroll
            for (int m = 0; m < 4; ++m) { int rl = ai * HALF + wr * 64 + m * 16 + fr; asm volatile("" : "+v"(rl));
                const f32x4 pp = *(const PG8_LAS f32x4*)(P + rl * 4);
                const float rr = 1.0f / sqrtf(((pp[0] + pp[1]) + (pp[2] + pp[3])) * (1.0f / 128.0f) + RMS_EPS_F);
                const size_t tok = (size_t)(b * 4 + u.pn) * 8192 + s0 + rl;
                bf16_t* krow = Kb + tok * 192; bf16_t* vrow = Vb + tok * 128;
                u32x4 w1, w2;
#pragma unroll
                for (int n = 0; n < 2; ++n) { const f32x4 g = *(const f32x4*)(gn_k + wc * 32 + 8 * fq + 4 * n);
                    const f32x4 kx = acc[ai][0][m][n] * rr * g, vx = acc[ai][1][m][n];
                    w1[2 * n] = cvt_pk_bf16(kx[0], kx[1]); w1[2 * n + 1] = cvt_pk_bf16(kx[2], kx[3]); w2[2 * n] = cvt_pk_bf16(vx[0], vx[1]); w2[2 * n + 1] = cvt_pk_bf16(vx[2], vx[3]); }
                *(u32x4*)(krow + wc * 32 + 8 * fq) = w1; *(u32x4*)(vrow + wc * 32 + 8 * fq) = w2;
                asm volatile("" ::: "memory"); }
    }
};
}
namespace att {
using bf16 = __hip_bfloat16;
typedef short bf16x8 __attribute__((ext_vector_type(8)));
typedef short s16x4 __attribute__((ext_vector_type(4)));
typedef float f32x16 __attribute__((ext_vector_type(16)));
typedef float f32x4 __attribute__((ext_vector_type(4)));
typedef unsigned u32x4 __attribute__((ext_vector_type(4)));
constexpr int DQ = 192, DV = 128, LDO = 1024, SEQL = 8192;
constexpr float SCALE = 0.07216878364870322f;
constexpr float THR = 8.f;
constexpr int NW = 8, QBLK = 32, KVBLK = 64, QB = NW * QBLK;
constexpr int SHM_V = KVBLK * DV * 2, SHM_K = KVBLK * DQ * 2;
constexpr int KPITCH = DQ * 2;
constexpr int NSLOT = 3;
constexpr int LDS_WS = NSLOT * (SHM_V + SHM_K), LDS_QP = LDS_WS + NW * 64 * 4, LDS_NEED = LDS_QP + NW * 4096;
#define KS3(row) ((((row) >> 1) & 3) | ((((row) >> 4) & 1) << 2))
#define KSWZ(row, colB) ((row) * 384 + ((colB) ^ (KS3(row) << 4)))
#define SBAR() __builtin_amdgcn_sched_barrier(0)
__device__ __forceinline__ int v_st(int k, int c) { const int kk = (k & ~0xC) | ((k & 4) << 1) | ((k & 8) >> 1); return ((kk >> 3) * 4 + (c >> 5)) * 512 + ((kk & 7) * 32 + (c & 31)) * 2; }
__device__ __forceinline__ int v_rd_base(int lane) { return ((lane & 3) << 3) | (((lane >> 2) & 3) << 6) | (((lane >> 4) & 1) << 5) | (((lane >> 5) & 1) << 8); }
constexpr int v_rd_off(int d0, int ks, int half) { return d0 * 512 + ks * 4096 + half * 2048; }
__device__ __forceinline__ int crow(int r, int hi) { return (r & 3) + 8 * (r >> 2) + 4 * hi; }
__device__ __forceinline__ unsigned cvtpk(float lo, float hi) { unsigned r; asm volatile("v_cvt_pk_bf16_f32 %0, %1, %2" : "=v"(r) : "v"(lo), "v"(hi)); return r; }
__device__ __forceinline__ bf16x8 load8(const bf16* p) { return *reinterpret_cast<const bf16x8*>(p); }
__device__ __forceinline__ void mask_tile(f32x16& p0, f32x16& p1, int dq) {
    const float NEG = -__builtin_inff();
#pragma unroll
    for (int r = 0; r < 16; ++r) {
        const int c = (r & 3) + 8 * (r >> 2);
        if (dq - c < 0) p0[r] = NEG;
        if (dq - c - 32 < 0) p1[r] = NEG;
    }
}
__device__ __forceinline__ void partialSM(f32x16& p0, f32x16& p1, float& m_reg, float& mn, float& alpha) {
    float pmax = p0[0]; for (int r = 1; r < 16; ++r) pmax = fmaxf(pmax, p0[r]); for (int r = 0; r < 16; ++r) pmax = fmaxf(pmax, p1[r]);
    { auto rr = __builtin_amdgcn_permlane32_swap(__float_as_uint(pmax), __float_as_uint(pmax), false, false);
      pmax = fmaxf(__uint_as_float(rr[0]), __uint_as_float(rr[1])); }
    constexpr float C2 = 1.4426950408889634f * SCALE;
    if (__builtin_expect(__all((pmax - m_reg) * SCALE <= THR), 1)) { mn = m_reg; alpha = 1.f; }
    else { mn = fmaxf(m_reg, pmax); alpha = __builtin_amdgcn_exp2f((m_reg - mn) * C2); m_reg = mn; }
    const float mnL = -mn * C2;
    for (int r = 0; r < 16; ++r) p0[r] = fmaf(p0[r], C2, mnL); for (int r = 0; r < 16; ++r) p1[r] = fmaf(p1[r], C2, mnL);
    for (int r = 0; r < 16; ++r) p0[r] = __builtin_amdgcn_exp2f(p0[r]);
}
__device__ __forceinline__ void finishSM(f32x16& p0, f32x16& p1, float alpha, float& l_reg, bf16x8& pa0, bf16x8& pa1, bf16x8& pa2, bf16x8& pa3) {
    for (int r = 0; r < 16; ++r) p1[r] = __builtin_amdgcn_exp2f(p1[r]);
    float ps = 0; for (int r = 0; r < 16; ++r) ps += p0[r]; for (int r = 0; r < 16; ++r) ps += p1[r];
    { auto rr = __builtin_amdgcn_permlane32_swap(__float_as_uint(ps), __float_as_uint(ps), false, false);
      ps = __uint_as_float(rr[0]) + __uint_as_float(rr[1]); }
    l_reg = l_reg * alpha + ps;
#define PK4(P, B_, OUT) do { unsigned a0 = cvtpk(P[B_+0], P[B_+1]), a1 = cvtpk(P[B_+2], P[B_+3]);                          \
        unsigned b0 = cvtpk(P[B_+4], P[B_+5]), b1 = cvtpk(P[B_+6], P[B_+7]);                                             \
        auto r0 = __builtin_amdgcn_permlane32_swap(a0, b0, false, false); auto r1 = __builtin_amdgcn_permlane32_swap(a1, b1, false, false); \
        u32x4 w = {r0[0], r1[0], r0[1], r1[1]}; OUT = *reinterpret_cast<bf16x8*>(&w); } while (0)
    PK4(p0, 0, pa0); PK4(p0, 8, pa1); PK4(p1, 0, pa2); PK4(p1, 8, pa3);
#undef PK4
}
__device__ __forceinline__ void glds16(const void* gsrc, unsigned lds_dst) { unsigned keep;
    asm volatile("s_mov_b32 %0, m0\n\ts_mov_b32 m0, %2\n\ts_nop 0\n\tglobal_load_lds_dwordx4 %1, off\n\ts_mov_b32 m0, %0" : "=&s"(keep) : "v"(gsrc), "s"(lds_dst) : "memory"); }
#define KRD(dst, a, off) asm volatile("ds_read_b128 %0, %1 offset:%2" : "=&v"(dst) : "v"(a), "i"(off) : "memory")
#define KWAIT(n, x, y) asm volatile("s_waitcnt lgkmcnt(" #n ")" : "+v"(x), "+v"(y) :: "memory")
__device__ __forceinline__ void qkt(f32x16& p0, f32x16& p1, unsigned kslot, int r32, int hi, const bf16x8* qr) {
    unsigned ka[4];
#pragma unroll
    for (int dd = 0; dd < 4; ++dd) ka[dd] = kslot + KSWZ(r32, (dd * 16 + hi * 8) * 2);
    bf16x8 a0, a1, b0, b1, c0, c1;
    p0 = f32x16{}; p1 = f32x16{};
#define ISSUE(X, d0) do { KRD(X##0, ka[(d0) & 3], ((d0) >> 2) * 128); KRD(X##1, ka[(d0) & 3], ((d0) >> 2) * 128 + 32 * KPITCH); } while (0)
#define USE(X, d0, n) do { KWAIT(n, X##0, X##1); p0 = __builtin_amdgcn_mfma_f32_32x32x16_bf16(X##0, qr[d0], p0, 0, 0, 0); p1 = __builtin_amdgcn_mfma_f32_32x32x16_bf16(X##1, qr[d0], p1, 0, 0, 0); } while (0)
    ISSUE(a, 0); ISSUE(b, 1); ISSUE(c, 2);
    USE(a, 0, 4); ISSUE(a, 3); USE(b, 1, 4); ISSUE(b, 4); USE(c, 2, 4); ISSUE(c, 5);
    USE(a, 3, 4); ISSUE(a, 6); USE(b, 4, 4); ISSUE(b, 7); USE(c, 5, 4); ISSUE(c, 8);
    USE(a, 6, 4); ISSUE(a, 9); USE(b, 7, 4); ISSUE(b, 10); USE(c, 8, 4); ISSUE(c, 11);
    USE(a, 9, 4); USE(b, 10, 2); USE(c, 11, 0);
#undef ISSUE
#undef USE
}
#undef KRD
#undef KWAIT
__device__ __forceinline__ void pv_tile(f32x16* o, int vb, bf16x8 pa0, bf16x8 pa1, bf16x8 pa2, bf16x8 pa3) {
#define TRRD(dst, off) asm volatile("ds_read_b64_tr_b16 %0, %1 offset:%2" : "=&v"(dst) : "v"(vb), "i"(off) : "memory")
#define RD8(S, d0) do { constexpr int b_ = v_rd_off(d0, 0, 0); TRRD(S##l0, b_); TRRD(S##h0, b_ + 2048); TRRD(S##l1, b_ + 4096); TRRD(S##h1, b_ + 6144); \
        TRRD(S##l2, b_ + 8192); TRRD(S##h2, b_ + 10240); TRRD(S##l3, b_ + 12288); TRRD(S##h3, b_ + 14336); } while (0)
#define MM4(S, d0) do {   \
        o[d0] = __builtin_amdgcn_mfma_f32_32x32x16_bf16(pa0, (bf16x8){S##l0[0], S##l0[1], S##l0[2], S##l0[3], S##h0[0], S##h0[1], S##h0[2], S##h0[3]}, o[d0], 0, 0, 0);   \
        o[d0] = __builtin_amdgcn_mfma_f32_32x32x16_bf16(pa1, (bf16x8){S##l1[0], S##l1[1], S##l1[2], S##l1[3], S##h1[0], S##h1[1], S##h1[2], S##h1[3]}, o[d0], 0, 0, 0);   \
        o[d0] = __builtin_amdgcn_mfma_f32_32x32x16_bf16(pa2, (bf16x8){S##l2[0], S##l2[1], S##l2[2], S##l2[3], S##h2[0], S##h2[1], S##h2[2], S##h2[3]}, o[d0], 0, 0, 0);   \
        o[d0] = __builtin_amdgcn_mfma_f32_32x32x16_bf16(pa3, (bf16x8){S##l3[0], S##l3[1], S##l3[2], S##l3[3], S##h3[0], S##h3[1], S##h3[2], S##h3[3]}, o[d0], 0, 0, 0); } while (0)
    s16x4 Al0, Al1, Al2, Al3, Ah0, Ah1, Ah2, Ah3, Bl0, Bl1, Bl2, Bl3, Bh0, Bh1, Bh2, Bh3;
    RD8(A, 0); RD8(B, 1);
    asm volatile("s_waitcnt lgkmcnt(8)" ::: "memory"); SBAR(); MM4(A, 0); SBAR();
    RD8(A, 2);
    asm volatile("s_waitcnt lgkmcnt(8)" ::: "memory"); SBAR(); MM4(B, 1); SBAR();
    RD8(B, 3);
    asm volatile("s_waitcnt lgkmcnt(8)" ::: "memory"); SBAR(); MM4(A, 2); SBAR();
    asm volatile("s_waitcnt lgkmcnt(0)" ::: "memory"); SBAR(); MM4(B, 3);
#undef MM4
#undef RD8
#undef TRRD
}
struct BlockRef { const bf16* Q; const bf16* K; const bf16* V; bf16* O; int P0; };
#define WAIT_BAR(N) asm volatile("s_waitcnt vmcnt(" #N ") lgkmcnt(0)\n\ts_barrier" ::: "memory")
__device__ __forceinline__ void attn_block(const BlockRef& cur, char* lds) {
    const int tid = opaque_tid(), wid = __builtin_amdgcn_readfirstlane(tid >> 6), lane = tid & 63, r32 = lane & 31, hi = lane >> 5;
    const int NT = cur.P0 / KVBLK + QB / KVBLK;
    const int qlo = cur.P0 + wid * QBLK, qm = qlo + r32 - 4 * hi;
    char* V_lds = lds; char* K_lds = lds + NSLOT * SHM_V;
    float* ws = (float*)(lds + LDS_WS) + wid * 64; float* li_l = ws, * al_l = ws + 32;
    float m_reg = -1e30f, l_reg = 0; f32x16 o[4] = {};
    const unsigned lds0 = (unsigned)(uintptr_t)lds;
    const int vb0 = (int)lds0 + v_rd_base(lane);
    unsigned kgo[3], vgo[2];
#pragma unroll
    for (int i = 0; i < 3; ++i) { const int ob = (wid * 3 + i) * 1024 + lane * 16, row = ob / 384, rem = ob % 384, g = rem >> 7, cp = (rem & 127) >> 4, c = cp ^ KS3(row);
        kgo[i] = (unsigned)(row * 384 + g * 128 + c * 16); }
#pragma unroll
    for (int i = 0; i < 2; ++i) { const int ob = (wid * 2 + i) * 1024 + lane * 16, st = ob >> 9, rem = ob & 511, kk = (st >> 2) * 8 + (rem >> 6), c = (st & 3) * 32 + ((rem & 63) >> 1);
        const int k = (kk & ~0xC) | ((kk & 4) << 1) | ((kk & 8) >> 1);
        vgo[i] = (unsigned)(k * 256 + c * 2); }
    const char* Kg = (const char*)cur.K; const char* Vg = (const char*)cur.V;
#define DMA_TILE(t, slot) do { const char* kt_ = Kg + (size_t)(t) * (KVBLK * DQ * 2); const char* vt_ = Vg + (size_t)(t) * (KVBLK * DV * 2);                       \
        const unsigned kd_ = lds0 + NSLOT * SHM_V + (slot) * SHM_K + wid * 3072, vd_ = lds0 + (slot) * SHM_V + wid * 2048;                                         \
        glds16(kt_ + kgo[0], (unsigned)__builtin_amdgcn_readfirstlane(kd_)); glds16(kt_ + kgo[1], (unsigned)__builtin_amdgcn_readfirstlane(kd_ + 1024));           \
        glds16(kt_ + kgo[2], (unsigned)__builtin_amdgcn_readfirstlane(kd_ + 2048));                                                                                \
        glds16(vt_ + vgo[0], (unsigned)__builtin_amdgcn_readfirstlane(vd_)); glds16(vt_ + vgo[1], (unsigned)__builtin_amdgcn_readfirstlane(vd_ + 1024)); } while (0)
    DMA_TILE(0, 0); DMA_TILE(1, 1);
    bf16x8 qr[12];
#pragma unroll
    for (int d0 = 0; d0 < 12; ++d0) qr[d0] = load8(cur.Q + (size_t)(wid * QBLK + r32) * DQ + d0 * 16 + hi * 8);
    WAIT_BAR(0);
    __builtin_amdgcn_s_waitcnt(0);
#pragma unroll
    for (int d0 = 0; d0 < 12; ++d0) asm volatile("" : "+v"(qr[d0]));
#define RESC(a) do { if (__any((a) < 1.f)) { if (hi == 0) al_l[r32] = (a); asm volatile("s_waitcnt lgkmcnt(0)" ::: "memory");              \
                     for (int d_ = 0; d_ < 4; ++d_) for (int r = 0; r < 16; ++r) o[d_][r] *= al_l[crow(r, hi)]; } } while (0)
#define KBASE(t) ((t) * KVBLK)
#define MASKT(P0_, P1_, t) do { const int kb_ = KBASE(t); if (kb_ + KVBLK - 1 > qlo) mask_tile(P0_, P1_, qm - kb_); } while (0)
    f32x16 p0, p1; float mn, al; bf16x8 pa0, pa1, pa2, pa3;
    int sl = 0, sl2 = 2;
    for (int t = 0; t < NT; ++t) {
        if (t + 2 < NT) DMA_TILE(t + 2, sl2);
        qkt(p0, p1, lds0 + NSLOT * SHM_V + sl * SHM_K, r32, hi, qr); SBAR();
        MASKT(p0, p1, t); partialSM(p0, p1, m_reg, mn, al);
        RESC(al);
        finishSM(p0, p1, al, l_reg, pa0, pa1, pa2, pa3); SBAR();
        pv_tile(o, vb0 + sl * SHM_V, pa0, pa1, pa2, pa3); SBAR();
        if (t + 2 < NT) WAIT_BAR(5); else WAIT_BAR(0);
        sl2 = sl; sl = (sl == NSLOT - 1) ? 0 : sl + 1;
    }
    if (hi == 0) li_l[r32] = l_reg; asm volatile("s_waitcnt lgkmcnt(0)" ::: "memory");
    float rli[16];
#pragma unroll
    for (int r = 0; r < 16; ++r) rli[r] = __builtin_amdgcn_rcpf(li_l[crow(r, hi)]);
    bf16* Ow = cur.O + (size_t)(wid * QBLK) * LDO;
#pragma unroll
    for (int r = 0; r < 16; ++r) { const int orow = crow(r, hi);
#pragma unroll
        for (int d0 = 0; d0 < 4; ++d0) { const float v = o[d0][r] * rli[r];
            const float vn = __shfl_xor(v, 1);
            if ((r32 & 1) == 0) *(unsigned*)(Ow + (size_t)orow * LDO + d0 * 32 + r32) = cvtpk(v, vn); } }
    WAIT_BAR(0);
#undef RESC
#undef KBASE
#undef MASKT
#undef DMA_TILE
}
#undef WAIT_BAR
struct Item { int bh, qb0, qb1; };
__device__ __forceinline__ Item decode(int L) { Item it; const int xcd = L & 7, k = L >> 3; it.bh = (k >> 4) * 8 + xcd; const int x = k & 15; it.qb0 = x; it.qb1 = 31 - x; return it; }
__device__ __forceinline__ BlockRef mkref(const Item& it, int pass, const bf16* Q, const bf16* K, const bf16* V, bf16* mixed) {
    const int qb = pass ? it.qb1 : it.qb0; BlockRef r;
    r.Q = Q + ((size_t)it.bh * SEQL + (size_t)qb * QB) * DQ; r.K = K + (size_t)it.bh * SEQL * DQ; r.V = V + (size_t)it.bh * SEQL * DV;
    r.O = mixed + ((size_t)(it.bh >> 2) * SEQL + (size_t)qb * QB) * LDO + 512 + (it.bh & 3) * 128; r.P0 = qb * QB;
    return r;
}
__device__ __forceinline__ void attn_phase(char* lds, const bf16* Q, const bf16* K, const bf16* V, bf16* mixed) {
    for (int L = blockIdx.x; L < 256; L += GRID) {
        const Item it = decode(L);
        attn_block(mkref(it, 0, Q, K, V, mixed), lds);
        attn_block(mkref(it, 1, Q, K, V, mixed), lds);
    }
}
#undef KSWZ
#undef KS3
#undef SBAR
}
namespace mk {
typedef unsigned short bf16_t;
typedef short bf16x8 __attribute__((ext_vector_type(8)));
typedef float f32x4 __attribute__((ext_vector_type(4)));
typedef float f32x2 __attribute__((ext_vector_type(2)));
typedef float f32x16 __attribute__((ext_vector_type(16)));
typedef unsigned u32x2 __attribute__((ext_vector_type(2)));
typedef unsigned u32x4 __attribute__((ext_vector_type(4)));
constexpr int NB = 4, SEQ = 8192, T = NB * SEQ, DM = 1024, DEPTH = 2, DFF = 4096, NIN = 2048, NMOD = 6 * DM;
constexpr float EPS = 1e-6f;
constexpr size_t MiB = 1u << 20;
constexpr size_t W_IN = 0, W_Q = 4 * MiB, W_KV = W_Q + 384 * 1024, W_O = W_KV + 256 * 1024, W_1 = W_O + 2 * MiB, W_2 = W_1 + 8 * MiB, W_LAYER = 23 * MiB;
static_assert(W_2 + 8 * MiB <= W_LAYER, "weights");
constexpr size_t WS_W = 0, WS_MOD = 46 * MiB, WS_COS = 47 * MiB, WS_SIN = 51 * MiB, WS_HN = 55 * MiB, WS_QN = 119 * MiB, WS_KVN = 135 * MiB,
                 WS_GST = 143 * MiB, WS_GDV = 207 * MiB, WS_R = 208 * MiB, WS_BT = 464 * MiB, WS_RSS = 496 * MiB, WS_BIAS = 497 * MiB, WS_END = 498 * MiB;
constexpr size_t WS_BAR = WS_MOD + 512 * 1024;
constexpr size_t R_PROJ = 0, R_Q = 128 * MiB, R_K = 176 * MiB, R_V = 224 * MiB;
constexpr int MISC_OFF = 157696;
constexpr int LDS_BYTES = MISC_OFF + 64;
constexpr int EPI_OFF = 131072;

__device__ __forceinline__ float bf2f(unsigned short v) { return __uint_as_float((unsigned)v << 16); }
typedef __bf16 hwbf16x2 __attribute__((ext_vector_type(2)));
__device__ __forceinline__ unsigned pk2(float lo, float hi) { const f32x2 v = {lo, hi}; return __builtin_bit_cast(unsigned, __builtin_convertvector(v, hwbf16x2)); }
__device__ __forceinline__ unsigned f2bf(float f) { return pk2(f, 0.f) & 0xffffu; }
__device__ __forceinline__ float wave_sum(float v) {
#pragma unroll
    for (int o = 1; o < 64; o <<= 1) v += __shfl_xor(v, o);
    return v;
}
__device__ __forceinline__ float half_sum32(float v) {
#pragma unroll
    for (int o = 1; o < 32; o <<= 1) v += __shfl_xor(v, o);
    return v;
}
__device__ __forceinline__ int crow(int r, int hi) { return (r & 3) + 8 * (r >> 2) + 4 * hi; }

__device__ __forceinline__ int src_col(int map, int n) {
    if (map == 1) { if (n < 1536) return n; if (n < 1984) return n + 16; if (n < 2000) return n - 1984 + 1536; return -1; }
    if (map == 2) { if (n < 512) return (n >> 7) * 192 + (n & 127); const int c = n - 512, bj = c >> 7, hd = (c & 127) >> 5, w = c & 31; return hd * 192 + 128 + 32 * bj + w; }
    return n;
}
__device__ __forceinline__ void transpose_item(const float* W, int K, int N, int NP, bf16_t* WT, int map, LAS float* scr, int item, int lane) {
    const int nblk = NP / 32, kb = item / nblk, nb = item % nblk, k0 = 64 * kb, n0 = 32 * nb;
    const int sc = src_col(map, n0 + (lane & 31));
    float tv[32];
#pragma unroll
    for (int i = 0; i < 32; ++i) { const int kk = 2 * i + (lane >> 5); tv[i] = sc >= 0 ? W[(size_t)(k0 + kk) * N + sc] : 0.f; }
#pragma unroll
    for (int i = 0; i < 32; ++i) { const int kk = 2 * i + (lane >> 5); scr[kk * 33 + (lane & 31)] = tv[i]; }
    asm volatile("s_waitcnt lgkmcnt(0)" ::: "memory");
    const int c = lane & 7;
#pragma unroll
    for (int j = 0; j < 4; ++j) { const int n = (lane >> 3) + 8 * j; const LAS float* s = scr + (8 * c) * 33 + n;
        u32x4 o; o.x = pk2(s[0 * 33], s[1 * 33]); o.y = pk2(s[2 * 33], s[3 * 33]); o.z = pk2(s[4 * 33], s[5 * 33]); o.w = pk2(s[6 * 33], s[7 * 33]);
        *(u32x4*)(WT + (size_t)(n0 + n) * K + k0 + 8 * c) = o; }
    asm volatile("s_waitcnt lgkmcnt(0)" ::: "memory");
}
__device__ __forceinline__ void adaln_unit(int u, const float* c, const float* w_ada, const float* b_ada, float* mod, LAS float* lds) {
    const int tid = opaque_tid(), wave = tid >> 6, lane = tid & 63;
    const int l = u / 96, n0 = (u % 96) * 64;
    LAS float* sc = lds; LAS float* red = lds + 4096;
    for (int i = tid; i < 4096; i += 512) { const float v = c[i]; sc[i] = v / (1.0f + __expf(-v)); }
    __syncthreads();
    const float* wp = w_ada + (size_t)l * DM * NMOD + n0 + lane;
    float a0 = 0.f, a1 = 0.f, a2 = 0.f, a3 = 0.f;
#pragma unroll 32
    for (int k = wave * 128; k < wave * 128 + 128; ++k) { const float w = wp[(size_t)k * NMOD]; a0 += sc[k] * w; a1 += sc[1024 + k] * w; a2 += sc[2048 + k] * w; a3 += sc[3072 + k] * w; }
    red[(wave * 4 + 0) * 64 + lane] = a0; red[(wave * 4 + 1) * 64 + lane] = a1; red[(wave * 4 + 2) * 64 + lane] = a2; red[(wave * 4 + 3) * 64 + lane] = a3;
    __syncthreads();
    if (tid < 256) { const int b = tid >> 6; float s = b_ada[(size_t)l * NMOD + n0 + lane];
#pragma unroll
        for (int w = 0; w < 8; ++w) s += red[(w * 4 + b) * 64 + lane];
        mod[((size_t)l * 4 + b) * NMOD + n0 + lane] = s; }
    __syncthreads();
}
__device__ __forceinline__ void prenorm_rows(const float* __restrict__ xin, bf16_t* __restrict__ an, float* __restrict__ rss, const float* __restrict__ modl, int coff) {
    const int tid = opaque_tid(), lane = tid & 63, gw = blockIdx.x * 8 + (tid >> 6), NGW = GRID * 8;
#pragma unroll 4
    for (int t = gw; t < T; t += NGW) {
        const f32x4* xr = (const f32x4*)(xin + (size_t)t * DM) + lane; f32x4 v[4]; float ss = 0.f;
#pragma unroll
        for (int j = 0; j < 4; ++j) { v[j] = xr[64 * j]; ss += (v[j][0] * v[j][0] + v[j][1] * v[j][1]) + (v[j][2] * v[j][2] + v[j][3] * v[j][3]); }
        ss = wave_sum(ss); if (lane == 0) rss[t] = ss;
        const float* mb = modl + (size_t)(t >> 13) * NMOD;
#pragma unroll
        for (int j = 0; j < 4; ++j) { const int col = 256 * j + 4 * lane;
            const f32x4 sc = *(const f32x4*)(mb + coff + col);
            const f32x4 h = v[j] * (sc + 1.0f);
            u32x2 w; w.x = pk2(h[0], h[1]); w.y = pk2(h[2], h[3]); *(u32x2*)(an + (size_t)t * DM + col) = w; }
    }
}
__device__ __forceinline__ void bias_rows(const bf16_t* __restrict__ Wt, int N, const float* __restrict__ modl, int soff, float* __restrict__ bias) {
    const int tid = opaque_tid(), lane = tid & 63, gw = blockIdx.x * 8 + (tid >> 6), NGW = GRID * 8;
#pragma unroll 2
    for (int n = gw; n < N; n += NGW) {
        const u32x4 w0 = *(const u32x4*)(Wt + (size_t)n * 1024 + 16 * lane), w1 = *(const u32x4*)(Wt + (size_t)n * 1024 + 16 * lane + 8);
        float wf[16];
#pragma unroll
        for (int e2 = 0; e2 < 4; ++e2) { wf[2 * e2] = __uint_as_float(w0[e2] << 16); wf[2 * e2 + 1] = __uint_as_float(w0[e2] & 0xffff0000u);
                                         wf[8 + 2 * e2] = __uint_as_float(w1[e2] << 16); wf[8 + 2 * e2 + 1] = __uint_as_float(w1[e2] & 0xffff0000u); }
#pragma unroll
        for (int b = 0; b < 4; ++b) { const float* sp = modl + (size_t)b * NMOD + soff + 16 * lane; float s = 0.f;
#pragma unroll
            for (int q = 0; q < 4; ++q) { const f32x4 sv = *(const f32x4*)(sp + 4 * q); s += (sv[0] * wf[4 * q] + sv[1] * wf[4 * q + 1]) + (sv[2] * wf[4 * q + 2] + sv[3] * wf[4 * q + 3]); }
            s = wave_sum(s); if (lane == 0) bias[(size_t)b * N + n] = s; }
    }
}
__device__ __forceinline__ void prep_tokens(const bf16_t* __restrict__ proj, bf16_t* __restrict__ qn, bf16_t* __restrict__ kvn, bf16_t* __restrict__ Kb, const float* __restrict__ qa, const float* __restrict__ kva, const float* __restrict__ kr,
                                            const float* __restrict__ cosT, const float* __restrict__ sinT) {
    const int tid = opaque_tid(), lane = tid & 63, gw = blockIdx.x * 8 + (tid >> 6), NGW = GRID * 8;
#pragma unroll 4
    for (int t = gw; t < T; t += NGW) {
        const bf16_t* pr = proj + (size_t)t * NIN;
        { const u32x2 w = *(const u32x2*)(pr + 1536 + 4 * lane);
          const float q0 = __uint_as_float(w.x << 16), q1 = __uint_as_float(w.x & 0xffff0000u), q2 = __uint_as_float(w.y << 16), q3 = __uint_as_float(w.y & 0xffff0000u);
          const float rr = 1.0f / sqrtf(wave_sum((q0 * q0 + q1 * q1) + (q2 * q2 + q3 * q3)) * (1.0f / 256.0f) + EPS);
          const f32x4 g = *(const f32x4*)(qa + 4 * lane);
          u32x2 o; o.x = pk2(q0 * rr * g[0], q1 * rr * g[1]); o.y = pk2(q2 * rr * g[2], q3 * rr * g[3]); *(u32x2*)(qn + (size_t)t * 256 + 4 * lane) = o; }
        { const unsigned w = *(const unsigned*)(pr + 1792 + 2 * lane);
          const float k0 = __uint_as_float(w << 16), k1 = __uint_as_float(w & 0xffff0000u);
          const float rr = 1.0f / sqrtf(wave_sum(k0 * k0 + k1 * k1) * (1.0f / 128.0f) + EPS);
          const f32x2 g = *(const f32x2*)(kva + 2 * lane);
          *(unsigned*)(kvn + (size_t)t * 128 + 2 * lane) = pk2(k0 * rr * g[0], k1 * rr * g[1]); }
        { float y = bf2f(pr[1920 + lane]);
          const float rr = 1.0f / sqrtf(wave_sum(y * y) * (1.0f / 64.0f) + EPS);
          y = y * rr * kr[lane];
          const float pn = __shfl_xor(y, 32); const int j = lane & 31;
          const float c = cosT[(size_t)t * 32 + j], s = sinT[(size_t)t * 32 + j];
          const float o = lane < 32 ? y * c - pn * s : y * c + pn * s;
          const bf16_t ob = (bf16_t)f2bf(o); const int b = t >> 13, sp = t & 8191;
#pragma unroll
          for (int h = 0; h < 4; ++h) Kb[((size_t)(b * 4 + h) * SEQ + sp) * 192 + 128 + lane] = ob; }
    }
}
__device__ __forceinline__ void gla_pass_a(LAS unsigned char* ldsl, const bf16_t* __restrict__ proj, const float* __restrict__ wgu, const float* __restrict__ bg, float* __restrict__ Btab, float* __restrict__ Gst, float* __restrict__ Gdv) {
    const int tid = opaque_tid(), lane = tid & 63, r = lane & 31, hh = lane >> 5, wv = tid >> 6, gw = blockIdx.x * 8 + wv, NGW = GRID * 8;
    LAS float* Bw = (LAS float*)(ldsl + wv * 16384);
    LAS unsigned char* Tl = ldsl + wv * 16384 + 8192;
    LAS bf16_t* Th = (LAS bf16_t*)Tl;
    for (int u = gw; u < 16 * 128 * 2; u += NGW) { const int item = u >> 1, dkb = u & 1;
        const int bh = item >> 7, n = item & 127, b = bh >> 2, h = bh & 3; const size_t row0 = (size_t)b * SEQ + (size_t)n * 64;
        const int dk = 32 * dkb + r;
        { const bf16_t* kp = proj + (row0 + (lane >> 3)) * NIN + 256 + h * 64 + (lane & 7) * 8; u32x4 sv[8];
#pragma unroll
          for (int i = 0; i < 8; ++i) sv[i] = *(const u32x4*)(kp + (size_t)(8 * i) * NIN);
#pragma unroll
          for (int i = 0; i < 8; ++i) *(LAS u32x4*)(Tl + (8 * i + (lane >> 3)) * 128 + (lane & 7) * 16) = sv[i]; }
        float bl;
        { float w[16];
#pragma unroll
          for (int q = 0; q < 16; ++q) w[q] = wgu[q * 256 + h * 64 + dk];
          const float bias = bg[h * 64 + dk];
          float loc[32]; float a = 0.f;
#pragma unroll
          for (int t0 = 0; t0 < 32; t0 += 8) { u32x4 g0[8], g1[8];
#pragma unroll
              for (int i = 0; i < 8; ++i) { const bf16_t* ga = proj + (row0 + 32 * hh + t0 + i) * NIN + 1984; g0[i] = *(const u32x4*)ga; g1[i] = *(const u32x4*)(ga + 8); }
#pragma unroll
              for (int i = 0; i < 8; ++i) { float x = bias;
#pragma unroll
                  for (int e2 = 0; e2 < 4; ++e2) { x += __uint_as_float(g0[i][e2] << 16) * w[2 * e2] + __uint_as_float(g0[i][e2] & 0xffff0000u) * w[2 * e2 + 1];
                                                   x += __uint_as_float(g1[i][e2] << 16) * w[8 + 2 * e2] + __uint_as_float(g1[i][e2] & 0xffff0000u) * w[8 + 2 * e2 + 1]; }
                  a += (fminf(x, 0.f) - __logf(1.0f + __expf(-fabsf(x)))) * (1.0f / 16.0f);
                  loc[t0 + i] = a; } }
          const float tot0 = __shfl(a, r);
          const float off = hh ? tot0 : 0.f;
#pragma unroll
          for (int t = 0; t < 32; ++t) { const float v = loc[t] + off; Bw[(32 * hh + t) * 32 + r] = v; Btab[(row0 + 32 * hh + t) * 256 + h * 64 + dk] = v; }
          bl = Bw[63 * 32 + r]; }
        bf16x8 bv[4];
#pragma unroll
        for (int ks = 0; ks < 4; ++ks) { u32x4 w;
#pragma unroll
            for (int j2 = 0; j2 < 4; ++j2) { const int t = 16 * ks + 8 * hh + 2 * j2;
                w[j2] = pk2(bf2f(Th[t * 64 + dk]) * __expf(bl - Bw[t * 32 + r]), bf2f(Th[(t + 1) * 64 + dk]) * __expf(bl - Bw[(t + 1) * 32 + r])); }
            bv[ks] = __builtin_bit_cast(bf16x8, w); }
        f32x16 acc[4] = {};
#pragma unroll
        for (int half = 0; half < 2; ++half) {
            { const bf16_t* vp = proj + (row0 + 32 * half + (lane >> 4)) * NIN + 512 + h * 128 + (lane & 15) * 8; u32x4 sv[8];
#pragma unroll
              for (int i = 0; i < 8; ++i) sv[i] = *(const u32x4*)(vp + (size_t)(4 * i) * NIN);
#pragma unroll
              for (int i = 0; i < 8; ++i) *(LAS u32x4*)(Tl + (4 * i + (lane >> 4)) * 256 + (lane & 15) * 16) = sv[i]; }
#pragma unroll
            for (int k2 = 0; k2 < 2; ++k2)
#pragma unroll
                for (int dvb = 0; dvb < 4; ++dvb) { bf16x8 av;
#pragma unroll
                    for (int j = 0; j < 8; ++j) av[j] = (short)Th[(16 * k2 + 8 * hh + j) * 128 + 32 * dvb + r];
                    acc[dvb] = __builtin_amdgcn_mfma_f32_32x32x16_bf16(av, bv[2 * half + k2], acc[dvb], 0, 0, 0); } }
#pragma unroll
        for (int dvb = 0; dvb < 4; ++dvb) { float* go = Gst + ((size_t)item * 128 + 32 * dvb) * 64 + dk;
#pragma unroll
            for (int i = 0; i < 16; ++i) go[(size_t)crow(i, hh) * 64] = acc[dvb][i]; }
        if (hh == 0) Gdv[(size_t)item * 64 + dk] = __expf(bl);
    }
}
__device__ __forceinline__ void gla_scan(float* __restrict__ Gst, const float* __restrict__ Gdv) {
    const int gt = blockIdx.x * 512 + opaque_tid(), GT = GRID * 512;
    for (int e = gt; e < 16 * 8192; e += GT) { const int bh = e >> 13, idx = e & 8191, dk = idx & 63;
        float* base = Gst + (size_t)bh * 128 * 8192 + idx; const float* dvp = Gdv + (size_t)bh * 128 * 64 + dk;
        float s = 0.f;
        for (int n0 = 0; n0 < 128; n0 += 32) { float u[32], dd[32];
#pragma unroll
            for (int i = 0; i < 32; ++i) { u[i] = base[(size_t)(n0 + i) * 8192]; dd[i] = dvp[(n0 + i) * 64]; }
#pragma unroll
            for (int i = 0; i < 32; ++i) { base[(size_t)(n0 + i) * 8192] = s; s = dd[i] * s + u[i]; } }
    }
}
__device__ __forceinline__ void gla_pass_c(LAS unsigned char* ldsl, const bf16_t* __restrict__ proj, const float* __restrict__ Btab, const float* __restrict__ Gst, const float* __restrict__ gout, bf16_t* __restrict__ mixed) {
    const int tid = opaque_tid(), lane = tid & 63, r = lane & 31, hh = lane >> 5, wv = tid >> 6, gw = blockIdx.x * 8 + wv, NGW = GRID * 8;
    LAS unsigned char* Lw = ldsl + wv * 16384;
    LAS bf16_t* Lh = (LAS bf16_t*)Lw;
    const int crw = lane >> 4, ccl = lane & 15;
    for (int u = gw; u < 16 * 128 * 2; u += NGW) { const int item = u >> 1, tb = __builtin_amdgcn_readfirstlane((u ^ (u >> 11) ^ (u >> 3)) & 1);
        const int bh = item >> 7, n = item & 127, b = bh >> 2, h = bh & 3; const size_t row0 = (size_t)b * SEQ + (size_t)n * 64;
        const int tl = 32 * tb + r;
        { const bf16_t* vp = proj + (row0 + crw) * NIN + 512 + h * 128 + ccl * 8; u32x4 sv[8];
#pragma unroll
          for (int i = 0; i < 8; ++i) sv[i] = *(const u32x4*)(vp + (size_t)(4 * i) * NIN);
#pragma unroll
          for (int i = 0; i < 8; ++i) *(LAS u32x4*)(Lw + (4 * i + crw) * 256 + ccl * 16) = sv[i];
          if (tb) {
#pragma unroll
              for (int i = 0; i < 8; ++i) sv[i] = *(const u32x4*)(vp + (size_t)(32 + 4 * i) * NIN);
#pragma unroll
              for (int i = 0; i < 8; ++i) *(LAS u32x4*)(Lw + (32 + 4 * i + crw) * 256 + ccl * 16) = sv[i]; } }
        bf16x8 qe[4];
        { const bf16_t* qp = proj + (row0 + tl) * NIN + h * 64; const float* bp = Btab + (row0 + tl) * 256 + h * 64;
#pragma unroll
          for (int ks = 0; ks < 4; ++ks) { const u32x4 qw = *(const u32x4*)(qp + 16 * ks + 8 * hh); const f32x4 b0 = *(const f32x4*)(bp + 16 * ks + 8 * hh), b1 = *(const f32x4*)(bp + 16 * ks + 8 * hh + 4);
              u32x4 w; w.x = pk2(__uint_as_float(qw[0] << 16) * 0.125f * __expf(b0[0]), __uint_as_float(qw[0] & 0xffff0000u) * 0.125f * __expf(b0[1]));
                       w.y = pk2(__uint_as_float(qw[1] << 16) * 0.125f * __expf(b0[2]), __uint_as_float(qw[1] & 0xffff0000u) * 0.125f * __expf(b0[3]));
                       w.z = pk2(__uint_as_float(qw[2] << 16) * 0.125f * __expf(b1[0]), __uint_as_float(qw[2] & 0xffff0000u) * 0.125f * __expf(b1[1]));
                       w.w = pk2(__uint_as_float(qw[3] << 16) * 0.125f * __expf(b1[2]), __uint_as_float(qw[3] & 0xffff0000u) * 0.125f * __expf(b1[3]));
              qe[ks] = __builtin_bit_cast(bf16x8, w); } }
        f32x16 o[4] = {};
#pragma unroll
        for (int dvb = 0; dvb < 4; ++dvb) { const float* sp = Gst + ((size_t)item * 128 + 32 * dvb + r) * 64;
#pragma unroll
          for (int ks = 0; ks < 4; ++ks) { const f32x4 s0 = *(const f32x4*)(sp + 16 * ks + 8 * hh), s1 = *(const f32x4*)(sp + 16 * ks + 8 * hh + 4);
              u32x4 sw; sw.x = pk2(s0[0], s0[1]); sw.y = pk2(s0[2], s0[3]); sw.z = pk2(s1[0], s1[1]); sw.w = pk2(s1[2], s1[3]);
              o[dvb] = __builtin_amdgcn_mfma_f32_32x32x16_bf16(qe[ks], __builtin_bit_cast(bf16x8, sw), o[dvb], 0, 0, 0); } }
        for (int sb = 0; sb <= tb; ++sb) {
            f32x16 x = {};
            const int sl = 32 * sb + r; const bf16_t* kp = proj + (row0 + sl) * NIN + 256 + h * 64; const float* bp = Btab + (row0 + sl) * 256 + h * 64;
#pragma unroll
            for (int ks = 0; ks < 4; ++ks) { const u32x4 kw = *(const u32x4*)(kp + 16 * ks + 8 * hh); const f32x4 b0 = *(const f32x4*)(bp + 16 * ks + 8 * hh), b1 = *(const f32x4*)(bp + 16 * ks + 8 * hh + 4);
                u32x4 w; w.x = pk2(__uint_as_float(kw[0] << 16) * __expf(-b0[0]), __uint_as_float(kw[0] & 0xffff0000u) * __expf(-b0[1]));
                         w.y = pk2(__uint_as_float(kw[1] << 16) * __expf(-b0[2]), __uint_as_float(kw[1] & 0xffff0000u) * __expf(-b0[3]));
                         w.z = pk2(__uint_as_float(kw[2] << 16) * __expf(-b1[0]), __uint_as_float(kw[2] & 0xffff0000u) * __expf(-b1[1]));
                         w.w = pk2(__uint_as_float(kw[3] << 16) * __expf(-b1[2]), __uint_as_float(kw[3] & 0xffff0000u) * __expf(-b1[3]));
                x = __builtin_amdgcn_mfma_f32_32x32x16_bf16(__builtin_bit_cast(bf16x8, w), qe[ks], x, 0, 0, 0); }
            if (sb == tb) {
#pragma unroll
                for (int i = 0; i < 16; ++i) if (crow(i, hh) > r) x[i] = 0.f; }
#pragma unroll
            for (int s2 = 0; s2 < 2; ++s2) { u32x4 xw; xw.x = pk2(x[8 * s2], x[8 * s2 + 1]); xw.y = pk2(x[8 * s2 + 2], x[8 * s2 + 3]); xw.z = pk2(x[8 * s2 + 4], x[8 * s2 + 5]); xw.w = pk2(x[8 * s2 + 6], x[8 * s2 + 7]);
#pragma unroll
                for (int dvb = 0; dvb < 4; ++dvb) { bf16x8 vb;
#pragma unroll
                    for (int j = 0; j < 8; ++j) { const int sk = 32 * sb + 16 * s2 + 8 * (j >> 2) + 4 * hh + (j & 3); vb[j] = (short)Lh[sk * 128 + 32 * dvb + r]; }
                    o[dvb] = __builtin_amdgcn_mfma_f32_32x32x16_bf16(__builtin_bit_cast(bf16x8, xw), vb, o[dvb], 0, 0, 0); } } }
        { const bf16_t* gp = proj + (row0 + 32 * tb + crw) * NIN + 1024 + h * 128 + ccl * 8; u32x4 sv[8];
#pragma unroll
          for (int i = 0; i < 8; ++i) sv[i] = *(const u32x4*)(gp + (size_t)(4 * i) * NIN);
#pragma unroll
          for (int i = 0; i < 8; ++i) *(LAS u32x4*)(Lw + (4 * i + crw) * 256 + ccl * 16) = sv[i]; }
        float gn[4];
#pragma unroll
        for (int dvb = 0; dvb < 4; ++dvb) gn[dvb] = gout[32 * dvb + r];
#pragma unroll
        for (int i = 0; i < 16; ++i) { const int tr = crow(i, hh);
            const float tot = half_sum32((o[0][i] * o[0][i] + o[1][i] * o[1][i]) + (o[2][i] * o[2][i] + o[3][i] * o[3][i]));
            const float rr = __builtin_amdgcn_rsqf(tot * (1.0f / 128.0f) + EPS);
#pragma unroll
            for (int dvb = 0; dvb < 4; ++dvb) { const float g = bf2f(Lh[tr * 128 + 32 * dvb + r]);
                const float val = o[dvb][i] * rr * gn[dvb] * (g * __builtin_amdgcn_rcpf(1.0f + __expf(-g)));
                Lh[(32 + tr) * 128 + 32 * dvb + r] = (bf16_t)f2bf(val); } }
        { bf16_t* mp = mixed + (row0 + 32 * tb + crw) * DM + h * 128 + ccl * 8;
#pragma unroll
          for (int i = 0; i < 8; ++i) *(u32x4*)(mp + (size_t)(4 * i) * DM) = *(const LAS u32x4*)(Lw + (32 + 4 * i + crw) * 256 + ccl * 16); }
    }
}
}
#define XB_TMO      128
#define XB_XCNT(j)  (256  + 64 * (j))
#define XB_XSUB(j)  (1280 + 64 * (j))
#define XB_XGEN(j)  (2304 + 64 * (j))
#define XB_TOP      3328
#define XB_TOPGEN   3392
#define XCD_BAR_WORDS 3456
#define XB_SPIN_CAP (1u << 18)

__device__ __forceinline__ unsigned xb_ld(unsigned* p)              { return __hip_atomic_load(p, __ATOMIC_RELAXED, __HIP_MEMORY_SCOPE_AGENT); }
__device__ __forceinline__ unsigned xb_add(unsigned* p, unsigned v) { return __hip_atomic_fetch_add(p, v, __ATOMIC_RELAXED, __HIP_MEMORY_SCOPE_AGENT); }
__device__ __forceinline__ unsigned xb_xcc_id() { return (unsigned)__builtin_amdgcn_s_getreg((3 << 11) | 20) & 0xFu; }
#define XB_SPIN(cond, bar) do { unsigned _sp = 0; while (cond) { __builtin_amdgcn_s_sleep(1); \
    if ((++_sp & 255u) == 0u) { if (xb_ld(&(bar)[XB_TMO])) break; if (_sp > XB_SPIN_CAP) { atomicAdd(&(bar)[XB_TMO], 1u); break; } } } } while (0)

struct XcdBarrier {
    unsigned* bar; unsigned x;
    volatile LAS unsigned* st;
};

__device__ __forceinline__ XcdBarrier xcd_barrier_post(unsigned* bar, volatile LAS unsigned* st) {
    XcdBarrier b; b.bar = bar; b.x = xb_xcc_id(); b.st = st;
    if (threadIdx.x == 0) (void)xb_add(&bar[XB_XCNT(b.x)], 1u);
    return b;
}
__device__ __forceinline__ void xcd_barrier_complete(unsigned* bar, unsigned x, unsigned& nloc, unsigned& nx) {
    const unsigned G = gridDim.x * gridDim.y * gridDim.z;
    unsigned sum, cnt, mine, sp = 0u;
    for (;;) {
        sum = 0u; cnt = 0u; mine = 0u;
#pragma unroll
        for (unsigned j = 0; j < 16; ++j) { const unsigned c = xb_ld(&bar[XB_XCNT(j)]); sum += c; cnt += (c > 0u) ? 1u : 0u; mine = (j == x) ? c : mine; }
        if (sum == G) break;
        __builtin_amdgcn_s_sleep(1);
        if ((++sp & 255u) == 0u) { if (xb_ld(&bar[XB_TMO])) break; if (sp > XB_SPIN_CAP) { atomicAdd(&bar[XB_TMO], 1u); break; } }
    }
    nloc = mine > 0u ? mine : 1u; nx = cnt > 0u ? cnt : 1u;
}

__device__ __forceinline__ void xcd_barrier(const XcdBarrier& b) {
    asm volatile("s_waitcnt vmcnt(0)" ::: "memory");
    __syncthreads();
    if (threadIdx.x == 0) {
        unsigned* bar = b.bar; unsigned bx = b.x; asm volatile("" : "+s"(bx));
        __builtin_amdgcn_s_waitcnt(0);
        unsigned nloc = b.st[0], nx = b.st[1];
        if (nloc == 0u) { xcd_barrier_complete(bar, bx, nloc, nx); b.st[0] = nloc; b.st[1] = nx; }
        const unsigned old = xb_add(&bar[XB_XSUB(bx)], 1u);
        const unsigned gen = old / nloc;
        if (old + 1u == (gen + 1u) * nloc) {
            __builtin_amdgcn_fence(__ATOMIC_RELEASE, "agent");
            asm volatile("s_waitcnt vmcnt(0)" ::: "memory");
            const unsigned og = xb_add(&bar[XB_TOP], 1u);
            const unsigned tg = og / nx;
            if (og + 1u == (tg + 1u) * nx) xb_add(&bar[XB_TOPGEN], 1u);
            else XB_SPIN(xb_ld(&bar[XB_TOPGEN]) == tg, bar);
            __builtin_amdgcn_fence(__ATOMIC_ACQUIRE, "agent");
            xb_add(&bar[XB_XGEN(bx)], 1u);
            asm volatile("s_waitcnt vmcnt(0)" ::: "memory");
        } else {
            XB_SPIN(xb_ld(&bar[XB_XGEN(bx)]) == gen, bar);
            __builtin_amdgcn_fence(__ATOMIC_ACQUIRE, "agent");
            asm volatile("s_waitcnt vmcnt(0)" ::: "memory");
        }
    }
    __syncthreads();
}
#ifndef PHM
#define PHM 0xffff
#endif
#ifndef REP
#define REP 0
#endif
#ifndef USE_XB
#define USE_XB 1
#endif
#if USE_XB
#define GSYNC() xcd_barrier(xbar)
#else
#define GSYNC() grid.sync()
#endif
#if REP
#define REPEAT(k) _Pragma("unroll 1") for (int rep_ = 0, nrep_ = opaque_int((((REP) >> (k)) & 1) + 1); rep_ < nrep_; ++rep_)
#else
#define REPEAT(k)
#endif
struct Args { const float* in[20]; float* out; unsigned char* ws; float inv_freq[32]; };
__global__ void __launch_bounds__(512, 2) mega_fwd(Args a) {
    using namespace mk;
    extern __shared__ __attribute__((aligned(16))) unsigned char lds[];
    cg::grid_group grid = cg::this_grid();
    const int tid = opaque_tid(), lane = tid & 63, wave = __builtin_amdgcn_readfirstlane(tid >> 6);
    constexpr int G = GRID;
    PG8_LAS unsigned char* ldsl = (PG8_LAS unsigned char*)lds;
    LAS float* ldsf = (LAS float*)lds;
    unsigned char* ws = a.ws;
    const float* x_in = a.in[0]; const float* c_in = a.in[1]; const int* pos = (const int*)a.in[2];
    const float* w_ada = a.in[3]; const float* b_ada = a.in[4];
    float* mod = (float*)(ws + WS_MOD); float* cosT = (float*)(ws + WS_COS); float* sinT = (float*)(ws + WS_SIN);
    bf16_t* HN = (bf16_t*)(ws + WS_HN); bf16_t* QN = (bf16_t*)(ws + WS_QN); bf16_t* KVN = (bf16_t*)(ws + WS_KVN);
    float* GST = (float*)(ws + WS_GST); float* GDV = (float*)(ws + WS_GDV); float* BT = (float*)(ws + WS_BT);
    bf16_t* PROJ = (bf16_t*)(ws + WS_R + R_PROJ); bf16_t* QB_ = (bf16_t*)(ws + WS_R + R_Q); bf16_t* KB_ = (bf16_t*)(ws + WS_R + R_K); bf16_t* VB_ = (bf16_t*)(ws + WS_R + R_V);
    bf16_t* HB = (bf16_t*)(ws + WS_R);
    float* xout = a.out;
    float* RSS = (float*)(ws + WS_RSS); float* BIAS = (float*)(ws + WS_BIAS); bf16_t* AN1 = (bf16_t*)(ws + WS_GST);
#if USE_XB
    volatile LAS unsigned* MISC = (volatile LAS unsigned*)(ldsl + MISC_OFF);
    if (tid < 16) MISC[tid] = 0u;
    __syncthreads();
    const XcdBarrier xbar = xcd_barrier_post((unsigned*)(ws + WS_BAR), MISC);
#endif

    REPEAT(0) {
#if (PHM >> 0) & 1
    for (int u = blockIdx.x; u < 192; u += G) adaln_unit(u, c_in, w_ada, b_ada, mod, ldsf);
    __syncthreads();
    { const int gt = blockIdx.x * 512 + tid, GT = G * 512;
      for (int e = gt; e < T * 32; e += GT) { const int t = e >> 5, j = e & 31;
          const float ang = (float)pos[t] * a.inv_freq[j];
          const double turns = (double)ang * 0.15915494309189535; const float fr = (float)(turns - rint(turns)) * 6.283185307179586f;
          cosT[e] = cosf(fr); sinT[e] = sinf(fr); } }
    { float* rz = (float*)(ws + WS_RSS) + T; const int gt = blockIdx.x * 512 + tid, GT = G * 512; for (int e = gt; e < 3 * T; e += GT) rz[e] = 0.f; }
    { LAS float* scr = (LAS float*)(ldsl + wave * 16384);
      const int gw = blockIdx.x * 8 + wave, NGW = G * 8;
      constexpr int I_IN = 16 * 64, I_Q = 4 * 24, I_KV = 2 * 32, I_O = 16 * 32, I_1 = 16 * 128, I_2 = 64 * 32, I_L = I_IN + I_Q + I_KV + I_O + I_1 + I_2;
      for (int it = gw; it < DEPTH * I_L; it += NGW) { const int l = it / I_L; int r = it % I_L; unsigned char* wl = ws + WS_W + (size_t)l * W_LAYER;
          if (r < I_IN) { transpose_item(a.in[5] + (size_t)l * 1024 * 2000, 1024, 2000, 2048, (bf16_t*)(wl + W_IN), 1, scr, r, lane); continue; } r -= I_IN;
          if (r < I_Q) { transpose_item(a.in[10] + (size_t)l * 256 * 768, 256, 768, 768, (bf16_t*)(wl + W_Q), 2, scr, r, lane); continue; } r -= I_Q;
          if (r < I_KV) { transpose_item(a.in[12] + (size_t)l * 128 * 1024, 128, 1024, 1024, (bf16_t*)(wl + W_KV), 0, scr, r, lane); continue; } r -= I_KV;
          if (r < I_O) { transpose_item(a.in[17] + (size_t)l * 1024 * 1024, 1024, 1024, 1024, (bf16_t*)(wl + W_O), 0, scr, r, lane); continue; } r -= I_O;
          if (r < I_1) { transpose_item(a.in[18] + (size_t)l * 1024 * 4096, 1024, 4096, 4096, (bf16_t*)(wl + W_1), 0, scr, r, lane); continue; } r -= I_1;
          transpose_item(a.in[19] + (size_t)l * 4096 * 1024, 4096, 1024, 1024, (bf16_t*)(wl + W_2), 0, scr, r, lane); } }
#endif
    grid.sync();
    prenorm_rows(x_in, HN, RSS, mod, 1024);
    for (int l = 0; l < DEPTH; ++l) { unsigned char* wl = ws + WS_W + (size_t)l * W_LAYER; const float* modl = mod + (size_t)l * 4 * NMOD;
        bias_rows((const bf16_t*)(wl + W_IN), NIN, modl, 0, BIAS + (size_t)l * 4 * NIN);
        bias_rows((const bf16_t*)(wl + W_1), DFF, modl, 3072, BIAS + 2 * 4 * NIN + (size_t)l * 4 * DFF); }
    GSYNC();

    }
#pragma unroll 1
    for (int l = 0; l < DEPTH; ++l) {
        const float* modl = mod + (size_t)l * 4 * NMOD;
        unsigned char* wl = ws + WS_W + (size_t)l * W_LAYER;
        const float* xin = l == 0 ? x_in : xout;
#if (PHM >> 2) & 1
        REPEAT(2) { pg8::Gemm g{HN, (const bf16_t*)(wl + W_IN), T, NIN, DM}; pg8::StaticOrder S; S.init(T, NIN, G, (int)blockIdx.x);
          pg8::EpiBf16<0> E{PROJ, NIN, BIAS + (size_t)l * 4 * NIN, 0, 0, 1.f, RSS + (size_t)(2 * l) * T, NIN};
          pg8::gemm_phase<pg8::EpiBf16<0>, pg8::StaticOrder, true, true>(ldsl, g, S, E); }
#endif
        GSYNC();
#if (PHM >> 3) & 1
        REPEAT(3) prep_tokens(PROJ, QN, KVN, KB_, a.in[9] + l * 256, a.in[11] + l * 128, a.in[16] + l * 64, cosT, sinT);
#endif
#if (PHM >> 4) & 1
        REPEAT(4) gla_pass_a(ldsl, PROJ, a.in[6] + (size_t)l * 16 * 256, a.in[7] + l * 256, BT, GST, GDV);
#endif
        GSYNC();
#if (PHM >> 5) & 1
        REPEAT(5) { int kq = 256; asm volatile("" : "+s"(kq));
          pg8::Gemm g{QN, (const bf16_t*)(wl + W_Q), T, 512, kq}; pg8::StaticOrder S; S.init(T, 512, G, (int)blockIdx.x);
          pg8::EpiQN E{QB_, a.in[13] + l * 128, (PG8_LAS float*)(ldsl + EPI_OFF)};
          pg8::gemm_phase<pg8::EpiQN, pg8::StaticOrder, true, true>(ldsl, g, S, E); }
#endif
#if (PHM >> 13) & 1
        REPEAT(5) { int kq = 256; asm volatile("" : "+s"(kq));
          pg8::Gemm g{QN, (const bf16_t*)(wl + W_Q) + 512 * 256, T, 256, kq}; pg8::StaticOrder S; S.init(T, 256, G, (int)blockIdx.x);
          pg8::EpiQR E{QB_, a.in[15] + l * 64, cosT, sinT};
          pg8::gemm_phase<pg8::EpiQR, pg8::StaticOrder, true, true>(ldsl, g, S, E); }
#endif
#if (PHM >> 6) & 1
        REPEAT(5) { int kk = 128; asm volatile("" : "+s"(kk));
          pg8::Gemm g{KVN, (const bf16_t*)(wl + W_KV), T, 1024, kk}; pg8::StaticOrder S; S.init(T, 1024, G, (int)blockIdx.x);
          pg8::EpiKV E{KB_, VB_, a.in[14] + l * 128, (PG8_LAS float*)(ldsl + EPI_OFF)};
          pg8::gemm_phase<pg8::EpiKV, pg8::StaticOrder, true, true>(ldsl, g, S, E); }
#endif
#if (PHM >> 7) & 1
        gla_scan(GST, GDV);
#endif
        GSYNC();
#if (PHM >> 8) & 1
        REPEAT(8) att::attn_phase((char*)lds, (const att::bf16*)QB_, (const att::bf16*)KB_, (const att::bf16*)VB_, (att::bf16*)HN);
#endif
        __syncthreads();
#if (PHM >> 9) & 1
        REPEAT(9) gla_pass_c(ldsl, PROJ, BT, GST, a.in[8] + l * 128, HN);
#endif
        GSYNC();
#if (PHM >> 10) & 1
        { pg8::Gemm g{HN, (const bf16_t*)(wl + W_O), T, DM, DM}; pg8::StaticOrder S; S.init(T, DM, G, (int)blockIdx.x);
          pg8::EpiResGate E{xin, xout, modl + 2048, AN1, modl + 4096, RSS + (size_t)(2 * l + 1) * T};
          pg8::gemm_phase<pg8::EpiResGate, pg8::StaticOrder, true, true>(ldsl, g, S, E); }
#endif
        GSYNC();
#if (PHM >> 11) & 1
        REPEAT(11) { pg8::Gemm g{AN1, (const bf16_t*)(wl + W_1), T, DFF, DM}; pg8::StaticOrder S; S.init(T, DFF, G, (int)blockIdx.x);
          pg8::EpiBf16<2> E{HB, DFF, BIAS + 2 * 4 * NIN + (size_t)l * 4 * DFF, 0, 0, 1.f, RSS + (size_t)(2 * l + 1) * T, DFF};
          pg8::gemm_phase<pg8::EpiBf16<2>, pg8::StaticOrder, true, true>(ldsl, g, S, E); }
#endif
        GSYNC();
#if (PHM >> 12) & 1
        { pg8::Gemm g{HB, (const bf16_t*)(wl + W_2), T, DM, DFF}; pg8::StaticOrder S; S.init(T, DM, G, (int)blockIdx.x);
          const bool more = l + 1 < DEPTH;
          pg8::EpiResGate E{xout, xout, modl + 5120, more ? HN : nullptr, mod + (size_t)(l + 1) * 4 * NMOD + 1024, RSS + (size_t)(2 * l + 2) * T};
          pg8::gemm_phase<pg8::EpiResGate, pg8::StaticOrder, true, true>(ldsl, g, S, E); }
#endif
        if (l + 1 < DEPTH) GSYNC();
    }
}

extern "C" void kernel_launch(void* const* d_in, const int* in_sizes, int n_in, void* d_out, int out_size, void* d_ws, size_t ws_size, hipStream_t stream) {
    static int grid = 0;
    if (grid == 0) {
        if (n_in != 20 || out_size != mk::T * mk::DM || ws_size < mk::WS_END) { fprintf(stderr, "kernel_launch: unexpected shapes (n_in %d out %d ws %zu)\n", n_in, out_size, ws_size); grid = -1; return; }
        int dev = 0, cus = 0, per = 0;
        (void)hipGetDevice(&dev); (void)hipDeviceGetAttribute(&cus, hipDeviceAttributeMultiprocessorCount, dev);
        (void)hipFuncSetAttribute((const void*)mega_fwd, hipFuncAttributeMaxDynamicSharedMemorySize, mk::LDS_BYTES);
        if (hipOccupancyMaxActiveBlocksPerMultiprocessor(&per, (const void*)mega_fwd, 512, mk::LDS_BYTES) != hipSuccess || per < 1) per = 1;
        (void)hipGetLastError();
        if (cus * per < GRID) fprintf(stderr, "kernel_launch: device holds %d co-resident workgroups, kernel built for %d\n", cus * per, GRID);
        grid = GRID;
    }
    if (grid < 0) return;
    (void)hipMemsetAsync((unsigned char*)d_ws + mk::WS_BAR, 0, XCD_BAR_WORDS * sizeof(unsigned), stream);
    Args a{};
    for (int i = 0; i < 20; ++i) a.in[i] = (const float*)d_in[i];
    a.out = (float*)d_out; a.ws = (unsigned char*)d_ws;
    for (int j = 0; j < 32; ++j) a.inv_freq[j] = powf(10000.0f, -(float)(2 * j) / 64.0f);
    void* args[] = {&a};
    hipError_t e = hipLaunchCooperativeKernel((const void*)mega_fwd, dim3(grid), dim3(512), args, mk::LDS_BYTES, stream);
    if (e != hipSuccess) fprintf(stderr, "kernel_launch: cooperative launch failed: %s (grid %d)\n", hipGetErrorString(e), grid);
}
```

```cpp
#include <hip/hip_runtime.h>
#include <hip/hip_bf16.h>
#include <hip/hip_cooperative_groups.h>
#include <cstdio>
#include <cstdint>
#include <cmath>
namespace cg = cooperative_groups;
#define LAS __attribute__((address_space(3)))
__device__ __forceinline__ int opaque_tid() { int t = threadIdx.x; asm volatile("" : "+v"(t)); return t; }
__device__ __forceinline__ int opaque_int(int v) { asm volatile("" : "+s"(v)); return v; }
constexpr int GRID = 256;
namespace pg8 {
#define PG8_LAS __attribute__((address_space(3)))
typedef unsigned short bf16_t;
typedef short bf16x8 __attribute__((ext_vector_type(8)));
typedef float f32x4 __attribute__((ext_vector_type(4)));
typedef unsigned u32x4 __attribute__((ext_vector_type(4)));
constexpr int BM = 256, BK = 64, HALF = 128, HTB = HALF * BK * 2  , STAGE_BYTES = 8 * HTB, NXCD = 8, WGM = 8;

__host__ __device__ __forceinline__ int lds_byte(int r, int c) { const int st = (r >> 4) * 2 + (c >> 5), rr = r & 15, cc = c & 31, ob = rr * 64 + cc * 2; return st * 1024 + (ob ^ (((ob >> 9) & 1) << 5)); }
__host__ __device__ __forceinline__ void stage_rc(int b, int& R, int& C) { const int st = b / 1024, sb = b % 1024, swz = sb ^ (((sb >> 9) & 1) << 5); R = (st >> 1) * 16 + swz / 64; C = (st & 1) * 32 + (swz % 64) / 2; }
__host__ __device__ __forceinline__ int perm32(int rho) { const int n = rho >> 4, i = rho & 15; return 8 * (i >> 2) + 4 * n + (i & 3); }

struct Unit { int pm, pn; };
struct Gemm { const bf16_t* A; const bf16_t* Bt; int M, N, K; };

struct StaticOrder {
    int nM, nN, nwg, G, c;
    __host__ __device__ void init(int M, int N, int G_, int c_) { nM = M / BM; nN = N / BM; nwg = nM * nN; G = G_; c = c_; }
    __host__ __device__ bool next(int i, Unit& u) const {
        const long L = (long)i * G + c; if (L >= nwg) return false;
        int wgid = (int)L; { const int q = nwg / NXCD, r = nwg % NXCD, xcd = wgid % NXCD, off = wgid / NXCD; wgid = (xcd < r ? xcd * (q + 1) : r * (q + 1) + (xcd - r) * q) + off; }
        const int nig = WGM * nN, gid = wgid / nig, fm = gid * WGM, gsz = (nM - fm) < WGM ? (nM - fm) : WGM;
        u.pm = fm + ((wgid % nig) % gsz); u.pn = (wgid % nig) / gsz; return true;
    }
    __device__ __forceinline__ void a_ready(const Unit&) const {}
    __device__ __forceinline__ void done(const Unit&) const {}
};

__device__ __forceinline__ unsigned cvt_pk_bf16(float lo, float hi) { unsigned r; asm volatile("v_cvt_pk_bf16_f32 %0, %1, %2" : "=v"(r) : "v"(lo), "v"(hi)); return r; }
typedef float f32x2 __attribute__((ext_vector_type(2)));
__device__ __forceinline__ f32x2 gelu_pk(f32x2 v) {
    const f32x2 av = __builtin_elementwise_abs(v), d = av * 0.2316418882f + 1.0f;
    f32x2 t; t.x = __builtin_amdgcn_rcpf(d.x); t.y = __builtin_amdgcn_rcpf(d.y);
    f32x2 q = t * 0.5307027145f + (-0.7265760135f); q = q * t + 0.7107068705f; q = q * t + (-0.142248368f); q = q * t + 0.127414796f; q = q * t;
    const f32x2 s = (v * v) * (-0.72134752044f);
    f32x2 e; e.x = __builtin_amdgcn_exp2f(s.x); e.y = __builtin_amdgcn_exp2f(s.y);
    const f32x2 m = v * (q * e), r = v - m;
    f32x2 o; o.x = v.x < 0.f ? m.x : r.x; o.y = v.y < 0.f ? m.y : r.y; return o;
}

template <int ACT  > struct EpiBf16 {
    static constexpr bool PERM = true, AFTER_DRAIN = false; static_assert(ACT == 0 || ACT == 1 || ACT == 2, "EpiBf16: ACT is 0 (none), 1 (gelu_pk) or 2 (relu squared)");
    bf16_t* O; int ldc; const float* bias; int split_cols; size_t split_stride; float scale0; const float* rowss = nullptr; int bstride = 0;
    __device__ __forceinline__ void operator()(const f32x4 (&acc)[2][2][4][2], const Unit& u, int wr, int wc, int fr, int fq) const {
        const int row0 = u.pm * BM + wr * 64 + fr; int colt = u.pn * BM; bf16_t* base = O;
        float sc = 1.f; if (split_cols) { const int t = colt / split_cols; base += (size_t)t * split_stride; colt -= t * split_cols; if (t == 0) sc = scale0; }
        const int col0 = colt + wc * 32 + 8 * fq, bcol0 = u.pn * BM + wc * 32 + 8 * fq;
        const float* bias = this->bias ? this->bias + (size_t)(u.pm >> 5) * bstride : nullptr;
        f32x4 bv[2][2];
#pragma unroll
        for (int bj = 0; bj < 2; ++bj)
#pragma unroll
            for (int n = 0; n < 2; ++n) bv[bj][n] = bias ? *(const f32x4*)(bias + bcol0 + bj * HALF + 4 * n) : (f32x4){0.f, 0.f, 0.f, 0.f};
#pragma unroll
        for (int ai = 0; ai < 2; ++ai)
#pragma unroll
            for (int m = 0; m < 4; ++m) { bf16_t* rowp = base + (size_t)(row0 + ai * HALF + m * 16) * ldc + col0;
                const float rs = rowss ? __builtin_amdgcn_rsqf(rowss[row0 + ai * HALF + m * 16] * (1.0f / 1024.0f) + 1e-6f) : 1.0f;
#pragma unroll
                for (int bj = 0; bj < 2; ++bj) { f32x4 v0 = acc[ai][bj][m][0] * rs + bv[bj][0], v1 = acc[ai][bj][m][1] * rs + bv[bj][1];
                    if (ACT == 1) { f32x2 a = gelu_pk((f32x2){v0[0], v0[1]}), b = gelu_pk((f32x2){v0[2], v0[3]}), c = gelu_pk((f32x2){v1[0], v1[1]}), d = gelu_pk((f32x2){v1[2], v1[3]});
                        v0 = (f32x4){a.x, a.y, b.x, b.y}; v1 = (f32x4){c.x, c.y, d.x, d.y}; }
                    if (ACT == 2) { v0 = __builtin_elementwise_max(v0, (f32x4){0.f, 0.f, 0.f, 0.f}); v1 = __builtin_elementwise_max(v1, (f32x4){0.f, 0.f, 0.f, 0.f}); v0 = v0 * v0; v1 = v1 * v1; }
                    v0 = v0 * sc; v1 = v1 * sc; u32x4 w; w.x = cvt_pk_bf16(v0[0], v0[1]); w.y = cvt_pk_bf16(v0[2], v0[3]); w.z = cvt_pk_bf16(v1[0], v1[1]); w.w = cvt_pk_bf16(v1[2], v1[3]);
                    *(u32x4*)(rowp + bj * HALF) = w; } }
    }
};
template <class Epi, class Sched, bool ALIGN_EPI = false, bool SP2 = false>
__device__ __forceinline__ void gemm_phase(PG8_LAS unsigned char* lds, const Gemm g, const Sched& S, const Epi& E) {
    const int tid = opaque_tid(), wid = __builtin_amdgcn_readfirstlane(tid >> 6), lane = tid & 63, wr = wid >> 2, wc = wid & 3, fr = lane & 15, fq = lane >> 4;
    const int K = g.K, nt = K / BK;
    unsigned voffA[2], voffB[2];
#pragma unroll
    for (int i = 0; i < 2; ++i) { int R, C; stage_rc(tid * 16 + i * 8192, R, C); const int Rb = Epi::PERM ? ((R & ~31) + perm32(R & 31)) : R;
        voffA[i] = (unsigned)(R * K + C) * 2u; voffB[i] = (unsigned)(Rb * K + C) * 2u; }
    const size_t kstep = (size_t)(BK * 2);
    const size_t hstep = (size_t)HALF * K * 2;
    const size_t tstep = 2 * hstep;
    const unsigned ldsw = (unsigned)wid * 1024u;
    const int aoff = lds_byte(wr * 64 + fr, fq * 8), boff = lds_byte(wc * 32 + fr, fq * 8);
#define PG8_SA(b, h) (((b) * 2 + (h)) * HTB)
#define PG8_SB(b, h) ((4 + (b) * 2 + (h)) * HTB)
#define PG8_STAGE(bufoff, gbase, voff) do { _Pragma("unroll") for (int _i = 0; _i < 2; ++_i) \
        __builtin_amdgcn_global_load_lds((const unsigned*)((const char*)(gbase) + (voff)[_i]), (PG8_LAS unsigned*)(lds + (bufoff) + ldsw + _i * 8192), 16, 0, 0); } while (0)
#define PG8_LDA(dst, b, h) do { _Pragma("unroll") for (int m = 0; m < 4; ++m) _Pragma("unroll") for (int k = 0; k < 2; ++k) dst[m][k] = *(const PG8_LAS bf16x8*)(lds + PG8_SA(b, h) + aoff + m * 2048 + k * 1024); } while (0)
#define PG8_LDB(dst, b, h) do { _Pragma("unroll") for (int n = 0; n < 2; ++n) _Pragma("unroll") for (int k = 0; k < 2; ++k) dst[n][k] = *(const PG8_LAS bf16x8*)(lds + PG8_SB(b, h) + boff + n * 2048 + k * 1024); } while (0)
#define PG8_MMA(ai, bj, At, Bt) do { __builtin_amdgcn_s_setprio(1); _Pragma("unroll") for (int m = 0; m < 4; ++m) _Pragma("unroll") for (int n = 0; n < 2; ++n) _Pragma("unroll") for (int k = 0; k < 2; ++k) \
        acc[ai][bj][m][n] = __builtin_amdgcn_mfma_f32_16x16x32_bf16(Bt[n][k], At[m][k], acc[ai][bj][m][n], 0, 0, 0); __builtin_amdgcn_s_setprio(0); } while (0)
#define PG8_WAIT_V(n) asm volatile("s_waitcnt vmcnt(" #n ")" ::: "memory")
#define PG8_WAIT_L(n) asm volatile("s_waitcnt lgkmcnt(" #n ")" ::: "memory")
#define PG8_BAR __builtin_amdgcn_s_barrier()
#define PG8_SCHED __builtin_amdgcn_sched_barrier(0)
    Unit cur, nxt; int ui = 0;
    if (!S.next(0, cur)) return;
    f32x4 acc[2][2][4][2];
#pragma unroll
    for (int a = 0; a < 2; ++a)
#pragma unroll
        for (int b = 0; b < 2; ++b)
#pragma unroll
            for (int m = 0; m < 4; ++m)
#pragma unroll
                for (int n = 0; n < 2; ++n) acc[a][b][m][n] = (f32x4){0.f, 0.f, 0.f, 0.f};
    bf16x8 At[4][2], B0[2][2], B1[2][2];
    const char* cA = (const char*)g.A + (size_t)cur.pm * tstep; const char* cB = (const char*)g.Bt + (size_t)cur.pn * tstep;
    S.a_ready(cur);
    if constexpr (SP2) {
        PG8_STAGE(PG8_SB(0, 0), cB, voffB); PG8_STAGE(PG8_SB(0, 1), cB + hstep, voffB); PG8_STAGE(PG8_SA(0, 0), cA, voffA); PG8_STAGE(PG8_SA(0, 1), cA + hstep, voffA);
        if (wr == 1) PG8_BAR;
        PG8_WAIT_V(2); PG8_BAR;
        PG8_STAGE(PG8_SB(1, 0), cB + kstep, voffB); PG8_STAGE(PG8_SA(1, 0), cA + kstep, voffA); PG8_STAGE(PG8_SB(1, 1), cB + hstep + kstep, voffB);
        PG8_WAIT_V(6); PG8_BAR;
    } else {
        PG8_STAGE(PG8_SB(0, 0), cB, voffB); PG8_STAGE(PG8_SA(0, 0), cA, voffA); PG8_STAGE(PG8_SB(0, 1), cB + hstep, voffB); PG8_STAGE(PG8_SA(0, 1), cA + hstep, voffA);
        if (wr == 1) PG8_BAR;
        PG8_WAIT_V(4); PG8_BAR;
        PG8_STAGE(PG8_SB(1, 0), cB + kstep, voffB); PG8_STAGE(PG8_SA(1, 0), cA + kstep, voffA); PG8_STAGE(PG8_SB(1, 1), cB + hstep + kstep, voffB);
        PG8_WAIT_V(6); PG8_BAR;
    }
    for (;;) {
        const bool has_next = S.next(ui + 1, nxt);
        const char* nA = has_next ? (const char*)g.A + (size_t)nxt.pm * tstep : cA; const char* nB = has_next ? (const char*)g.Bt + (size_t)nxt.pn * tstep : cB;
        for (int t = 0; t < nt; t += 2) {
            const bool last = (t == nt - 2);
            const char* a1 = cA + (size_t)(t + 1) * kstep;
            const char* a2 = last ? nA : cA + (size_t)(t + 2) * kstep; const char* b2 = last ? nB : cB + (size_t)(t + 2) * kstep;
            const char* a3 = a2 + kstep; const char* b3 = b2 + kstep;
            if (last && has_next) S.a_ready(nxt);
            if constexpr (SP2) {
            PG8_LDB(B0, 0, 0); PG8_LDB(B1, 0, 1); PG8_SCHED; PG8_LDA(At, 0, 0); PG8_STAGE(PG8_SA(1, 1), a1 + hstep, voffA);
            PG8_WAIT_V(8); PG8_WAIT_L(0); PG8_BAR; PG8_MMA(0, 0, At, B0); PG8_MMA(0, 1, At, B1); PG8_BAR; PG8_SCHED;
            PG8_LDA(At, 0, 1); PG8_STAGE(PG8_SB(0, 0), b2, voffB); PG8_STAGE(PG8_SB(0, 1), b2 + hstep, voffB); PG8_STAGE(PG8_SA(0, 0), a2, voffA);
            PG8_WAIT_V(8); PG8_WAIT_L(0); PG8_BAR; PG8_MMA(1, 0, At, B0); PG8_MMA(1, 1, At, B1); PG8_BAR; PG8_SCHED;
            PG8_LDB(B0, 1, 0); PG8_LDB(B1, 1, 1); PG8_SCHED; PG8_LDA(At, 1, 0); PG8_STAGE(PG8_SA(0, 1), a2 + hstep, voffA);
            PG8_WAIT_V(8); PG8_WAIT_L(0); PG8_BAR; PG8_MMA(0, 0, At, B0); PG8_MMA(0, 1, At, B1); PG8_BAR; PG8_SCHED;
            PG8_LDA(At, 1, 1); PG8_STAGE(PG8_SB(1, 0), b3, voffB); PG8_STAGE(PG8_SB(1, 1), b3 + hstep, voffB); PG8_STAGE(PG8_SA(1, 0), a3, voffA);
            PG8_WAIT_V(8); PG8_WAIT_L(0); PG8_BAR; PG8_MMA(1, 0, At, B0); PG8_MMA(1, 1, At, B1); PG8_BAR; PG8_SCHED;
            } else {
            PG8_LDB(B0, 0, 0); PG8_SCHED; PG8_LDA(At, 0, 0); PG8_STAGE(PG8_SA(1, 1), a1 + hstep, voffA);
            PG8_WAIT_L(8); PG8_BAR; PG8_WAIT_L(0); PG8_MMA(0, 0, At, B0); PG8_BAR; PG8_SCHED;
            PG8_LDB(B1, 0, 1); PG8_STAGE(PG8_SB(0, 0), b2, voffB);
            PG8_BAR; PG8_WAIT_L(0); PG8_MMA(0, 1, At, B1); PG8_BAR;
            PG8_LDA(At, 0, 1); PG8_STAGE(PG8_SA(0, 0), a2, voffA);
            PG8_BAR; PG8_WAIT_L(0); PG8_MMA(1, 0, At, B0); PG8_BAR; PG8_SCHED;
            PG8_STAGE(PG8_SB(0, 1), b2 + hstep, voffB);
            PG8_WAIT_V(6); PG8_BAR; PG8_MMA(1, 1, At, B1); PG8_BAR;
            PG8_LDB(B0, 1, 0); PG8_SCHED; PG8_LDA(At, 1, 0); PG8_STAGE(PG8_SA(0, 1), a2 + hstep, voffA);
            PG8_WAIT_L(8); PG8_BAR; PG8_WAIT_L(0); PG8_MMA(0, 0, At, B0); PG8_BAR; PG8_SCHED;
            PG8_LDB(B1, 1, 1); PG8_STAGE(PG8_SB(1, 0), b3, voffB);
            PG8_BAR; PG8_WAIT_L(0); PG8_MMA(0, 1, At, B1); PG8_BAR;
            PG8_LDA(At, 1, 1); PG8_STAGE(PG8_SA(1, 0), a3, voffA);
            PG8_BAR; PG8_WAIT_L(0); PG8_MMA(1, 0, At, B0); PG8_BAR; PG8_SCHED;
            PG8_STAGE(PG8_SB(1, 1), b3 + hstep, voffB);
            PG8_WAIT_V(6); PG8_BAR; PG8_MMA(1, 1, At, B1); PG8_BAR;
            }
        }
        if constexpr (ALIGN_EPI) { if (wr == 0) PG8_BAR; }
        if constexpr (!Epi::AFTER_DRAIN) { E(acc, cur, wr, wc, fr, fq); S.done(cur); }
        if (!has_next) break;
#pragma unroll
        for (int a = 0; a < 2; ++a)
#pragma unroll
            for (int b = 0; b < 2; ++b)
#pragma unroll
                for (int m = 0; m < 4; ++m)
#pragma unroll
                    for (int n = 0; n < 2; ++n) acc[a][b][m][n] = (f32x4){0.f, 0.f, 0.f, 0.f};
        cur = nxt; cA = nA; cB = nB; ++ui;
        if constexpr (ALIGN_EPI) { if (wr == 1) PG8_BAR; }
    }
    PG8_WAIT_V(0);
    if constexpr (!ALIGN_EPI) { if (wr == 0) PG8_BAR; }
    PG8_BAR;
    if constexpr (Epi::AFTER_DRAIN) { E.fused(acc, cur, wr, wc, fr, fq, lds, wid, lane); S.done(cur); }
#undef PG8_SA
#undef PG8_SB
#undef PG8_STAGE
#undef PG8_LDA
#undef PG8_LDB
#undef PG8_MMA
#undef PG8_WAIT_V
#undef PG8_WAIT_L
#undef PG8_BAR
#undef PG8_SCHED
}
typedef unsigned u32x2 __attribute__((ext_vector_type(2)));
constexpr float RMS_EPS_F = 1e-6f;
struct EpiResGate {
    static constexpr bool PERM = true, AFTER_DRAIN = false;
    const float* xin; float* xout; const float* gate;
    bf16_t* anext; const float* scale_next; float* rss_next;
    __device__ __forceinline__ void operator()(const f32x4 (&acc)[2][2][4][2], const Unit& u, int wr_, int wc_, int fr_, int fq_) const {
        int tx = threadIdx.x; asm volatile("" : "+v"(tx));
        const int fr = tx & 15, fq = (tx >> 4) & 3, wc = (tx >> 6) & 3, wr = tx >> 8;
        const int b = u.pm >> 5;
        const int col0 = u.pn * BM + wc * 32 + 8 * fq;
        const float* gp = gate + (size_t)b * 6144 + col0;
        f32x4 gv[2][2], sv[2][2];
#pragma unroll
        for (int bj = 0; bj < 2; ++bj)
#pragma unroll
            for (int n = 0; n < 2; ++n) { gv[bj][n] = *(const f32x4*)(gp + bj * HALF + n * 4);
                sv[bj][n] = anext ? *(const f32x4*)(scale_next + (size_t)b * 6144 + col0 + bj * HALF + n * 4) + 1.0f : (f32x4){0.f, 0.f, 0.f, 0.f}; }
#pragma unroll
        for (int ai = 0; ai < 2; ++ai)
#pragma unroll
            for (int m = 0; m < 4; ++m) { int row = u.pm * BM + ai * HALF + wr * 64 + m * 16 + fr; asm volatile("" : "+v"(row));
                const size_t off = (size_t)row * 1024 + col0; float ss = 0.f;
#pragma unroll
                for (int bj = 0; bj < 2; ++bj) { u32x4 w;
#pragma unroll
                    for (int n = 0; n < 2; ++n) { const f32x4 xi = *(const f32x4*)(xin + off + bj * HALF + n * 4);
                        const f32x4 xn = xi + gv[bj][n] * acc[ai][bj][m][n];
                        *(f32x4*)(xout + off + bj * HALF + n * 4) = xn;
                        if (anext) { ss += (xn[0] * xn[0] + xn[1] * xn[1]) + (xn[2] * xn[2] + xn[3] * xn[3]);
                            const f32x4 an = xn * sv[bj][n]; w[2 * n] = cvt_pk_bf16(an[0], an[1]); w[2 * n + 1] = cvt_pk_bf16(an[2], an[3]); } }
                    if (anext) *(u32x4*)(anext + off + bj * HALF) = w; }
                if (anext) { ss += __shfl_xor(ss, 16); ss += __shfl_xor(ss, 32); if (fq == 0) atomicAdd(rss_next + row, ss); }
                asm volatile("" ::: "memory"); }
    }
};
struct EpiQN {
    static constexpr bool PERM = true, AFTER_DRAIN = false;
    bf16_t* Q; const float* gn_nope; PG8_LAS float* P;
    __device__ __forceinline__ void operator()(const f32x4 (&acc)[2][2][4][2], const Unit& u, int wr_, int wc_, int fr_, int fq_) const {
        int tx = threadIdx.x; asm volatile("" : "+v"(tx));
        const int fr = tx & 15, fq = (tx >> 4) & 3, wc = (tx >> 6) & 3, wr = tx >> 8;
        const int b = u.pm >> 5, s0 = (u.pm & 31) * BM;
#pragma unroll
            for (int ai = 0; ai < 2; ++ai)
#pragma unroll
                for (int m = 0; m < 4; ++m)
#pragma unroll
                    for (int bj = 0; bj < 2; ++bj) { float s = 0.f;
#pragma unroll
                        for (int n = 0; n < 2; ++n) { const f32x4 x = acc[ai][bj][m][n]; s += (x[0] * x[0] + x[1] * x[1]) + (x[2] * x[2] + x[3] * x[3]); }
                        s += __shfl_xor(s, 16); s += __shfl_xor(s, 32);
                        if (fq == 0) P[((ai * HALF + wr * 64 + m * 16 + fr) * 2 + bj) * 4 + wc] = s; }
            asm volatile("s_waitcnt lgkmcnt(0)" ::: "memory"); __builtin_amdgcn_s_barrier(); asm volatile("" ::: "memory");
#pragma unroll
            for (int ai = 0; ai < 2; ++ai)
#pragma unroll
                for (int m = 0; m < 4; ++m) { int rl = ai * HALF + wr * 64 + m * 16 + fr; asm volatile("" : "+v"(rl));
#pragma unroll
                    for (int bj = 0; bj < 2; ++bj) { const f32x4 pp = *(const PG8_LAS f32x4*)(P + (rl * 2 + bj) * 4);
                        const float rr = 1.0f / sqrtf(((pp[0] + pp[1]) + (pp[2] + pp[3])) * (1.0f / 128.0f) + RMS_EPS_F);
                        const int head = 2 * u.pn + bj;
                        const unsigned qoff = (unsigned)(((b * 4 + head) * 8192 + s0 + rl) * 192 + wc * 32 + 8 * fq); u32x4 w;
#pragma unroll
                        for (int n = 0; n < 2; ++n) { const f32x4 g = *(const f32x4*)(gn_nope + wc * 32 + 8 * fq + 4 * n);
                            const f32x4 v = acc[ai][bj][m][n] * rr * g; w[2 * n] = cvt_pk_bf16(v[0], v[1]); w[2 * n + 1] = cvt_pk_bf16(v[2], v[3]); }
                        *(u32x4*)(Q + qoff) = w; }
                    asm volatile("" ::: "memory"); }
    }
};
struct EpiQR {
    static constexpr bool PERM = true, AFTER_DRAIN = false;
    bf16_t* Q; const float* gn_rope; const float* cosT; const float* sinT;
    __device__ __forceinline__ void operator()(const f32x4 (&acc)[2][2][4][2], const Unit& u, int wr_, int wc_, int fr_, int fq_) const {
        int tx = threadIdx.x; asm volatile("" : "+v"(tx));
        const int fr = tx & 15, fq = (tx >> 4) & 3, wc = (tx >> 6) & 3, wr = tx >> 8;
        const int b = u.pm >> 5, s0 = (u.pm & 31) * BM;
#pragma unroll
            for (int ai = 0; ai < 2; ++ai)
#pragma unroll
                for (int m = 0; m < 4; ++m) { int rl = ai * HALF + wr * 64 + m * 16 + fr; asm volatile("" : "+v"(rl)); float s = 0.f;
#pragma unroll
                    for (int bj = 0; bj < 2; ++bj)
#pragma unroll
                        for (int n = 0; n < 2; ++n) { const f32x4 x = acc[ai][bj][m][n]; s += (x[0] * x[0] + x[1] * x[1]) + (x[2] * x[2] + x[3] * x[3]); }
                    s += __shfl_xor(s, 16); s += __shfl_xor(s, 32);
                    const float rr = 1.0f / sqrtf(s * (1.0f / 64.0f) + RMS_EPS_F);
                    const size_t t = (size_t)u.pm * BM + rl;
                    bf16_t* qrow = Q + ((size_t)(b * 4 + wc) * 8192 + s0 + rl) * 192 + 128;
                    u32x4 wa, wb;
#pragma unroll
                    for (int n = 0; n < 2; ++n) { const int j0 = 8 * fq + 4 * n;
                        const f32x4 c4 = *(const f32x4*)(cosT + t * 32 + j0), s4 = *(const f32x4*)(sinT + t * 32 + j0);
                        const f32x4 g1 = *(const f32x4*)(gn_rope + j0), g2 = *(const f32x4*)(gn_rope + 32 + j0);
                        const f32x4 y1 = acc[ai][0][m][n] * rr * g1, y2 = acc[ai][1][m][n] * rr * g2;
                        const f32x4 o1 = y1 * c4 - y2 * s4, o2 = y2 * c4 + y1 * s4;
                        wa[2 * n] = cvt_pk_bf16(o1[0], o1[1]); wa[2 * n + 1] = cvt_pk_bf16(o1[2], o1[3]); wb[2 * n] = cvt_pk_bf16(o2[0], o2[1]); wb[2 * n + 1] = cvt_pk_bf16(o2[2], o2[3]); }
                    *(u32x4*)(qrow + 8 * fq) = wa; *(u32x4*)(qrow + 32 + 8 * fq) = wb;
                    asm volatile("" ::: "memory"); }
    }
};
struct EpiKV {
    static constexpr bool PERM = true, AFTER_DRAIN = false;
    bf16_t* Kb; bf16_t* Vb; const float* gn_k; PG8_LAS float* P;
    __device__ __forceinline__ void operator()(const f32x4 (&acc)[2][2][4][2], const Unit& u, int wr_, int wc_, int fr_, int fq_) const {
        int tx = threadIdx.x; asm volatile("" : "+v"(tx));
        const int fr = tx & 15, fq = (tx >> 4) & 3, wc = (tx >> 6) & 3, wr = tx >> 8;
        const int b = u.pm >> 5, s0 = (u.pm & 31) * BM;
#pragma unroll
        for (int ai = 0; ai < 2; ++ai)
#pragma unroll
            for (int m = 0; m < 4; ++m) { float s = 0.f;
#pragma unroll
                for (int n = 0; n < 2; ++n) { const f32x4 x = acc[ai][0][m][n]; s += (x[0] * x[0] + x[1] * x[1]) + (x[2] * x[2] + x[3] * x[3]); }
                s += __shfl_xor(s, 16); s += __shfl_xor(s, 32);
                if (fq == 0) P[(ai * HALF + wr * 64 + m * 16 + fr) * 4 + wc] = s; }
        asm volatile("s_waitcnt lgkmcnt(0)" ::: "memory"); __builtin_amdgcn_s_barrier(); asm volatile("" ::: "memory");
#pragma unroll
        for (int ai = 0; ai < 2; ++ai)
#pragma unroll
            for (int m = 0; m < 4; ++m) { int rl = ai * HALF + wr * 64 + m * 16 + fr; asm volatile("" : "+v"(rl));
                const f32x4 pp = *(const PG8_LAS f32x4*)(P + rl * 4);
                const float rr = 1.0f / sqrtf(((pp[0] + pp[1]) + (pp[2] + pp[3])) * (1.0f / 128.0f) + RMS_EPS_F);
                const size_t tok = (size_t)(b * 4 + u.pn) * 8192 + s0 + rl;
                bf16_t* krow = Kb + tok * 192; bf16_t* vrow = Vb + tok * 128;
                u32x4 w1, w2;
#pragma unroll
                for (int n = 0; n < 2; ++n) { const f32x4 g = *(const f32x4*)(gn_k + wc * 32 + 8 * fq + 4 * n);
                    const f32x4 kx = acc[ai][0][m][n] * rr * g, vx = acc[ai][1][m][n];
                    w1[2 * n] = cvt_pk_bf16(kx[0], kx[1]); w1[2 * n + 1] = cvt_pk_bf16(kx[2], kx[3]); w2[2 * n] = cvt_pk_bf16(vx[0], vx[1]); w2[2 * n + 1] = cvt_pk_bf16(vx[2], vx[3]); }
                *(u32x4*)(krow + wc * 32 + 8 * fq) = w1; *(u32x4*)(vrow + wc * 32 + 8 * fq) = w2;
                asm volatile("" ::: "memory"); }
    }
};
}
namespace att {
using bf16 = __hip_bfloat16;
typedef short bf16x8 __attribute__((ext_vector_type(8)));
typedef short s16x4 __attribute__((ext_vector_type(4)));
typedef float f32x16 __attribute__((ext_vector_type(16)));
typedef float f32x4 __attribute__((ext_vector_type(4)));
typedef unsigned u32x4 __attribute__((ext_vector_type(4)));
constexpr int DQ = 192, DV = 128, LDO = 1024, SEQL = 8192;
constexpr float SCALE = 0.07216878364870322f;
constexpr float THR = 8.f;
constexpr int NW = 8, QBLK = 32, KVBLK = 64, QB = NW * QBLK;
constexpr int SHM_V = KVBLK * DV * 2, SHM_K = KVBLK * DQ * 2;
constexpr int KPITCH = DQ * 2;
constexpr int NSLOT = 3;
constexpr int LDS_WS = NSLOT * (SHM_V + SHM_K), LDS_QP = LDS_WS + NW * 64 * 4, LDS_NEED = LDS_QP + NW * 4096;
#define KS3(row) ((((row) >> 1) & 3) | ((((row) >> 4) & 1) << 2))
#define KSWZ(row, colB) ((row) * 384 + ((colB) ^ (KS3(row) << 4)))
#define SBAR() __builtin_amdgcn_sched_barrier(0)
__device__ __forceinline__ int v_st(int k, int c) { const int kk = (k & ~0xC) | ((k & 4) << 1) | ((k & 8) >> 1); return ((kk >> 3) * 4 + (c >> 5)) * 512 + ((kk & 7) * 32 + (c & 31)) * 2; }
__device__ __forceinline__ int v_rd_base(int lane) { return ((lane & 3) << 3) | (((lane >> 2) & 3) << 6) | (((lane >> 4) & 1) << 5) | (((lane >> 5) & 1) << 8); }
constexpr int v_rd_off(int d0, int ks, int half) { return d0 * 512 + ks * 4096 + half * 2048; }
__device__ __forceinline__ int crow(int r, int hi) { return (r & 3) + 8 * (r >> 2) + 4 * hi; }
__device__ __forceinline__ unsigned cvtpk(float lo, float hi) { unsigned r; asm volatile("v_cvt_pk_bf16_f32 %0, %1, %2" : "=v"(r) : "v"(lo), "v"(hi)); return r; }
__device__ __forceinline__ bf16x8 load8(const bf16* p) { return *reinterpret_cast<const bf16x8*>(p); }
__device__ __forceinline__ void mask_tile(f32x16& p0, f32x16& p1, int dq) {
    const float NEG = -__builtin_inff();
#pragma unroll
    for (int r = 0; r < 16; ++r) {
        const int c = (r & 3) + 8 * (r >> 2);
        if (dq - c < 0) p0[r] = NEG;
        if (dq - c - 32 < 0) p1[r] = NEG;
    }
}
__device__ __forceinline__ void partialSM(f32x16& p0, f32x16& p1, float& m_reg, float& mn, float& alpha) {
    float pmax = p0[0]; for (int r = 1; r < 16; ++r) pmax = fmaxf(pmax, p0[r]); for (int r = 0; r < 16; ++r) pmax = fmaxf(pmax, p1[r]);
    { auto rr = __builtin_amdgcn_permlane32_swap(__float_as_uint(pmax), __float_as_uint(pmax), false, false);
      pmax = fmaxf(__uint_as_float(rr[0]), __uint_as_float(rr[1])); }
    constexpr float C2 = 1.4426950408889634f * SCALE;
    if (__builtin_expect(__all((pmax - m_reg) * SCALE <= THR), 1)) { mn = m_reg; alpha = 1.f; }
    else { mn = fmaxf(m_reg, pmax); alpha = __builtin_amdgcn_exp2f((m_reg - mn) * C2); m_reg = mn; }
    const float mnL = -mn * C2;
    for (int r = 0; r < 16; ++r) p0[r] = fmaf(p0[r], C2, mnL); for (int r = 0; r < 16; ++r) p1[r] = fmaf(p1[r], C2, mnL);
    for (int r = 0; r < 16; ++r) p0[r] = __builtin_amdgcn_exp2f(p0[r]);
}
__device__ __forceinline__ void finishSM(f32x16& p0, f32x16& p1, float alpha, float& l_reg, bf16x8& pa0, bf16x8& pa1, bf16x8& pa2, bf16x8& pa3) {
    for (int r = 0; r < 16; ++r) p1[r] = __builtin_amdgcn_exp2f(p1[r]);
    float ps = 0; for (int r = 0; r < 16; ++r) ps += p0[r]; for (int r = 0; r < 16; ++r) ps += p1[r];
    { auto rr = __builtin_amdgcn_permlane32_swap(__float_as_uint(ps), __float_as_uint(ps), false, false);
      ps = __uint_as_float(rr[0]) + __uint_as_float(rr[1]); }
    l_reg = l_reg * alpha + ps;
#define PK4(P, B_, OUT) do { unsigned a0 = cvtpk(P[B_+0], P[B_+1]), a1 = cvtpk(P[B_+2], P[B_+3]);                          \
        unsigned b0 = cvtpk(P[B_+4], P[B_+5]), b1 = cvtpk(P[B_+6], P[B_+7]);                                             \
        auto r0 = __builtin_amdgcn_permlane32_swap(a0, b0, false, false); auto r1 = __builtin_amdgcn_permlane32_swap(a1, b1, false, false); \
        u32x4 w = {r0[0], r1[0], r0[1], r1[1]}; OUT = *reinterpret_cast<bf16x8*>(&w); } while (0)
    PK4(p0, 0, pa0); PK4(p0, 8, pa1); PK4(p1, 0, pa2); PK4(p1, 8, pa3);
#undef PK4
}
__device__ __forceinline__ void glds16(const void* gsrc, unsigned lds_dst) { unsigned keep;
    asm volatile("s_mov_b32 %0, m0\n\ts_mov_b32 m0, %2\n\ts_nop 0\n\tglobal_load_lds_dwordx4 %1, off\n\ts_mov_b32 m0, %0" : "=&s"(keep) : "v"(gsrc), "s"(lds_dst) : "memory"); }
#define KRD(dst, a, off) asm volatile("ds_read_b128 %0, %1 offset:%2" : "=&v"(dst) : "v"(a), "i"(off) : "memory")
#define KWAIT(n, x, y) asm volatile("s_waitcnt lgkmcnt(" #n ")" : "+v"(x), "+v"(y) :: "memory")
__device__ __forceinline__ void qkt(f32x16& p0, f32x16& p1, unsigned kslot, int r32, int hi, const bf16x8* qr) {
    unsigned ka[4];
#pragma unroll
    for (int dd = 0; dd < 4; ++dd) ka[dd] = kslot + KSWZ(r32, (dd * 16 + hi * 8) * 2);
    bf16x8 a0, a1, b0, b1, c0, c1;
    p0 = f32x16{}; p1 = f32x16{};
#define ISSUE(X, d0) do { KRD(X##0, ka[(d0) & 3], ((d0) >> 2) * 128); KRD(X##1, ka[(d0) & 3], ((d0) >> 2) * 128 + 32 * KPITCH); } while (0)
#define USE(X, d0, n) do { KWAIT(n, X##0, X##1); p0 = __builtin_amdgcn_mfma_f32_32x32x16_bf16(X##0, qr[d0], p0, 0, 0, 0); p1 = __builtin_amdgcn_mfma_f32_32x32x16_bf16(X##1, qr[d0], p1, 0, 0, 0); } while (0)
    ISSUE(a, 0); ISSUE(b, 1); ISSUE(c, 2);
    USE(a, 0, 4); ISSUE(a, 3); USE(b, 1, 4); ISSUE(b, 4); USE(c, 2, 4); ISSUE(c, 5);
    USE(a, 3, 4); ISSUE(a, 6); USE(b, 4, 4); ISSUE(b, 7); USE(c, 5, 4); ISSUE(c, 8);
    USE(a, 6, 4); ISSUE(a, 9); USE(b, 7, 4); ISSUE(b, 10); USE(c, 8, 4); ISSUE(c, 11);
    USE(a, 9, 4); USE(b, 10, 2); USE(c, 11, 0);
#undef ISSUE
#undef USE
}
#undef KRD
#undef KWAIT
__device__ __forceinline__ void pv_tile(f32x16* o, int vb, bf16x8 pa0, bf16x8 pa1, bf16x8 pa2, bf16x8 pa3) {
#define TRRD(dst, off) asm volatile("ds_read_b64_tr_b16 %0, %1 offset:%2" : "=&v"(dst) : "v"(vb), "i"(off) : "memory")
#define RD8(S, d0) do { constexpr int b_ = v_rd_off(d0, 0, 0); TRRD(S##l0, b_); TRRD(S##h0, b_ + 2048); TRRD(S##l1, b_ + 4096); TRRD(S##h1, b_ + 6144); \
        TRRD(S##l2, b_ + 8192); TRRD(S##h2, b_ + 10240); TRRD(S##l3, b_ + 12288); TRRD(S##h3, b_ + 14336); } while (0)
#define MM4(S, d0) do {   \
        o[d0] = __builtin_amdgcn_mfma_f32_32x32x16_bf16(pa0, (bf16x8){S##l0[0], S##l0[1], S##l0[2], S##l0[3], S##h0[0], S##h0[1], S##h0[2], S##h0[3]}, o[d0], 0, 0, 0);   \
        o[d0] = __builtin_amdgcn_mfma_f32_32x32x16_bf16(pa1, (bf16x8){S##l1[0], S##l1[1], S##l1[2], S##l1[3], S##h1[0], S##h1[1], S##h1[2], S##h1[3]}, o[d0], 0, 0, 0);   \
        o[d0] = __builtin_amdgcn_mfma_f32_32x32x16_bf16(pa2, (bf16x8){S##l2[0], S##l2[1], S##l2[2], S##l2[3], S##h2[0], S##h2[1], S##h2[2], S##h2[3]}, o[d0], 0, 0, 0);   \
        o[d0] = __builtin_amdgcn_mfma_f32_32x32x16_bf16(pa3, (bf16x8){S##l3[0], S##l3[1], S##l3[2], S##l3[3], S##h3[0], S##h3[1], S##h3[2], S##h3[3]}, o[d0], 0, 0, 0); } while (0)
    s16x4 Al0, Al1, Al2, Al3, Ah0, Ah1, Ah2, Ah3, Bl0, Bl1, Bl2, Bl3, Bh0, Bh1, Bh2, Bh3;
    RD8(A, 0); RD8(B, 1);
    asm volatile("s_waitcnt lgkmcnt(8)" ::: "memory"); SBAR(); MM4(A, 0); SBAR();
    RD8(A, 2);
    asm volatile("s_waitcnt lgkmcnt(8)" ::: "memory"); SBAR(); MM4(B, 1); SBAR();
    RD8(B, 3);
    asm volatile("s_waitcnt lgkmcnt(8)" ::: "memory"); SBAR(); MM4(A, 2); SBAR();
    asm volatile("s_waitcnt lgkmcnt(0)" ::: "memory"); SBAR(); MM4(B, 3);
#undef MM4
#undef RD8
#undef TRRD
}
#define KRD(dst, a, off) asm volatile("ds_read_b128 %0, %1 offset:%2" : "=&v"(dst) : "v"(a), "i"(off) : "memory")
#define KWAIT(n, x, y) asm volatile("s_waitcnt lgkmcnt(" #n ")" : "+v"(x), "+v"(y) :: "memory")
#define PK4(P, B_, OUT) do { unsigned a0_ = cvtpk(P[B_+0], P[B_+1]), a1_ = cvtpk(P[B_+2], P[B_+3]);                          \
        unsigned b0_ = cvtpk(P[B_+4], P[B_+5]), b1_ = cvtpk(P[B_+6], P[B_+7]);                                             \
        auto r0_ = __builtin_amdgcn_permlane32_swap(a0_, b0_, false, false); auto r1_ = __builtin_amdgcn_permlane32_swap(a1_, b1_, false, false); \
        u32x4 w_ = {r0_[0], r1_[0], r0_[1], r1_[1]}; OUT = *reinterpret_cast<bf16x8*>(&w_); } while (0)
__device__ __forceinline__ void qkt_fin(f32x16& x0, f32x16& x1, unsigned kslot, int r32, int hi, const bf16x8* qr,
                                        f32x16& y0, f32x16& y1, float alpha, float& l_reg, bf16x8& pa0, bf16x8& pa1, bf16x8& pa2, bf16x8& pa3) {
    unsigned ka[4];
#pragma unroll
    for (int dd = 0; dd < 4; ++dd) ka[dd] = kslot + KSWZ(r32, (dd * 16 + hi * 8) * 2);
    bf16x8 a0, a1, b0, b1, c0, c1;
    x0 = f32x16{}; x1 = f32x16{};
    float sacc = 0.f;
#define ISSUE(X, d0) do { KRD(X##0, ka[(d0) & 3], ((d0) >> 2) * 128); KRD(X##1, ka[(d0) & 3], ((d0) >> 2) * 128 + 32 * KPITCH); } while (0)
#define USE(X, d0, n) do { KWAIT(n, X##0, X##1); x0 = __builtin_amdgcn_mfma_f32_32x32x16_bf16(X##0, qr[d0], x0, 0, 0, 0); x1 = __builtin_amdgcn_mfma_f32_32x32x16_bf16(X##1, qr[d0], x1, 0, 0, 0); } while (0)
#define GAP_E(g) do { y1[2 * (g)] = __builtin_amdgcn_exp2f(y1[2 * (g)]); y1[2 * (g) + 1] = __builtin_amdgcn_exp2f(y1[2 * (g) + 1]); sacc += y0[2 * (g)]; sacc += y0[2 * (g) + 1]; SBAR(); } while (0)
    ISSUE(a, 0); ISSUE(b, 1); ISSUE(c, 2); SBAR();
    USE(a, 0, 4); ISSUE(a, 3); GAP_E(0); USE(b, 1, 4); ISSUE(b, 4); GAP_E(1); USE(c, 2, 4); ISSUE(c, 5); GAP_E(2);
    USE(a, 3, 4); ISSUE(a, 6); GAP_E(3); USE(b, 4, 4); ISSUE(b, 7); GAP_E(4); USE(c, 5, 4); ISSUE(c, 8); GAP_E(5);
    USE(a, 6, 4); ISSUE(a, 9); GAP_E(6); USE(b, 7, 4); ISSUE(b, 10); GAP_E(7);
    USE(c, 8, 4); ISSUE(c, 11); PK4(y0, 0, pa0); sacc += (y1[0] + y1[1]) + (y1[2] + y1[3]); SBAR();
    USE(a, 9, 4); PK4(y0, 8, pa1); sacc += (y1[4] + y1[5]) + (y1[6] + y1[7]); SBAR();
    USE(b, 10, 2); PK4(y1, 0, pa2); sacc += (y1[8] + y1[9]) + (y1[10] + y1[11]); SBAR();
    USE(c, 11, 0); PK4(y1, 8, pa3); sacc += (y1[12] + y1[13]) + (y1[14] + y1[15]);
    { auto rr = __builtin_amdgcn_permlane32_swap(__float_as_uint(sacc), __float_as_uint(sacc), false, false);
      sacc = __uint_as_float(rr[0]) + __uint_as_float(rr[1]); }
    l_reg = l_reg * alpha + sacc;
#undef ISSUE
#undef USE
#undef GAP_E
}
__device__ __forceinline__ void pv_part(f32x16* o, int vb, bf16x8 pa0, bf16x8 pa1, bf16x8 pa2, bf16x8 pa3, f32x16& x0, f32x16& x1, float& m_reg, float& mn, float& alpha) {
#define TRRD(dst, off) asm volatile("ds_read_b64_tr_b16 %0, %1 offset:%2" : "=&v"(dst) : "v"(vb), "i"(off) : "memory")
#define RD8(S, d0) do { constexpr int b_ = v_rd_off(d0, 0, 0); TRRD(S##l0, b_); TRRD(S##h0, b_ + 2048); TRRD(S##l1, b_ + 4096); TRRD(S##h1, b_ + 6144); \
        TRRD(S##l2, b_ + 8192); TRRD(S##h2, b_ + 10240); TRRD(S##l3, b_ + 12288); TRRD(S##h3, b_ + 14336); } while (0)
#define MM4(S, d0) do {   \
        o[d0] = __builtin_amdgcn_mfma_f32_32x32x16_bf16(pa0, (bf16x8){S##l0[0], S##l0[1], S##l0[2], S##l0[3], S##h0[0], S##h0[1], S##h0[2], S##h0[3]}, o[d0], 0, 0, 0);   \
        o[d0] = __builtin_amdgcn_mfma_f32_32x32x16_bf16(pa1, (bf16x8){S##l1[0], S##l1[1], S##l1[2], S##l1[3], S##h1[0], S##h1[1], S##h1[2], S##h1[3]}, o[d0], 0, 0, 0);   \
        o[d0] = __builtin_amdgcn_mfma_f32_32x32x16_bf16(pa2, (bf16x8){S##l2[0], S##l2[1], S##l2[2], S##l2[3], S##h2[0], S##h2[1], S##h2[2], S##h2[3]}, o[d0], 0, 0, 0);   \
        o[d0] = __builtin_amdgcn_mfma_f32_32x32x16_bf16(pa3, (bf16x8){S##l3[0], S##l3[1], S##l3[2], S##l3[3], S##h3[0], S##h3[1], S##h3[2], S##h3[3]}, o[d0], 0, 0, 0); } while (0)
#define MX3(a, b, c) __builtin_fmaxf(__builtin_fmaxf((a), (b)), (c))
    s16x4 Al0, Al1, Al2, Al3, Ah0, Ah1, Ah2, Ah3, Bl0, Bl1, Bl2, Bl3, Bh0, Bh1, Bh2, Bh3;
    constexpr float C2 = 1.4426950408889634f * SCALE;
    RD8(A, 0); RD8(B, 1);
    asm volatile("s_waitcnt lgkmcnt(8)" ::: "memory"); SBAR(); MM4(A, 0);
    float ma = MX3(x0[0], x0[1], x1[0]), mb = MX3(x0[2], x0[3], x1[1]); ma = MX3(ma, x1[2], x1[3]);
    ma = MX3(ma, x0[4], x0[5]); mb = MX3(mb, x0[6], x0[7]); ma = MX3(ma, x1[4], x1[5]); mb = MX3(mb, x1[6], x1[7]);
    SBAR();
    RD8(A, 2);
    asm volatile("s_waitcnt lgkmcnt(8)" ::: "memory"); SBAR(); MM4(B, 1);
    ma = MX3(ma, x0[8], x0[9]); mb = MX3(mb, x0[10], x0[11]); ma = MX3(ma, x1[8], x1[9]); mb = MX3(mb, x1[10], x1[11]);
    ma = MX3(ma, x0[12], x0[13]); mb = MX3(mb, x0[14], x0[15]); ma = MX3(ma, x1[12], x1[13]); mb = MX3(mb, x1[14], x1[15]);
    float pmax = __builtin_fmaxf(ma, mb);
    { auto rr = __builtin_amdgcn_permlane32_swap(__float_as_uint(pmax), __float_as_uint(pmax), false, false);
      pmax = fmaxf(__uint_as_float(rr[0]), __uint_as_float(rr[1])); }
    if (__builtin_expect(__all((pmax - m_reg) * SCALE <= THR), 1)) { mn = m_reg; alpha = 1.f; }
    else { mn = fmaxf(m_reg, pmax); alpha = __builtin_amdgcn_exp2f((m_reg - mn) * C2); m_reg = mn; }
    const float mnL = -mn * C2;
    SBAR();
    RD8(B, 3);
    asm volatile("s_waitcnt lgkmcnt(8)" ::: "memory"); SBAR(); MM4(A, 2);
#pragma unroll
    for (int r = 0; r < 16; ++r) x0[r] = fmaf(x0[r], C2, mnL);
#pragma unroll
    for (int r = 0; r < 16; ++r) x1[r] = fmaf(x1[r], C2, mnL);
#pragma unroll
    for (int r = 0; r < 6; ++r) x0[r] = __builtin_amdgcn_exp2f(x0[r]);
    SBAR();
    asm volatile("s_waitcnt lgkmcnt(0)" ::: "memory"); SBAR(); MM4(B, 3);
#pragma unroll
    for (int r = 6; r < 16; ++r) x0[r] = __builtin_amdgcn_exp2f(x0[r]);
#undef MX3
#undef MM4
#undef RD8
#undef TRRD
}
#undef KRD
#undef KWAIT
#undef PK4
struct BlockRef { const bf16* Q; const bf16* K; const bf16* V; bf16* O; int P0; };
#define WAIT_BAR(N) asm volatile("s_waitcnt vmcnt(" #N ") lgkmcnt(0)\n\ts_barrier" ::: "memory")
__device__ __forceinline__ void attn_block(const BlockRef& cur, char* lds) {
    const int tid = opaque_tid(), wid = __builtin_amdgcn_readfirstlane(tid >> 6), lane = tid & 63, r32 = lane & 31, hi = lane >> 5;
    const int NT = cur.P0 / KVBLK + QB / KVBLK;
    const int qlo = cur.P0 + wid * QBLK, qm = qlo + r32 - 4 * hi;
    char* V_lds = lds; char* K_lds = lds + NSLOT * SHM_V;
    float* ws = (float*)(lds + LDS_WS) + wid * 64; float* li_l = ws, * al_l = ws + 32;
    float m_reg = -1e30f, l_reg = 0; f32x16 o[4] = {};
    const unsigned lds0 = (unsigned)(uintptr_t)lds;
    const int vb0 = (int)lds0 + v_rd_base(lane);
    unsigned kgo[3], vgo[2];
#pragma unroll
    for (int i = 0; i < 3; ++i) { const int ob = (wid * 3 + i) * 1024 + lane * 16, row = ob / 384, rem = ob % 384, g = rem >> 7, cp = (rem & 127) >> 4, c = cp ^ KS3(row);
        kgo[i] = (unsigned)(row * 384 + g * 128 + c * 16); }
#pragma unroll
    for (int i = 0; i < 2; ++i) { const int ob = (wid * 2 + i) * 1024 + lane * 16, st = ob >> 9, rem = ob & 511, kk = (st >> 2) * 8 + (rem >> 6), c = (st & 3) * 32 + ((rem & 63) >> 1);
        const int k = (kk & ~0xC) | ((kk & 4) << 1) | ((kk & 8) >> 1);
        vgo[i] = (unsigned)(k * 256 + c * 2); }
    const char* Kg = (const char*)cur.K; const char* Vg = (const char*)cur.V;
#define DMA_K(t, slot) do { const char* kt_ = Kg + (size_t)(t) * (KVBLK * DQ * 2); const unsigned kd_ = lds0 + NSLOT * SHM_V + (slot) * SHM_K + wid * 3072;                \
        glds16(kt_ + kgo[0], (unsigned)__builtin_amdgcn_readfirstlane(kd_)); glds16(kt_ + kgo[1], (unsigned)__builtin_amdgcn_readfirstlane(kd_ + 1024));           \
        glds16(kt_ + kgo[2], (unsigned)__builtin_amdgcn_readfirstlane(kd_ + 2048)); } while (0)
#define DMA_V(t, slot) do { const char* vt_ = Vg + (size_t)(t) * (KVBLK * DV * 2); const unsigned vd_ = lds0 + (slot) * SHM_V + wid * 2048;                                  \
        glds16(vt_ + vgo[0], (unsigned)__builtin_amdgcn_readfirstlane(vd_)); glds16(vt_ + vgo[1], (unsigned)__builtin_amdgcn_readfirstlane(vd_ + 1024)); } while (0)
    DMA_K(0, 0); DMA_V(0, 0); DMA_K(1, 1); DMA_K(2, 2); DMA_V(1, 1);
    bf16x8 qr[12];
#pragma unroll
    for (int d0 = 0; d0 < 12; ++d0) qr[d0] = load8(cur.Q + (size_t)(wid * QBLK + r32) * DQ + d0 * 16 + hi * 8);
    WAIT_BAR(0);
    __builtin_amdgcn_s_waitcnt(0);
#pragma unroll
    for (int d0 = 0; d0 < 12; ++d0) asm volatile("" : "+v"(qr[d0]));
#define RESC(a) do { if (__any((a) < 1.f)) { if (hi == 0) al_l[r32] = (a); asm volatile("s_waitcnt lgkmcnt(0)" ::: "memory");              \
                     for (int d_ = 0; d_ < 4; ++d_) for (int r = 0; r < 16; ++r) o[d_][r] *= al_l[crow(r, hi)]; } } while (0)
#define KBASE(t) ((t) * KVBLK)
#define MASKT(P0_, P1_, t) do { const int kb_ = KBASE(t); if (kb_ + KVBLK - 1 > qlo) mask_tile(P0_, P1_, qm - kb_); } while (0)
    f32x16 pA0, pA1, pB0, pB1; float mnA, mnB, alA, alB; bf16x8 pa0, pa1, pa2, pa3;
    int ks0 = 0, ks1 = 1, ks2 = 2;
    qkt(pA0, pA1, lds0 + NSLOT * SHM_V, r32, hi, qr); SBAR();
    MASKT(pA0, pA1, 0); partialSM(pA0, pA1, m_reg, mnA, alA);
    asm volatile("s_waitcnt lgkmcnt(0)\n\ts_barrier" ::: "memory");
#define HALF_STEP(PX0, PX1, mnX, alX, PY0, PY1, alY, t) do {                                                                   \
        if ((t) + 2 < NT) DMA_K((t) + 2, ks0); if ((t) + 1 < NT) DMA_V((t) + 1, ks2);                                         \
        SBAR(); qkt_fin(PX0, PX1, lds0 + NSLOT * SHM_V + ks1 * SHM_K, r32, hi, qr, PY0, PY1, alY, l_reg, pa0, pa1, pa2, pa3); SBAR(); \
        MASKT(PX0, PX1, (t));                                                                                                 \
        pv_part(o, vb0 + ks0 * SHM_V, pa0, pa1, pa2, pa3, PX0, PX1, m_reg, mnX, alX);                                         \
        if ((t) + 2 < NT) WAIT_BAR(5); else WAIT_BAR(0);                                                                      \
        RESC(alX); { const int k_ = ks0; ks0 = ks1; ks1 = ks2; ks2 = k_; } } while (0)
    for (int t = 1; t + 1 < NT; t += 2) {
        HALF_STEP(pB0, pB1, mnB, alB, pA0, pA1, alA, t);
        HALF_STEP(pA0, pA1, mnA, alA, pB0, pB1, alB, t + 1);
    }
    HALF_STEP(pB0, pB1, mnB, alB, pA0, pA1, alA, NT - 1);
    finishSM(pB0, pB1, alB, l_reg, pa0, pa1, pa2, pa3); SBAR();
    pv_tile(o, vb0 + ks0 * SHM_V, pa0, pa1, pa2, pa3); SBAR();
#undef HALF_STEP
    if (hi == 0) li_l[r32] = l_reg; asm volatile("s_waitcnt lgkmcnt(0)" ::: "memory");
    float rli[16];
#pragma unroll
    for (int r = 0; r < 16; ++r) rli[r] = __builtin_amdgcn_rcpf(li_l[crow(r, hi)]);
    bf16* Ow = cur.O + (size_t)(wid * QBLK) * LDO;
#pragma unroll
    for (int r = 0; r < 16; ++r) { const int orow = crow(r, hi);
#pragma unroll
        for (int d0 = 0; d0 < 4; ++d0) { const float v = o[d0][r] * rli[r];
            const float vn = __shfl_xor(v, 1);
            if ((r32 & 1) == 0) *(unsigned*)(Ow + (size_t)orow * LDO + d0 * 32 + r32) = cvtpk(v, vn); } }
    WAIT_BAR(0);
#undef RESC
#undef KBASE
#undef MASKT
#undef DMA_K
#undef DMA_V
}
#undef WAIT_BAR
struct Item { int bh, qb0, qb1; };
__device__ __forceinline__ Item decode(int L) { Item it; const int xcd = L & 7, k = L >> 3; it.bh = (k >> 4) * 8 + xcd; const int x = k & 15; it.qb0 = x; it.qb1 = 31 - x; return it; }
__device__ __forceinline__ BlockRef mkref(const Item& it, int pass, const bf16* Q, const bf16* K, const bf16* V, bf16* mixed) {
    const int qb = pass ? it.qb1 : it.qb0; BlockRef r;
    r.Q = Q + ((size_t)it.bh * SEQL + (size_t)qb * QB) * DQ; r.K = K + (size_t)it.bh * SEQL * DQ; r.V = V + (size_t)it.bh * SEQL * DV;
    r.O = mixed + ((size_t)(it.bh >> 2) * SEQL + (size_t)qb * QB) * LDO + 512 + (it.bh & 3) * 128; r.P0 = qb * QB;
    return r;
}
__device__ __forceinline__ void attn_phase(char* lds, const bf16* Q, const bf16* K, const bf16* V, bf16* mixed) {
    for (int L = blockIdx.x; L < 256; L += GRID) {
        const Item it = decode(L);
        attn_block(mkref(it, 0, Q, K, V, mixed), lds);
        attn_block(mkref(it, 1, Q, K, V, mixed), lds);
    }
}
#undef KSWZ
#undef KS3
#undef SBAR
}
namespace mk {
typedef unsigned short bf16_t;
typedef short bf16x8 __attribute__((ext_vector_type(8)));
typedef float f32x4 __attribute__((ext_vector_type(4)));
typedef float f32x2 __attribute__((ext_vector_type(2)));
typedef float f32x16 __attribute__((ext_vector_type(16)));
typedef unsigned u32x2 __attribute__((ext_vector_type(2)));
typedef unsigned u32x4 __attribute__((ext_vector_type(4)));
constexpr int NB = 4, SEQ = 8192, T = NB * SEQ, DM = 1024, DEPTH = 2, DFF = 4096, NIN = 2048, NMOD = 6 * DM;
constexpr float EPS = 1e-6f;
constexpr size_t MiB = 1u << 20;
constexpr size_t W_IN = 0, W_Q = 4 * MiB, W_KV = W_Q + 384 * 1024, W_O = W_KV + 256 * 1024, W_1 = W_O + 2 * MiB, W_2 = W_1 + 8 * MiB, W_LAYER = 23 * MiB;
static_assert(W_2 + 8 * MiB <= W_LAYER, "weights");
constexpr size_t WS_W = 0, WS_MOD = 46 * MiB, WS_COS = 47 * MiB, WS_SIN = 51 * MiB, WS_HN = 55 * MiB, WS_QN = 119 * MiB, WS_KVN = 135 * MiB,
                 WS_GST = 143 * MiB, WS_GDV = 207 * MiB, WS_R = 208 * MiB, WS_BT = 464 * MiB, WS_RSS = 496 * MiB, WS_BIAS = 497 * MiB, WS_END = 498 * MiB;
constexpr size_t WS_BAR = WS_MOD + 512 * 1024;
constexpr size_t R_PROJ = 0, R_Q = 128 * MiB, R_K = 176 * MiB, R_V = 224 * MiB;
constexpr int MISC_OFF = 157696;
constexpr int LDS_BYTES = MISC_OFF + 64;
constexpr int EPI_OFF = 131072;

__device__ __forceinline__ float bf2f(unsigned short v) { return __uint_as_float((unsigned)v << 16); }
typedef __bf16 hwbf16x2 __attribute__((ext_vector_type(2)));
__device__ __forceinline__ unsigned pk2(float lo, float hi) { const f32x2 v = {lo, hi}; return __builtin_bit_cast(unsigned, __builtin_convertvector(v, hwbf16x2)); }
__device__ __forceinline__ unsigned f2bf(float f) { return pk2(f, 0.f) & 0xffffu; }
__device__ __forceinline__ float wave_sum(float v) {
#pragma unroll
    for (int o = 1; o < 64; o <<= 1) v += __shfl_xor(v, o);
    return v;
}
__device__ __forceinline__ float half_sum32(float v) {
#pragma unroll
    for (int o = 1; o < 32; o <<= 1) v += __shfl_xor(v, o);
    return v;
}
__device__ __forceinline__ int crow(int r, int hi) { return (r & 3) + 8 * (r >> 2) + 4 * hi; }

__device__ __forceinline__ int src_col(int map, int n) {
    if (map == 1) { if (n < 1536) return n; if (n < 1984) return n + 16; if (n < 2000) return n - 1984 + 1536; return -1; }
    if (map == 2) { if (n < 512) return (n >> 7) * 192 + (n & 127); const int c = n - 512, bj = c >> 7, hd = (c & 127) >> 5, w = c & 31; return hd * 192 + 128 + 32 * bj + w; }
    return n;
}
__device__ __forceinline__ void transpose_item(const float* W, int K, int N, int NP, bf16_t* WT, int map, LAS float* scr, int item, int lane) {
    const int nblk = NP / 32, kb = item / nblk, nb = item % nblk, k0 = 64 * kb, n0 = 32 * nb;
    const int n4 = (lane & 7) * 4, kr = lane >> 3;
    const int sc = src_col(map, n0 + n4);
    f32x4 tv[8];
#pragma unroll
    for (int i = 0; i < 8; ++i) tv[i] = sc >= 0 ? *(const f32x4*)(W + (size_t)(k0 + 8 * i + kr) * N + sc) : (f32x4){0.f, 0.f, 0.f, 0.f};
#pragma unroll
    for (int i = 0; i < 8; ++i) { LAS float* d = scr + (8 * i + kr) * 33 + n4; d[0] = tv[i][0]; d[1] = tv[i][1]; d[2] = tv[i][2]; d[3] = tv[i][3]; }
    asm volatile("s_waitcnt lgkmcnt(0)" ::: "memory");
    const int c = lane & 7;
#pragma unroll
    for (int j = 0; j < 4; ++j) { const int n = (lane >> 3) + 8 * j; const LAS float* s = scr + (8 * c) * 33 + n;
        u32x4 o; o.x = pk2(s[0 * 33], s[1 * 33]); o.y = pk2(s[2 * 33], s[3 * 33]); o.z = pk2(s[4 * 33], s[5 * 33]); o.w = pk2(s[6 * 33], s[7 * 33]);
        *(u32x4*)(WT + (size_t)(n0 + n) * K + k0 + 8 * c) = o; }
    asm volatile("s_waitcnt lgkmcnt(0)" ::: "memory");
}
__device__ __forceinline__ void adaln_unit(int u, const float* c, const float* w_ada, const float* b_ada, float* mod, LAS float* lds) {
    const int tid = opaque_tid(), wave = tid >> 6, lane = tid & 63;
    const int l = u / 96, n0 = (u % 96) * 64;
    LAS float* sc = lds; LAS float* red = lds + 4096;
    for (int i = tid; i < 4096; i += 512) { const float v = c[i]; sc[i] = v / (1.0f + __expf(-v)); }
    __syncthreads();
    const int n4 = (lane & 15) * 4, kq = lane >> 4;
    const float* wp = w_ada + (size_t)l * DM * NMOD + n0 + n4;
    f32x4 a0 = {0.f, 0.f, 0.f, 0.f}, a1 = a0, a2 = a0, a3 = a0;
#pragma unroll 16
    for (int i = 0; i < 32; ++i) { const int k = wave * 128 + 4 * i + kq; const f32x4 w = *(const f32x4*)(wp + (size_t)k * NMOD);
        a0 += w * sc[k]; a1 += w * sc[1024 + k]; a2 += w * sc[2048 + k]; a3 += w * sc[3072 + k]; }
#pragma unroll
    for (int e2 = 0; e2 < 4; ++e2) { a0[e2] += __shfl_xor(a0[e2], 16); a0[e2] += __shfl_xor(a0[e2], 32); a1[e2] += __shfl_xor(a1[e2], 16); a1[e2] += __shfl_xor(a1[e2], 32);
                                     a2[e2] += __shfl_xor(a2[e2], 16); a2[e2] += __shfl_xor(a2[e2], 32); a3[e2] += __shfl_xor(a3[e2], 16); a3[e2] += __shfl_xor(a3[e2], 32); }
    if (kq == 0) {
#pragma unroll
        for (int e2 = 0; e2 < 4; ++e2) { red[(wave * 4 + 0) * 64 + n4 + e2] = a0[e2]; red[(wave * 4 + 1) * 64 + n4 + e2] = a1[e2]; red[(wave * 4 + 2) * 64 + n4 + e2] = a2[e2]; red[(wave * 4 + 3) * 64 + n4 + e2] = a3[e2]; } }
    __syncthreads();
    if (tid < 256) { const int b = tid >> 6; float s = b_ada[(size_t)l * NMOD + n0 + lane];
#pragma unroll
        for (int w = 0; w < 8; ++w) s += red[(w * 4 + b) * 64 + lane];
        mod[((size_t)l * 4 + b) * NMOD + n0 + lane] = s; }
    __syncthreads();
}
__device__ __forceinline__ void prenorm_rows(const float* __restrict__ xin, bf16_t* __restrict__ an, float* __restrict__ rss, const float* __restrict__ modl, int coff) {
    const int tid = opaque_tid(), lane = tid & 63, gw = blockIdx.x * 8 + (tid >> 6), NGW = GRID * 8;
#pragma unroll 4
    for (int t = gw; t < T; t += NGW) {
        const f32x4* xr = (const f32x4*)(xin + (size_t)t * DM) + lane; f32x4 v[4]; float ss = 0.f;
#pragma unroll
        for (int j = 0; j < 4; ++j) { v[j] = xr[64 * j]; ss += (v[j][0] * v[j][0] + v[j][1] * v[j][1]) + (v[j][2] * v[j][2] + v[j][3] * v[j][3]); }
        ss = wave_sum(ss); if (lane == 0) rss[t] = ss;
        const float* mb = modl + (size_t)(t >> 13) * NMOD;
#pragma unroll
        for (int j = 0; j < 4; ++j) { const int col = 256 * j + 4 * lane;
            const f32x4 sc = *(const f32x4*)(mb + coff + col);
            const f32x4 h = v[j] * (sc + 1.0f);
            u32x2 w; w.x = pk2(h[0], h[1]); w.y = pk2(h[2], h[3]); *(u32x2*)(an + (size_t)t * DM + col) = w; }
    }
}
__device__ __forceinline__ void bias_rows(const bf16_t* __restrict__ Wt, int N, const float* __restrict__ modl, int soff, float* __restrict__ bias) {
    const int tid = opaque_tid(), lane = tid & 63, gw = blockIdx.x * 8 + (tid >> 6), NGW = GRID * 8;
#pragma unroll 2
    for (int n = gw; n < N; n += NGW) {
        const u32x4 w0 = *(const u32x4*)(Wt + (size_t)n * 1024 + 16 * lane), w1 = *(const u32x4*)(Wt + (size_t)n * 1024 + 16 * lane + 8);
        float wf[16];
#pragma unroll
        for (int e2 = 0; e2 < 4; ++e2) { wf[2 * e2] = __uint_as_float(w0[e2] << 16); wf[2 * e2 + 1] = __uint_as_float(w0[e2] & 0xffff0000u);
                                         wf[8 + 2 * e2] = __uint_as_float(w1[e2] << 16); wf[8 + 2 * e2 + 1] = __uint_as_float(w1[e2] & 0xffff0000u); }
#pragma unroll
        for (int b = 0; b < 4; ++b) { const float* sp = modl + (size_t)b * NMOD + soff + 16 * lane; float s = 0.f;
#pragma unroll
            for (int q = 0; q < 4; ++q) { const f32x4 sv = *(const f32x4*)(sp + 4 * q); s += (sv[0] * wf[4 * q] + sv[1] * wf[4 * q + 1]) + (sv[2] * wf[4 * q + 2] + sv[3] * wf[4 * q + 3]); }
            s = wave_sum(s); if (lane == 0) bias[(size_t)b * N + n] = s; }
    }
}
__device__ __forceinline__ float sum16(float v) { v += __shfl_xor(v, 1); v += __shfl_xor(v, 2); v += __shfl_xor(v, 4); v += __shfl_xor(v, 8); return v; }
__device__ __forceinline__ void prep_tokens(const bf16_t* __restrict__ proj, bf16_t* __restrict__ qn, bf16_t* __restrict__ kvn, bf16_t* __restrict__ Kb, const float* __restrict__ qa, const float* __restrict__ kva, const float* __restrict__ kr,
                                            const float* __restrict__ cosT, const float* __restrict__ sinT) {
    const int tid = opaque_tid(), lane = tid & 63, sub = lane >> 4, l16 = lane & 15, gw = blockIdx.x * 8 + (tid >> 6), NGW = GRID * 8;
    f32x4 gq[4], gkv[2];
#pragma unroll
    for (int i = 0; i < 4; ++i) gq[i] = *(const f32x4*)(qa + 16 * l16 + 4 * i);
#pragma unroll
    for (int i = 0; i < 2; ++i) gkv[i] = *(const f32x4*)(kva + 8 * l16 + 4 * i);
    const f32x4 gr = *(const f32x4*)(kr + 4 * l16);
#pragma unroll 2
    for (int tg = gw; tg < T / 4; tg += NGW) { const int t = 4 * tg + sub;
        const bf16_t* pr = proj + (size_t)t * NIN;
        const u32x4 q0 = *(const u32x4*)(pr + 1536 + 16 * l16), q1 = *(const u32x4*)(pr + 1536 + 16 * l16 + 8);
        const u32x4 k0 = *(const u32x4*)(pr + 1792 + 8 * l16);
        const u32x2 p0 = *(const u32x2*)(pr + 1920 + 4 * l16);
        const f32x4 c4 = *(const f32x4*)(cosT + (size_t)t * 32 + 4 * (l16 & 7)), s4 = *(const f32x4*)(sinT + (size_t)t * 32 + 4 * (l16 & 7));
        { float f[16]; float ss = 0.f;
#pragma unroll
          for (int e2 = 0; e2 < 4; ++e2) { f[2 * e2] = __uint_as_float(q0[e2] << 16); f[2 * e2 + 1] = __uint_as_float(q0[e2] & 0xffff0000u); f[8 + 2 * e2] = __uint_as_float(q1[e2] << 16); f[8 + 2 * e2 + 1] = __uint_as_float(q1[e2] & 0xffff0000u); }
#pragma unroll
          for (int e2 = 0; e2 < 16; ++e2) ss += f[e2] * f[e2];
          const float rr = __builtin_amdgcn_rsqf(sum16(ss) * (1.0f / 256.0f) + EPS);
          u32x4 o0, o1;
#pragma unroll
          for (int e2 = 0; e2 < 4; ++e2) { o0[e2] = pk2(f[2 * e2] * rr * gq[e2 >> 1][2 * (e2 & 1)], f[2 * e2 + 1] * rr * gq[e2 >> 1][2 * (e2 & 1) + 1]);
                                           o1[e2] = pk2(f[8 + 2 * e2] * rr * gq[2 + (e2 >> 1)][2 * (e2 & 1)], f[8 + 2 * e2 + 1] * rr * gq[2 + (e2 >> 1)][2 * (e2 & 1) + 1]); }
          *(u32x4*)(qn + (size_t)t * 256 + 16 * l16) = o0; *(u32x4*)(qn + (size_t)t * 256 + 16 * l16 + 8) = o1; }
        { float f[8]; float ss = 0.f;
#pragma unroll
          for (int e2 = 0; e2 < 4; ++e2) { f[2 * e2] = __uint_as_float(k0[e2] << 16); f[2 * e2 + 1] = __uint_as_float(k0[e2] & 0xffff0000u); }
#pragma unroll
          for (int e2 = 0; e2 < 8; ++e2) ss += f[e2] * f[e2];
          const float rr = __builtin_amdgcn_rsqf(sum16(ss) * (1.0f / 128.0f) + EPS);
          u32x4 o0;
#pragma unroll
          for (int e2 = 0; e2 < 4; ++e2) o0[e2] = pk2(f[2 * e2] * rr * gkv[e2 >> 1][2 * (e2 & 1)], f[2 * e2 + 1] * rr * gkv[e2 >> 1][2 * (e2 & 1) + 1]);
          *(u32x4*)(kvn + (size_t)t * 128 + 8 * l16) = o0; }
        { float y[4] = {__uint_as_float(p0[0] << 16), __uint_as_float(p0[0] & 0xffff0000u), __uint_as_float(p0[1] << 16), __uint_as_float(p0[1] & 0xffff0000u)};
          const float rr = __builtin_amdgcn_rsqf(sum16((y[0] * y[0] + y[1] * y[1]) + (y[2] * y[2] + y[3] * y[3])) * (1.0f / 64.0f) + EPS);
          float ov[4];
#pragma unroll
          for (int i = 0; i < 4; ++i) { y[i] = y[i] * rr * gr[i]; const float pn = __shfl_xor(y[i], 8);
              ov[i] = l16 < 8 ? y[i] * c4[i] - pn * s4[i] : y[i] * c4[i] + pn * s4[i]; }
          u32x2 w; w.x = pk2(ov[0], ov[1]); w.y = pk2(ov[2], ov[3]);
          const int b = t >> 13, sp = t & 8191;
#pragma unroll
          for (int h = 0; h < 4; ++h) *(u32x2*)(Kb + ((size_t)(b * 4 + h) * SEQ + sp) * 192 + 128 + 4 * l16) = w; }
    }
}
__device__ __forceinline__ void gla_pass_a(LAS unsigned char* ldsl, const bf16_t* __restrict__ proj, const float* __restrict__ wgu, const float* __restrict__ bg, float* __restrict__ Btab, float* __restrict__ Gst, float* __restrict__ Gdv) {
    const int tid = opaque_tid(), lane = tid & 63, r = lane & 31, hh = lane >> 5, wv = tid >> 6, gw = blockIdx.x * 8 + wv, NGW = GRID * 8;
    LAS float* Bw = (LAS float*)(ldsl + wv * 16384);
    LAS unsigned char* Tl = ldsl + wv * 16384 + 8192;
    LAS bf16_t* Th = (LAS bf16_t*)Tl;
    for (int u = gw; u < 16 * 128 * 2; u += NGW) { const int item = u >> 1, dkb = u & 1;
        const int bh = item >> 7, n = item & 127, b = bh >> 2, h = bh & 3; const size_t row0 = (size_t)b * SEQ + (size_t)n * 64;
        const int dk = 32 * dkb + r;
        { const bf16_t* kp = proj + (row0 + (lane >> 3)) * NIN + 256 + h * 64 + (lane & 7) * 8; u32x4 sv[8];
#pragma unroll
          for (int i = 0; i < 8; ++i) sv[i] = *(const u32x4*)(kp + (size_t)(8 * i) * NIN);
#pragma unroll
          for (int i = 0; i < 8; ++i) *(LAS u32x4*)(Tl + (8 * i + (lane >> 3)) * 128 + (lane & 7) * 16) = sv[i]; }
        float bl;
        { float w[16];
#pragma unroll
          for (int q = 0; q < 16; ++q) w[q] = wgu[q * 256 + h * 64 + dk];
          const float bias = bg[h * 64 + dk];
          float loc[32]; float a = 0.f;
#pragma unroll
          for (int t0 = 0; t0 < 32; t0 += 8) { u32x4 g0[8], g1[8];
#pragma unroll
              for (int i = 0; i < 8; ++i) { const bf16_t* ga = proj + (row0 + 32 * hh + t0 + i) * NIN + 1984; g0[i] = *(const u32x4*)ga; g1[i] = *(const u32x4*)(ga + 8); }
#pragma unroll
              for (int i = 0; i < 8; ++i) { float x = bias;
#pragma unroll
                  for (int e2 = 0; e2 < 4; ++e2) { x += __uint_as_float(g0[i][e2] << 16) * w[2 * e2] + __uint_as_float(g0[i][e2] & 0xffff0000u) * w[2 * e2 + 1];
                                                   x += __uint_as_float(g1[i][e2] << 16) * w[8 + 2 * e2] + __uint_as_float(g1[i][e2] & 0xffff0000u) * w[8 + 2 * e2 + 1]; }
                  a += (fminf(x, 0.f) - __logf(1.0f + __expf(-fabsf(x)))) * (1.0f / 16.0f);
                  loc[t0 + i] = a; } }
          const float tot0 = __shfl(a, r);
          const float off = hh ? tot0 : 0.f;
#pragma unroll
          for (int t = 0; t < 32; ++t) { const float v = loc[t] + off; Bw[(32 * hh + t) * 32 + r] = v; Btab[(row0 + 32 * hh + t) * 256 + h * 64 + dk] = v; }
          bl = Bw[63 * 32 + r]; }
        bf16x8 bv[4];
#pragma unroll
        for (int ks = 0; ks < 4; ++ks) { u32x4 w;
#pragma unroll
            for (int j2 = 0; j2 < 4; ++j2) { const int t = 16 * ks + 8 * hh + 2 * j2;
                w[j2] = pk2(bf2f(Th[t * 64 + dk]) * __expf(bl - Bw[t * 32 + r]), bf2f(Th[(t + 1) * 64 + dk]) * __expf(bl - Bw[(t + 1) * 32 + r])); }
            bv[ks] = __builtin_bit_cast(bf16x8, w); }
        f32x16 acc[4] = {};
#pragma unroll
        for (int half = 0; half < 2; ++half) {
            { const bf16_t* vp = proj + (row0 + 32 * half + (lane >> 4)) * NIN + 512 + h * 128 + (lane & 15) * 8; u32x4 sv[8];
#pragma unroll
              for (int i = 0; i < 8; ++i) sv[i] = *(const u32x4*)(vp + (size_t)(4 * i) * NIN);
#pragma unroll
              for (int i = 0; i < 8; ++i) *(LAS u32x4*)(Tl + (4 * i + (lane >> 4)) * 256 + (lane & 15) * 16) = sv[i]; }
#pragma unroll
            for (int k2 = 0; k2 < 2; ++k2)
#pragma unroll
                for (int dvb = 0; dvb < 4; ++dvb) { bf16x8 av;
#pragma unroll
                    for (int j = 0; j < 8; ++j) av[j] = (short)Th[(16 * k2 + 8 * hh + j) * 128 + 32 * dvb + r];
                    acc[dvb] = __builtin_amdgcn_mfma_f32_32x32x16_bf16(av, bv[2 * half + k2], acc[dvb], 0, 0, 0); } }
#pragma unroll
        for (int dvb = 0; dvb < 4; ++dvb) { float* go = Gst + ((size_t)item * 128 + 32 * dvb) * 64 + dk;
#pragma unroll
            for (int i = 0; i < 16; ++i) go[(size_t)crow(i, hh) * 64] = acc[dvb][i]; }
        if (hh == 0) Gdv[(size_t)item * 64 + dk] = __expf(bl);
    }
}
__device__ __forceinline__ void gla_scan(float* __restrict__ Gst, const float* __restrict__ Gdv) {
    const int gt = blockIdx.x * 512 + opaque_tid(), GT = GRID * 512;
    for (int e = gt; e < 16 * 8192; e += GT) { const int bh = e >> 13, idx = e & 8191, dk = idx & 63;
        float* base = Gst + (size_t)bh * 128 * 8192 + idx; const float* dvp = Gdv + (size_t)bh * 128 * 64 + dk;
        float s = 0.f;
        for (int n0 = 0; n0 < 128; n0 += 32) { float u[32], dd[32];
#pragma unroll
            for (int i = 0; i < 32; ++i) { u[i] = base[(size_t)(n0 + i) * 8192]; dd[i] = dvp[(n0 + i) * 64]; }
#pragma unroll
            for (int i = 0; i < 32; ++i) { base[(size_t)(n0 + i) * 8192] = s; s = dd[i] * s + u[i]; } }
    }
}
__device__ __forceinline__ void gla_pass_c(LAS unsigned char* ldsl, const bf16_t* __restrict__ proj, const float* __restrict__ Btab, const float* __restrict__ Gst, const float* __restrict__ gout, bf16_t* __restrict__ mixed) {
    const int tid = opaque_tid(), lane = tid & 63, r = lane & 31, hh = lane >> 5, wv = tid >> 6, gw = blockIdx.x * 8 + wv, NGW = GRID * 8;
    LAS unsigned char* Lw = ldsl + wv * 16384;
    LAS bf16_t* Lh = (LAS bf16_t*)Lw;
    const int crw = lane >> 4, ccl = lane & 15;
    for (int u = gw; u < 16 * 128 * 2; u += NGW) { const int item = u >> 1, tb = __builtin_amdgcn_readfirstlane((u ^ (u >> 11) ^ (u >> 3)) & 1);
        const int bh = item >> 7, n = item & 127, b = bh >> 2, h = bh & 3; const size_t row0 = (size_t)b * SEQ + (size_t)n * 64;
        const int tl = 32 * tb + r;
        { const bf16_t* vp = proj + (row0 + crw) * NIN + 512 + h * 128 + ccl * 8; u32x4 sv[8];
#pragma unroll
          for (int i = 0; i < 8; ++i) sv[i] = *(const u32x4*)(vp + (size_t)(4 * i) * NIN);
#pragma unroll
          for (int i = 0; i < 8; ++i) *(LAS u32x4*)(Lw + (4 * i + crw) * 256 + ccl * 16) = sv[i];
          if (tb) {
#pragma unroll
              for (int i = 0; i < 8; ++i) sv[i] = *(const u32x4*)(vp + (size_t)(32 + 4 * i) * NIN);
#pragma unroll
              for (int i = 0; i < 8; ++i) *(LAS u32x4*)(Lw + (32 + 4 * i + crw) * 256 + ccl * 16) = sv[i]; } }
        bf16x8 qe[4];
        { const bf16_t* qp = proj + (row0 + tl) * NIN + h * 64; const float* bp = Btab + (row0 + tl) * 256 + h * 64;
#pragma unroll
          for (int ks = 0; ks < 4; ++ks) { const u32x4 qw = *(const u32x4*)(qp + 16 * ks + 8 * hh); const f32x4 b0 = *(const f32x4*)(bp + 16 * ks + 8 * hh), b1 = *(const f32x4*)(bp + 16 * ks + 8 * hh + 4);
              u32x4 w; w.x = pk2(__uint_as_float(qw[0] << 16) * 0.125f * __expf(b0[0]), __uint_as_float(qw[0] & 0xffff0000u) * 0.125f * __expf(b0[1]));
                       w.y = pk2(__uint_as_float(qw[1] << 16) * 0.125f * __expf(b0[2]), __uint_as_float(qw[1] & 0xffff0000u) * 0.125f * __expf(b0[3]));
                       w.z = pk2(__uint_as_float(qw[2] << 16) * 0.125f * __expf(b1[0]), __uint_as_float(qw[2] & 0xffff0000u) * 0.125f * __expf(b1[1]));
                       w.w = pk2(__uint_as_float(qw[3] << 16) * 0.125f * __expf(b1[2]), __uint_as_float(qw[3] & 0xffff0000u) * 0.125f * __expf(b1[3]));
              qe[ks] = __builtin_bit_cast(bf16x8, w); } }
        f32x16 o[4] = {};
#pragma unroll
        for (int dvb = 0; dvb < 4; ++dvb) { const float* sp = Gst + ((size_t)item * 128 + 32 * dvb + r) * 64;
#pragma unroll
          for (int ks = 0; ks < 4; ++ks) { const f32x4 s0 = *(const f32x4*)(sp + 16 * ks + 8 * hh), s1 = *(const f32x4*)(sp + 16 * ks + 8 * hh + 4);
              u32x4 sw; sw.x = pk2(s0[0], s0[1]); sw.y = pk2(s0[2], s0[3]); sw.z = pk2(s1[0], s1[1]); sw.w = pk2(s1[2], s1[3]);
              o[dvb] = __builtin_amdgcn_mfma_f32_32x32x16_bf16(qe[ks], __builtin_bit_cast(bf16x8, sw), o[dvb], 0, 0, 0); } }
        for (int sb = 0; sb <= tb; ++sb) {
            f32x16 x = {};
            const int sl = 32 * sb + r; const bf16_t* kp = proj + (row0 + sl) * NIN + 256 + h * 64; const float* bp = Btab + (row0 + sl) * 256 + h * 64;
#pragma unroll
            for (int ks = 0; ks < 4; ++ks) { const u32x4 kw = *(const u32x4*)(kp + 16 * ks + 8 * hh); const f32x4 b0 = *(const f32x4*)(bp + 16 * ks + 8 * hh), b1 = *(const f32x4*)(bp + 16 * ks + 8 * hh + 4);
                u32x4 w; w.x = pk2(__uint_as_float(kw[0] << 16) * __expf(-b0[0]), __uint_as_float(kw[0] & 0xffff0000u) * __expf(-b0[1]));
                         w.y = pk2(__uint_as_float(kw[1] << 16) * __expf(-b0[2]), __uint_as_float(kw[1] & 0xffff0000u) * __expf(-b0[3]));
                         w.z = pk2(__uint_as_float(kw[2] << 16) * __expf(-b1[0]), __uint_as_float(kw[2] & 0xffff0000u) * __expf(-b1[1]));
                         w.w = pk2(__uint_as_float(kw[3] << 16) * __expf(-b1[2]), __uint_as_float(kw[3] & 0xffff0000u) * __expf(-b1[3]));
                x = __builtin_amdgcn_mfma_f32_32x32x16_bf16(__builtin_bit_cast(bf16x8, w), qe[ks], x, 0, 0, 0); }
            if (sb == tb) {
#pragma unroll
                for (int i = 0; i < 16; ++i) if (crow(i, hh) > r) x[i] = 0.f; }
#pragma unroll
            for (int s2 = 0; s2 < 2; ++s2) { u32x4 xw; xw.x = pk2(x[8 * s2], x[8 * s2 + 1]); xw.y = pk2(x[8 * s2 + 2], x[8 * s2 + 3]); xw.z = pk2(x[8 * s2 + 4], x[8 * s2 + 5]); xw.w = pk2(x[8 * s2 + 6], x[8 * s2 + 7]);
#pragma unroll
                for (int dvb = 0; dvb < 4; ++dvb) { bf16x8 vb;
#pragma unroll
                    for (int j = 0; j < 8; ++j) { const int sk = 32 * sb + 16 * s2 + 8 * (j >> 2) + 4 * hh + (j & 3); vb[j] = (short)Lh[sk * 128 + 32 * dvb + r]; }
                    o[dvb] = __builtin_amdgcn_mfma_f32_32x32x16_bf16(__builtin_bit_cast(bf16x8, xw), vb, o[dvb], 0, 0, 0); } } }
        { const bf16_t* gp = proj + (row0 + 32 * tb + crw) * NIN + 1024 + h * 128 + ccl * 8; u32x4 sv[8];
#pragma unroll
          for (int i = 0; i < 8; ++i) sv[i] = *(const u32x4*)(gp + (size_t)(4 * i) * NIN);
#pragma unroll
          for (int i = 0; i < 8; ++i) *(LAS u32x4*)(Lw + (4 * i + crw) * 256 + ccl * 16) = sv[i]; }
        float gn[4];
#pragma unroll
        for (int dvb = 0; dvb < 4; ++dvb) gn[dvb] = gout[32 * dvb + r];
#pragma unroll
        for (int i = 0; i < 16; ++i) { const int tr = crow(i, hh);
            const float tot = half_sum32((o[0][i] * o[0][i] + o[1][i] * o[1][i]) + (o[2][i] * o[2][i] + o[3][i] * o[3][i]));
            const float rr = __builtin_amdgcn_rsqf(tot * (1.0f / 128.0f) + EPS);
#pragma unroll
            for (int dvb = 0; dvb < 4; ++dvb) { const float g = bf2f(Lh[tr * 128 + 32 * dvb + r]);
                const float val = o[dvb][i] * rr * gn[dvb] * (g * __builtin_amdgcn_rcpf(1.0f + __expf(-g)));
                Lh[(32 + tr) * 128 + 32 * dvb + r] = (bf16_t)f2bf(val); } }
        { bf16_t* mp = mixed + (row0 + 32 * tb + crw) * DM + h * 128 + ccl * 8;
#pragma unroll
          for (int i = 0; i < 8; ++i) *(u32x4*)(mp + (size_t)(4 * i) * DM) = *(const LAS u32x4*)(Lw + (32 + 4 * i + crw) * 256 + ccl * 16); }
    }
}
}
#define XB_TMO      128
#define XB_XCNT(j)  (256  + 64 * (j))
#define XB_XSUB(j)  (1280 + 64 * (j))
#define XB_XGEN(j)  (2304 + 64 * (j))
#define XB_TOP      3328
#define XB_TOPGEN   3392
#define XCD_BAR_WORDS 3456
#define XB_SPIN_CAP (1u << 18)

__device__ __forceinline__ unsigned xb_ld(unsigned* p)              { return __hip_atomic_load(p, __ATOMIC_RELAXED, __HIP_MEMORY_SCOPE_AGENT); }
__device__ __forceinline__ unsigned xb_add(unsigned* p, unsigned v) { return __hip_atomic_fetch_add(p, v, __ATOMIC_RELAXED, __HIP_MEMORY_SCOPE_AGENT); }
__device__ __forceinline__ unsigned xb_xcc_id() { return (unsigned)__builtin_amdgcn_s_getreg((3 << 11) | 20) & 0xFu; }
#define XB_SPIN(cond, bar) do { unsigned _sp = 0; while (cond) { __builtin_amdgcn_s_sleep(1); \
    if ((++_sp & 255u) == 0u) { if (xb_ld(&(bar)[XB_TMO])) break; if (_sp > XB_SPIN_CAP) { atomicAdd(&(bar)[XB_TMO], 1u); break; } } } } while (0)

struct XcdBarrier {
    unsigned* bar; unsigned x;
    volatile LAS unsigned* st;
};

__device__ __forceinline__ XcdBarrier xcd_barrier_post(unsigned* bar, volatile LAS unsigned* st) {
    XcdBarrier b; b.bar = bar; b.x = xb_xcc_id(); b.st = st;
    if (threadIdx.x == 0) (void)xb_add(&bar[XB_XCNT(b.x)], 1u);
    return b;
}
__device__ __forceinline__ void xcd_barrier_complete(unsigned* bar, unsigned x, unsigned& nloc, unsigned& nx) {
    const unsigned G = gridDim.x * gridDim.y * gridDim.z;
    unsigned sum, cnt, mine, sp = 0u;
    for (;;) {
        sum = 0u; cnt = 0u; mine = 0u;
#pragma unroll
        for (unsigned j = 0; j < 16; ++j) { const unsigned c = xb_ld(&bar[XB_XCNT(j)]); sum += c; cnt += (c > 0u) ? 1u : 0u; mine = (j == x) ? c : mine; }
        if (sum == G) break;
        __builtin_amdgcn_s_sleep(1);
        if ((++sp & 255u) == 0u) { if (xb_ld(&bar[XB_TMO])) break; if (sp > XB_SPIN_CAP) { atomicAdd(&bar[XB_TMO], 1u); break; } }
    }
    nloc = mine > 0u ? mine : 1u; nx = cnt > 0u ? cnt : 1u;
}

__device__ __forceinline__ void xcd_barrier(const XcdBarrier& b) {
    asm volatile("s_waitcnt vmcnt(0)" ::: "memory");
    __syncthreads();
    if (threadIdx.x == 0) {
        unsigned* bar = b.bar; unsigned bx = b.x; asm volatile("" : "+s"(bx));
        __builtin_amdgcn_s_waitcnt(0);
        unsigned nloc = b.st[0], nx = b.st[1];
        if (nloc == 0u) { xcd_barrier_complete(bar, bx, nloc, nx); b.st[0] = nloc; b.st[1] = nx; }
        const unsigned old = xb_add(&bar[XB_XSUB(bx)], 1u);
        const unsigned gen = old / nloc;
        if (old + 1u == (gen + 1u) * nloc) {
            __builtin_amdgcn_fence(__ATOMIC_RELEASE, "agent");
            asm volatile("s_waitcnt vmcnt(0)" ::: "memory");
            const unsigned og = xb_add(&bar[XB_TOP], 1u);
            const unsigned tg = og / nx;
            if (og + 1u == (tg + 1u) * nx) xb_add(&bar[XB_TOPGEN], 1u);
            else XB_SPIN(xb_ld(&bar[XB_TOPGEN]) == tg, bar);
            __builtin_amdgcn_fence(__ATOMIC_ACQUIRE, "agent");
            xb_add(&bar[XB_XGEN(bx)], 1u);
            asm volatile("s_waitcnt vmcnt(0)" ::: "memory");
        } else {
            XB_SPIN(xb_ld(&bar[XB_XGEN(bx)]) == gen, bar);
            __builtin_amdgcn_fence(__ATOMIC_ACQUIRE, "agent");
            asm volatile("s_waitcnt vmcnt(0)" ::: "memory");
        }
    }
    __syncthreads();
}
#ifndef PHM
#define PHM 0xffff
#endif
#ifndef REP
#define REP 0
#endif
#ifndef USE_XB
#define USE_XB 1
#endif
#if USE_XB
#define GSYNC() xcd_barrier(xbar)
#else
#define GSYNC() grid.sync()
#endif
#if REP
#define REPEAT(k) _Pragma("unroll 1") for (int rep_ = 0, nrep_ = opaque_int((((REP) >> (k)) & 1) + 1); rep_ < nrep_; ++rep_)
#else
#define REPEAT(k)
#endif
struct Args { const float* in[20]; float* out; unsigned char* ws; float inv_freq[32]; };
__global__ void __launch_bounds__(512, 2) mega_fwd(Args a) {
    using namespace mk;
    extern __shared__ __attribute__((aligned(16))) unsigned char lds[];
    cg::grid_group grid = cg::this_grid();
    const int tid = opaque_tid(), lane = tid & 63, wave = __builtin_amdgcn_readfirstlane(tid >> 6);
    constexpr int G = GRID;
    PG8_LAS unsigned char* ldsl = (PG8_LAS unsigned char*)lds;
    LAS float* ldsf = (LAS float*)lds;
    unsigned char* ws = a.ws;
    const float* x_in = a.in[0]; const float* c_in = a.in[1]; const int* pos = (const int*)a.in[2];
    const float* w_ada = a.in[3]; const float* b_ada = a.in[4];
    float* mod = (float*)(ws + WS_MOD); float* cosT = (float*)(ws + WS_COS); float* sinT = (float*)(ws + WS_SIN);
    bf16_t* HN = (bf16_t*)(ws + WS_HN); bf16_t* QN = (bf16_t*)(ws + WS_QN); bf16_t* KVN = (bf16_t*)(ws + WS_KVN);
    float* GST = (float*)(ws + WS_GST); float* GDV = (float*)(ws + WS_GDV); float* BT = (float*)(ws + WS_BT);
    bf16_t* PROJ = (bf16_t*)(ws + WS_R + R_PROJ); bf16_t* QB_ = (bf16_t*)(ws + WS_R + R_Q); bf16_t* KB_ = (bf16_t*)(ws + WS_R + R_K); bf16_t* VB_ = (bf16_t*)(ws + WS_R + R_V);
    bf16_t* HB = (bf16_t*)(ws + WS_R);
    float* xout = a.out;
    float* RSS = (float*)(ws + WS_RSS); float* BIAS = (float*)(ws + WS_BIAS); bf16_t* AN1 = (bf16_t*)(ws + WS_GST);
#if USE_XB
    volatile LAS unsigned* MISC = (volatile LAS unsigned*)(ldsl + MISC_OFF);
    if (tid < 16) MISC[tid] = 0u;
    __syncthreads();
    const XcdBarrier xbar = xcd_barrier_post((unsigned*)(ws + WS_BAR), MISC);
#endif

    REPEAT(0) {
#if (PHM >> 0) & 1
    for (int u = blockIdx.x; u < 192; u += G) adaln_unit(u, c_in, w_ada, b_ada, mod, ldsf);
    __syncthreads();
    { const int gt = blockIdx.x * 512 + tid, GT = G * 512;
      for (int e = gt; e < T * 32; e += GT) { const int t = e >> 5, j = e & 31;
          const float ang = (float)pos[t] * a.inv_freq[j];
          const double turns = (double)ang * 0.15915494309189535; const float fr = (float)(turns - rint(turns)) * 6.283185307179586f;
          cosT[e] = cosf(fr); sinT[e] = sinf(fr); } }
    { float* rz = (float*)(ws + WS_RSS) + T; const int gt = blockIdx.x * 512 + tid, GT = G * 512; for (int e = gt; e < 3 * T; e += GT) rz[e] = 0.f; }
    { LAS float* scr = (LAS float*)(ldsl + wave * 16384);
      const int gw = blockIdx.x * 8 + wave, NGW = G * 8;
      constexpr int I_IN = 16 * 64, I_Q = 4 * 24, I_KV = 2 * 32, I_O = 16 * 32, I_1 = 16 * 128, I_2 = 64 * 32, I_L = I_IN + I_Q + I_KV + I_O + I_1 + I_2;
      for (int it = gw; it < DEPTH * I_L; it += NGW) { const int l = it / I_L; int r = it % I_L; unsigned char* wl = ws + WS_W + (size_t)l * W_LAYER;
          if (r < I_IN) { transpose_item(a.in[5] + (size_t)l * 1024 * 2000, 1024, 2000, 2048, (bf16_t*)(wl + W_IN), 1, scr, r, lane); continue; } r -= I_IN;
          if (r < I_Q) { transpose_item(a.in[10] + (size_t)l * 256 * 768, 256, 768, 768, (bf16_t*)(wl + W_Q), 2, scr, r, lane); continue; } r -= I_Q;
          if (r < I_KV) { transpose_item(a.in[12] + (size_t)l * 128 * 1024, 128, 1024, 1024, (bf16_t*)(wl + W_KV), 0, scr, r, lane); continue; } r -= I_KV;
          if (r < I_O) { transpose_item(a.in[17] + (size_t)l * 1024 * 1024, 1024, 1024, 1024, (bf16_t*)(wl + W_O), 0, scr, r, lane); continue; } r -= I_O;
          if (r < I_1) { transpose_item(a.in[18] + (size_t)l * 1024 * 4096, 1024, 4096, 4096, (bf16_t*)(wl + W_1), 0, scr, r, lane); continue; } r -= I_1;
          transpose_item(a.in[19] + (size_t)l * 4096 * 1024, 4096, 1024, 1024, (bf16_t*)(wl + W_2), 0, scr, r, lane); } }
#endif
    grid.sync();
    prenorm_rows(x_in, HN, RSS, mod, 1024);
    for (int l = 0; l < DEPTH; ++l) { unsigned char* wl = ws + WS_W + (size_t)l * W_LAYER; const float* modl = mod + (size_t)l * 4 * NMOD;
        bias_rows((const bf16_t*)(wl + W_IN), NIN, modl, 0, BIAS + (size_t)l * 4 * NIN);
        bias_rows((const bf16_t*)(wl + W_1), DFF, modl, 3072, BIAS + 2 * 4 * NIN + (size_t)l * 4 * DFF); }
    GSYNC();

    }
#pragma unroll 1
    for (int l = 0; l < DEPTH; ++l) {
        const float* modl = mod + (size_t)l * 4 * NMOD;
        unsigned char* wl = ws + WS_W + (size_t)l * W_LAYER;
        const float* xin = l == 0 ? x_in : xout;
#if (PHM >> 2) & 1
        REPEAT(2) { pg8::Gemm g{HN, (const bf16_t*)(wl + W_IN), T, NIN, DM}; pg8::StaticOrder S; S.init(T, NIN, G, (int)blockIdx.x);
          pg8::EpiBf16<0> E{PROJ, NIN, BIAS + (size_t)l * 4 * NIN, 0, 0, 1.f, RSS + (size_t)(2 * l) * T, NIN};
          pg8::gemm_phase<pg8::EpiBf16<0>, pg8::StaticOrder, true, true>(ldsl, g, S, E); }
#endif
        GSYNC();
#if (PHM >> 3) & 1
        REPEAT(3) prep_tokens(PROJ, QN, KVN, KB_, a.in[9] + l * 256, a.in[11] + l * 128, a.in[16] + l * 64, cosT, sinT);
#endif
#if (PHM >> 4) & 1
        REPEAT(4) gla_pass_a(ldsl, PROJ, a.in[6] + (size_t)l * 16 * 256, a.in[7] + l * 256, BT, GST, GDV);
#endif
        GSYNC();
#if (PHM >> 5) & 1
        REPEAT(5) { int kq = 256; asm volatile("" : "+s"(kq));
          pg8::Gemm g{QN, (const bf16_t*)(wl + W_Q), T, 512, kq}; pg8::StaticOrder S; S.init(T, 512, G, (int)blockIdx.x);
          pg8::EpiQN E{QB_, a.in[13] + l * 128, (PG8_LAS float*)(ldsl + EPI_OFF)};
          pg8::gemm_phase<pg8::EpiQN, pg8::StaticOrder, true, true>(ldsl, g, S, E); }
#endif
#if (PHM >> 13) & 1
        REPEAT(5) { int kq = 256; asm volatile("" : "+s"(kq));
          pg8::Gemm g{QN, (const bf16_t*)(wl + W_Q) + 512 * 256, T, 256, kq}; pg8::StaticOrder S; S.init(T, 256, G, (int)blockIdx.x);
          pg8::EpiQR E{QB_, a.in[15] + l * 64, cosT, sinT};
          pg8::gemm_phase<pg8::EpiQR, pg8::StaticOrder, true, true>(ldsl, g, S, E); }
#endif
#if (PHM >> 6) & 1
        REPEAT(5) { int kk = 128; asm volatile("" : "+s"(kk));
          pg8::Gemm g{KVN, (const bf16_t*)(wl + W_KV), T, 1024, kk}; pg8::StaticOrder S; S.init(T, 1024, G, (int)blockIdx.x);
          pg8::EpiKV E{KB_, VB_, a.in[14] + l * 128, (PG8_LAS float*)(ldsl + EPI_OFF)};
          pg8::gemm_phase<pg8::EpiKV, pg8::StaticOrder, true, true>(ldsl, g, S, E); }
#endif
#if (PHM >> 7) & 1
        gla_scan(GST, GDV);
#endif
        GSYNC();
#if (PHM >> 8) & 1
        REPEAT(8) att::attn_phase((char*)lds, (const att::bf16*)QB_, (const att::bf16*)KB_, (const att::bf16*)VB_, (att::bf16*)HN);
#endif
        __syncthreads();
#if (PHM >> 9) & 1
        REPEAT(9) gla_pass_c(ldsl, PROJ, BT, GST, a.in[8] + l * 128, HN);
#endif
        GSYNC();
#if (PHM >> 10) & 1
        { pg8::Gemm g{HN, (const bf16_t*)(wl + W_O), T, DM, DM}; pg8::StaticOrder S; S.init(T, DM, G, (int)blockIdx.x);
          pg8::EpiResGate E{xin, xout, modl + 2048, AN1, modl + 4096, RSS + (size_t)(2 * l + 1) * T};
          pg8::gemm_phase<pg8::EpiResGate, pg8::StaticOrder, true, true>(ldsl, g, S, E); }
#endif
        GSYNC();
#if (PHM >> 11) & 1
        REPEAT(11) { pg8::Gemm g{AN1, (const bf16_t*)(wl + W_1), T, DFF, DM}; pg8::StaticOrder S; S.init(T, DFF, G, (int)blockIdx.x);
          pg8::EpiBf16<2> E{HB, DFF, BIAS + 2 * 4 * NIN + (size_t)l * 4 * DFF, 0, 0, 1.f, RSS + (size_t)(2 * l + 1) * T, DFF};
          pg8::gemm_phase<pg8::EpiBf16<2>, pg8::StaticOrder, true, true>(ldsl, g, S, E); }
#endif
        GSYNC();
#if (PHM >> 12) & 1
        { pg8::Gemm g{HB, (const bf16_t*)(wl + W_2), T, DM, DFF}; pg8::StaticOrder S; S.init(T, DM, G, (int)blockIdx.x);
          const bool more = l + 1 < DEPTH;
          pg8::EpiResGate E{xout, xout, modl + 5120, more ? HN : nullptr, mod + (size_t)(l + 1) * 4 * NMOD + 1024, RSS + (size_t)(2 * l + 2) * T};
          pg8::gemm_phase<pg8::EpiResGate, pg8::StaticOrder, true, true>(ldsl, g, S, E); }
#endif
        if (l + 1 < DEPTH) GSYNC();
    }
}

extern "C" void kernel_launch(void* const* d_in, const int* in_sizes, int n_in, void* d_out, int out_size, void* d_ws, size_t ws_size, hipStream_t stream) {
    static int grid = 0;
    if (grid == 0) {
        if (n_in != 20 || out_size != mk::T * mk::DM || ws_size < mk::WS_END) { fprintf(stderr, "kernel_launch: unexpected shapes (n_in %d out %d ws %zu)\n", n_in, out_size, ws_size); grid = -1; return; }
        int dev = 0, cus = 0, per = 0;
        (void)hipGetDevice(&dev); (void)hipDeviceGetAttribute(&cus, hipDeviceAttributeMultiprocessorCount, dev);
        (void)hipFuncSetAttribute((const void*)mega_fwd, hipFuncAttributeMaxDynamicSharedMemorySize, mk::LDS_BYTES);
        if (hipOccupancyMaxActiveBlocksPerMultiprocessor(&per, (const void*)mega_fwd, 512, mk::LDS_BYTES) != hipSuccess || per < 1) per = 1;
        (void)hipGetLastError();
        if (cus * per < GRID) fprintf(stderr, "kernel_launch: device holds %d co-resident workgroups, kernel built for %d\n", cus * per, GRID);
        grid = GRID;
    }
    if (grid < 0) return;
    (void)hipMemsetAsync((unsigned char*)d_ws + mk::WS_BAR, 0, XCD_BAR_WORDS * sizeof(unsigned), stream);
    Args a{};
    for (int i = 0; i < 20; ++i) a.in[i] = (const float*)d_in[i];
    a.out = (float*)d_out; a.ws = (unsigned char*)d_ws;
    for (int j = 0; j < 32; ++j) a.inv_freq[j] = powf(10000.0f, -(float)(2 * j) / 64.0f);
    void* args[] = {&a};
    hipError_t e = hipLaunchCooperativeKernel((const void*)mega_fwd, dim3(grid), dim3(512), args, mk::LDS_BYTES, stream);
    if (e != hipSuccess) fprintf(stderr, "kernel_launch: cooperative launch failed: %s (grid %d)\n", hipGetErrorString(e), grid);
}
```
